# Optimizing an MI355X kernel written in HIP

```python
import jax, jax.numpy as jnp
from jax import lax
import numpy as np


D_MODEL = 1024
BATCH = 1
SEQ = 16384
DEPTH = 4

EPS = 1e-6
N_MEM = 256
MLSTM_HEADS = 4
MLSTM_DH = 128
MLSTM_W = MLSTM_HEADS * MLSTM_DH
MLSTM_CHUNK = 128
CONV_W = 4
M_INIT = -1e30
DIL_PATTERNS = ((128, 1), (512, 4), (2048, 16))
DIL_HEADS_PER_GROUP = 4
DIL_DH = 64
DIL_W = 3 * DIL_HEADS_PER_GROUP * DIL_DH
DIL_OUT_W = DIL_HEADS_PER_GROUP * DIL_DH
Q_BLOCK = 128
MEM_HEADS = 4
MEM_DH = 128
MEM_W = MEM_HEADS * MEM_DH
N_BRANCH = 3
IN_SPLITS = (MLSTM_W, MLSTM_W, MLSTM_W, MLSTM_W, 2 * MLSTM_HEADS, DIL_W, DIL_W, DIL_W, MEM_W, N_BRANCH * D_MODEL)
IN_COLS = 4 * MLSTM_W + 2 * MLSTM_HEADS + 3 * DIL_W + MEM_W + N_BRANCH * D_MODEL
D_FF = 11 * D_MODEL // 4
N_EXPERTS = 8
TOP_K = 2
D_FF_EXPERT = 7 * D_MODEL // 2
MOE_TOKEN_BLOCK = 128
N_DENSE = (DEPTH + 1) // 2
N_MOE = DEPTH // 2

kernel_name = 'hybrid_mlstm_dilated_memory_moe'


def _rmsnorm(x, g):
    xf = x.astype(jnp.float32)
    y = xf * lax.rsqrt(jnp.mean(xf * xf, axis=-1, keepdims=True) + EPS)
    return (y * g.astype(jnp.float32)).astype(x.dtype)


def _headwise_layernorm(h, g):
    mu = jnp.mean(h, axis=-1, keepdims=True)
    var = jnp.mean(jnp.square(h - mu), axis=-1, keepdims=True)
    return (h - mu) * lax.rsqrt(var + EPS) * g.astype(jnp.float32).reshape(h.shape[-2], h.shape[-1])


def _causal_depthwise_conv(x, w):
    c = x.shape[-1]
    return lax.conv_general_dilated(x, w[:, None, :].astype(x.dtype), window_strides=(1,), padding=((CONV_W - 1, 0),), dimension_numbers=('NWC', 'WIO', 'NWC'), feature_group_count=c)


def _mlstm_chunkwise(q, k, v, i_pre, f_pre):
    b, s, h, dh = q.shape
    L = MLSTM_CHUNK
    nc = s // L
    k = k * (dh ** -0.5)
    log_f = jax.nn.log_sigmoid(f_pre)

    def seq_chunks(a):
        return a.reshape(b, nc, L, h, dh).transpose(1, 0, 3, 2, 4)

    def gate_chunks(a):
        return a.reshape(b, nc, L, h).transpose(1, 0, 3, 2)

    causal = jnp.tril(jnp.ones((L, L), dtype=bool))

    def step(carry, xs):
        c_state, n_state, m_state = carry
        qc, kc, vc, ic, lfc = xs
        cum = jnp.cumsum(lfc, axis=-1)
        d_mat = cum[..., :, None] - cum[..., None, :] + ic[..., None, :]
        d_mat = jnp.where(causal, d_mat, -jnp.inf)
        inter = cum + m_state[..., None]
        m_row = jnp.maximum(jnp.max(d_mat, axis=-1), inter)
        w_intra = jnp.exp(d_mat - m_row[..., None])
        w_inter = jnp.exp(inter - m_row)
        s_mat = jnp.einsum('bhld,bhjd->bhlj', qc, kc) * w_intra
        num = jnp.einsum('bhlj,bhjd->bhld', s_mat, vc) + w_inter[..., None] * jnp.einsum('bhvd,bhld->bhlv', c_state, qc)
        den = jnp.sum(s_mat, axis=-1) + w_inter * jnp.einsum('bhd,bhld->bhl', n_state, qc)
        h_out = num / jnp.maximum(jnp.abs(den), jnp.exp(-m_row))[..., None]
        total = cum[..., -1]
        g_end = total[..., None] - cum + ic
        m_new = jnp.maximum(total + m_state, jnp.max(g_end, axis=-1))
        w_end = jnp.exp(g_end - m_new[..., None])
        decay = jnp.exp(total + m_state - m_new)
        c_new = decay[..., None, None] * c_state + jnp.einsum('bhlv,bhld->bhvd', vc * w_end[..., None], kc)
        n_new = decay[..., None] * n_state + jnp.einsum('bhl,bhld->bhd', w_end, kc)
        return (c_new, n_new, m_new), h_out

    init = (jnp.zeros((b, h, dh, dh), jnp.float32), jnp.zeros((b, h, dh), jnp.float32), jnp.full((b, h), M_INIT, jnp.float32))
    _, hs = lax.scan(step, init, (seq_chunks(q), seq_chunks(k), seq_chunks(v), gate_chunks(i_pre), gate_chunks(log_f)))
    return hs.transpose(1, 0, 3, 2, 4).reshape(b, s, h, dh)


def _dilated_attention(q, k, v):
    b, s, _ = q.shape
    g_n = len(DIL_PATTERNS)
    hg, dh = DIL_HEADS_PER_GROUP, DIL_DH
    q = q.reshape(b, s, g_n, hg, dh)
    k = k.reshape(b, s, g_n, hg, dh)
    v = v.reshape(b, s, g_n, hg, dh)
    nb = s // Q_BLOCK
    q_blocks = q.reshape(b, nb, Q_BLOCK, g_n, hg, dh).transpose(1, 0, 2, 3, 4, 5)
    scale = dh ** -0.5

    def block(args):
        q_blk, start = args
        pos = start + jnp.arange(Q_BLOCK)
        outs, lses = [], []
        for g, (window, dil) in enumerate(DIL_PATTERNS):
            offs = jnp.arange(window // dil + 1) * dil
            idx = pos[:, None] - offs[None, :]
            valid = idx >= 0
            idx = jnp.maximum(idx, 0)
            kg = jnp.take(k[:, :, g], idx, axis=1)
            vg = jnp.take(v[:, :, g], idx, axis=1)
            sc = jnp.einsum('bqhd,bqjhd->bhqj', q_blk[:, :, g], kg) * scale
            sc = jnp.where(valid[None, None], sc, -jnp.inf)
            mx = jnp.max(sc, axis=-1, keepdims=True)
            p = jnp.exp(sc - mx)
            den = jnp.sum(p, axis=-1)
            o = jnp.einsum('bhqj,bqjhd->bqhd', p, vg) / den.transpose(0, 2, 1)[..., None]
            lse = (mx[..., 0] + jnp.log(den)).transpose(0, 2, 1)
            outs.append(o)
            lses.append(lse)
        o_all = jnp.stack(outs, axis=2)
        w = jax.nn.softmax(jnp.stack(lses, axis=2), axis=2)
        return jnp.einsum('bqgh,bqghd->bqhd', w, o_all)

    out = lax.map(block, (q_blocks, jnp.arange(nb) * Q_BLOCK))
    return out.transpose(1, 0, 2, 3, 4).reshape(b, s, hg * dh)


def _memory_attention(q, mem_n, w_kv):
    b, s, _ = q.shape
    kv = (mem_n @ w_kv).astype(jnp.float32)
    km, vm = jnp.split(kv, 2, axis=-1)
    km = km.reshape(b, -1, MEM_HEADS, MEM_DH)
    vm = vm.reshape(b, -1, MEM_HEADS, MEM_DH)
    qh = q.reshape(b, s, MEM_HEADS, MEM_DH)
    sc = jnp.einsum('bshd,bnhd->bhsn', qh, km) * (MEM_DH ** -0.5)
    p = jax.nn.softmax(sc, axis=-1)
    return jnp.einsum('bhsn,bnhd->bshd', p, vm).reshape(b, s, MEM_W)


def _swiglu(u, wg, wu, wd):
    return (jax.nn.silu(u @ wg) * (u @ wu)) @ wd


def _moe_swiglu(u, w_router, wg, wu, wd):
    b, s, d = u.shape
    ut = u.reshape(-1, d)
    t = ut.shape[0]
    probs = jax.nn.softmax((ut @ w_router).astype(jnp.float32), axis=-1)
    top_p, top_i = lax.top_k(probs, TOP_K)
    top_p = top_p / jnp.sum(top_p, axis=-1, keepdims=True)
    gates = jnp.sum(jax.nn.one_hot(top_i, N_EXPERTS, dtype=jnp.float32) * top_p[..., None], axis=1).astype(u.dtype)
    nblk = t // MOE_TOKEN_BLOCK

    def block(args):
        xb, gb = args
        h = jax.nn.silu(jnp.einsum('td,edf->tef', xb, wg)) * jnp.einsum('td,edf->tef', xb, wu)
        return jnp.einsum('tef,efd->td', h * gb[..., None], wd)

    y = lax.map(block, (ut.reshape(nblk, MOE_TOKEN_BLOCK, d), gates.reshape(nblk, MOE_TOKEN_BLOCK, N_EXPERTS)))
    return y.reshape(b, s, d)


def setup_inputs(seed: int = 0) -> dict:
    key = jax.random.key(seed)
    ks = jax.random.split(key, 24)

    def nrm(k, shape, scale):
        return jax.random.normal(k, shape, jnp.float32) * scale

    def gain(k, shape):
        return 1.0 + 0.02 * jax.random.normal(k, shape, jnp.float32)

    b_i = nrm(ks[4], (DEPTH, MLSTM_HEADS), 0.1)
    b_f = 3.0 + nrm(ks[5], (DEPTH, MLSTM_HEADS), 0.5)
    return {
        'x': nrm(ks[0], (BATCH, SEQ, D_MODEL), 1.0),
        'mem': nrm(ks[1], (BATCH, N_MEM, D_MODEL), 1.0),
        'norm_mix': gain(ks[2], (DEPTH, D_MODEL)),
        'w_in': nrm(ks[3], (DEPTH, D_MODEL, IN_COLS), D_MODEL ** -0.5),
        'conv_qk': nrm(ks[6], (DEPTH, CONV_W, 2 * MLSTM_W), CONV_W ** -0.5),
        'b_gate_if': jnp.concatenate([b_i, b_f], axis=-1),
        'mlstm_norm': gain(ks[7], (DEPTH, MLSTM_W)),
        'norm_mem': gain(ks[8], (DEPTH, D_MODEL)),
        'w_mem_kv': nrm(ks[9], (DEPTH, D_MODEL, 2 * MEM_W), D_MODEL ** -0.5),
        'w_br_m': nrm(ks[10], (DEPTH, MLSTM_W, D_MODEL), MLSTM_W ** -0.5),
        'w_br_d': nrm(ks[11], (DEPTH, DIL_OUT_W, D_MODEL), DIL_OUT_W ** -0.5),
        'w_br_x': nrm(ks[12], (DEPTH, MEM_W, D_MODEL), MEM_W ** -0.5),
        'w_out': nrm(ks[13], (DEPTH, D_MODEL, D_MODEL), D_MODEL ** -0.5),
        'norm_ffn': gain(ks[14], (DEPTH, D_MODEL)),
        'ffn_w_gate': nrm(ks[15], (N_DENSE, D_MODEL, D_FF), D_MODEL ** -0.5),
        'ffn_w_up': nrm(ks[16], (N_DENSE, D_MODEL, D_FF), D_MODEL ** -0.5),
        'ffn_w_down': nrm(ks[17], (N_DENSE, D_FF, D_MODEL), D_FF ** -0.5),
        'moe_router': nrm(ks[18], (N_MOE, D_MODEL, N_EXPERTS), D_MODEL ** -0.5),
        'moe_w_gate': nrm(ks[19], (N_MOE, N_EXPERTS, D_MODEL, D_FF_EXPERT), D_MODEL ** -0.5),
        'moe_w_up': nrm(ks[20], (N_MOE, N_EXPERTS, D_MODEL, D_FF_EXPERT), D_MODEL ** -0.5),
        'moe_w_down': nrm(ks[21], (N_MOE, N_EXPERTS, D_FF_EXPERT, D_MODEL), D_FF_EXPERT ** -0.5),
        'norm_final': gain(ks[22], (D_MODEL,)),
    }


def reference(x, mem, norm_mix, w_in, conv_qk, b_gate_if, mlstm_norm, norm_mem, w_mem_kv, w_br_m, w_br_d, w_br_x, w_out, norm_ffn, ffn_w_gate, ffn_w_up, ffn_w_down, moe_router, moe_w_gate, moe_w_up, moe_w_down, norm_final):
    b, s, _ = x.shape
    split_points = [int(p) for p in np.cumsum(IN_SPLITS)[:-1]]
    for layer in range(DEPTH):
        u = _rmsnorm(x, norm_mix[layer])
        proj = u @ w_in[layer]
        q_m, k_m, v_m, o_m, if_m, q_d, k_d, v_d, q_x, gate_pre = jnp.split(proj, split_points, axis=-1)
        qk = jax.nn.silu(_causal_depthwise_conv(jnp.concatenate([q_m, k_m], axis=-1), conv_qk[layer]))
        q_m, k_m = jnp.split(qk, 2, axis=-1)
        if_pre = (if_m + b_gate_if[layer]).astype(jnp.float32)
        h_m = _mlstm_chunkwise(q_m.astype(jnp.float32).reshape(b, s, MLSTM_HEADS, MLSTM_DH), k_m.astype(jnp.float32).reshape(b, s, MLSTM_HEADS, MLSTM_DH), v_m.astype(jnp.float32).reshape(b, s, MLSTM_HEADS, MLSTM_DH), if_pre[..., :MLSTM_HEADS], if_pre[..., MLSTM_HEADS:])
        h_m = (_headwise_layernorm(h_m, mlstm_norm[layer]).reshape(b, s, MLSTM_W) * jax.nn.sigmoid(o_m.astype(jnp.float32))).astype(x.dtype)
        h_d = _dilated_attention(q_d.astype(jnp.float32), k_d.astype(jnp.float32), v_d.astype(jnp.float32)).astype(x.dtype)
        mem_n = _rmsnorm(mem, norm_mem[layer])
        h_x = _memory_attention(q_x.astype(jnp.float32), mem_n, w_mem_kv[layer]).astype(x.dtype)
        g_m, g_d, g_x = jnp.split(jax.nn.sigmoid(gate_pre), N_BRANCH, axis=-1)
        merged = g_m * (h_m @ w_br_m[layer]) + g_d * (h_d @ w_br_d[layer]) + g_x * (h_x @ w_br_x[layer])
        x = x + merged @ w_out[layer]
        u = _rmsnorm(x, norm_ffn[layer])
        if layer % 2 == 0:
            x = x + _swiglu(u, ffn_w_gate[layer // 2], ffn_w_up[layer // 2], ffn_w_down[layer // 2])
        else:
            x = x + _moe_swiglu(u, moe_router[layer // 2], moe_w_gate[layer // 2], moe_w_up[layer // 2], moe_w_down[layer // 2])
    return _rmsnorm(x, norm_final)
```

```cpp
#include <hip/hip_runtime.h>
#include <cstdio>
#include <cstdint>

#define LAS __attribute__((address_space(3)))
#define GAS __attribute__((address_space(1)))
#define DI __device__ __forceinline__
typedef unsigned short bf16;
typedef short bf16x8 __attribute__((ext_vector_type(8)));
typedef short bf16x4 __attribute__((ext_vector_type(4)));
typedef float f32x4 __attribute__((ext_vector_type(4)));
typedef float f32x2 __attribute__((ext_vector_type(2)));
typedef unsigned u32x4 __attribute__((ext_vector_type(4)));
typedef unsigned u32x2 __attribute__((ext_vector_type(2)));
typedef LAS unsigned char* ldsp;

constexpr int SEQ = 16384, DM = 1024, DEPTH = 4, NMEM = 256;
constexpr int IN_COLS = 7944, PC = 7936;
constexpr int C_QM = 0, C_KM = 512, C_VM = 1024, C_OM = 1536, C_QD = 2048, C_KD = 2816, C_VD = 3584, C_QX = 4352, C_GT = 4864;
constexpr int DFF = 2816, DFE = 3584, NEXP = 8;
constexpr float EPS = 1e-6f;
constexpr float RS128 = 0.08838834764831845f;
constexpr float LOG2E = 1.4426950408889634f;

constexpr size_t MiB = 1u << 20;
constexpr size_t WS_CTL = 0, CTL_ZERO_BYTES = 1 * MiB;
constexpr size_t WS_IFG = 1 * MiB;
constexpr size_t WS_LSE = 2 * MiB;
constexpr size_t WS_SUMM = 3 * MiB;
constexpr size_t WS_MST = 3 * MiB + 65536;
constexpr size_t WS_ND = 3 * MiB + 262144;
constexpr size_t WS_NST = 3 * MiB + 524288;
constexpr size_t WS_TOKE = 4 * MiB;
constexpr size_t WS_GATEE = 4 * MiB + 524288;
constexpr size_t WS_MEMN = 6 * MiB;
constexpr size_t WS_KM = 8 * MiB;
constexpr size_t WS_VMT = 9 * MiB;
constexpr size_t WS_WIN = 16 * MiB;
constexpr size_t SZ_WIN = (size_t)PC * DM * 2;
constexpr size_t WS_WKV = 78 * MiB;
constexpr size_t WS_WBRM = 86 * MiB;
constexpr size_t WS_WBRD = 90 * MiB;
constexpr size_t WS_WBRX = 92 * MiB;
constexpr size_t WS_WOUT = 96 * MiB;
constexpr size_t WS_FGU = 104 * MiB;
constexpr size_t SZ_FGU = (size_t)2 * DFF * DM * 2;
constexpr size_t WS_FD = 126 * MiB;
constexpr size_t SZ_FD = (size_t)DM * DFF * 2;
constexpr size_t WS_MGU = 137 * MiB;
constexpr size_t SZ_MGU_E = (size_t)2 * DFE * DM * 2;
constexpr size_t WS_MD = 361 * MiB;
constexpr size_t SZ_MD_E = (size_t)DM * DFE * 2;
constexpr size_t WS_XRES = 473 * MiB;
constexpr size_t WS_U = 537 * MiB;
constexpr size_t WS_PROJ = 569 * MiB;
constexpr size_t WS_QKC = 817 * MiB;
constexpr size_t WS_DELTA = 849 * MiB;
constexpr size_t WS_YS = 817 * MiB;
constexpr size_t WS_CST = 881 * MiB;
constexpr size_t WS_OD = 897 * MiB;
constexpr size_t WS_MERGED = 881 * MiB;
constexpr size_t WS_HM = 921 * MiB;
constexpr size_t WS_HD = 937 * MiB;
constexpr size_t WS_HX = 945 * MiB;
constexpr size_t WS_END = 961 * MiB;
static_assert(WS_WIN + 4 * SZ_WIN <= WS_WKV && WS_FGU + 2 * SZ_FGU <= WS_FD && WS_FD + 2 * SZ_FD <= WS_MGU && WS_MGU + 16 * SZ_MGU_E <= WS_MD && WS_MD + 16 * SZ_MD_E <= WS_XRES, "weights map");
static_assert(WS_PROJ + (size_t)SEQ * PC * 2 <= WS_QKC && (size_t)34816 * DFE * 2 <= (size_t)SEQ * PC * 2, "proj map");
constexpr int CW_BAR = 4096;
constexpr int CW_MOE = 16384;

constexpr int SCR_BYTES = 139264;
constexpr int LDSCTL_OFF = SCR_BYTES;
constexpr int LDS_BYTES = 147456;
constexpr int LC_BAR = 8, LC_TB = 16, LC_CNT = 32, LC_LC = 48, LC_BASE = 64;

DI float bf2f(unsigned v) { return __uint_as_float(v << 16); }
DI float bflo(unsigned w) { return __uint_as_float(w << 16); }
DI float bfhi(unsigned w) { return __uint_as_float(w & 0xffff0000u); }
DI unsigned cvt_pk_bf16(float lo, float hi) { unsigned r; asm volatile("v_cvt_pk_bf16_f32 %0, %1, %2" : "=v"(r) : "v"(lo), "v"(hi)); return r; }
DI float fexp2(float x) { return __builtin_amdgcn_exp2f(x); }
DI float fexp(float x) { return __builtin_amdgcn_exp2f(x * LOG2E); }
DI float frcp(float x) { return __builtin_amdgcn_rcpf(x); }
DI float sigmoidf_(float x) { return frcp(1.0f + fexp(-x)); }
DI float siluf_(float x) { return x * sigmoidf_(x); }
DI float wave_sum(float v) {
#pragma unroll
    for (int o = 1; o < 64; o <<= 1) v += __shfl_xor(v, o);
    return v;
}
DI float wave_max(float v) {
#pragma unroll
    for (int o = 1; o < 64; o <<= 1) v = fmaxf(v, __shfl_xor(v, o));
    return v;
}
#define LDS_WAIT() asm volatile("s_waitcnt lgkmcnt(0)" ::: "memory")
#define VM_WAIT() asm volatile("s_waitcnt vmcnt(0)" ::: "memory")
#define MFMA16(a, b, c) __builtin_amdgcn_mfma_f32_16x16x32_bf16((a), (b), (c), 0, 0, 0)

#define XB_TMO      128
#define XB_XCNT(j)  (256  + 64 * (j))
#define XB_XSUB(j)  (1280 + 64 * (j))
#define XB_XGEN(j)  (2304 + 64 * (j))
#define XB_TOP      3328
#define XB_TOPGEN   3392
#define XCD_BAR_WORDS 3456
#define XB_SPIN_CAP (1u << 18)
DI unsigned xb_ld(unsigned* p)              { return __hip_atomic_load(p, __ATOMIC_RELAXED, __HIP_MEMORY_SCOPE_AGENT); }
DI unsigned xb_add(unsigned* p, unsigned v) { return __hip_atomic_fetch_add(p, v, __ATOMIC_RELAXED, __HIP_MEMORY_SCOPE_AGENT); }
DI unsigned xb_xcc_id() { return (unsigned)__builtin_amdgcn_s_getreg((3 << 11) | 20) & 0xFu; }
#define XB_SPIN(cond, bar) do { unsigned _sp = 0; while (cond) { __builtin_amdgcn_s_sleep(1); \
    if ((++_sp & 255u) == 0u) { if (xb_ld(&(bar)[XB_TMO])) break; if (_sp > XB_SPIN_CAP) { atomicAdd(&(bar)[XB_TMO], 1u); break; } } } } while (0)
struct XcdBarrier { unsigned* bar; unsigned x; volatile LAS unsigned* st; };
DI XcdBarrier xcd_barrier_post(unsigned* bar, volatile LAS unsigned* st) {
    XcdBarrier b; b.bar = bar; b.x = xb_xcc_id(); b.st = st;
    if (threadIdx.x == 0) (void)xb_add(&bar[XB_XCNT(b.x)], 1u);
    return b;
}
DI void xcd_barrier_complete(unsigned* bar, unsigned x, unsigned& nloc, unsigned& nx) {
    const unsigned G = gridDim.x * gridDim.y * gridDim.z;
    unsigned sum, cnt, mine, sp = 0u;
    for (;;) {
        sum = 0u; cnt = 0u; mine = 0u;
#pragma unroll 1
        for (unsigned j = 0; j < 16; ++j) { const unsigned c = xb_ld(&bar[XB_XCNT(j)]); sum += c; cnt += (c > 0u) ? 1u : 0u; mine = (j == x) ? c : mine; }
        if (sum == G) break;
        __builtin_amdgcn_s_sleep(1);
        if ((++sp & 255u) == 0u) { if (xb_ld(&bar[XB_TMO])) break; if (sp > XB_SPIN_CAP) { atomicAdd(&bar[XB_TMO], 1u); break; } }
    }
    nloc = mine > 0u ? mine : 1u; nx = cnt > 0u ? cnt : 1u;
}
DI void xcd_barrier(const XcdBarrier& b) {
    asm volatile("s_waitcnt vmcnt(0)" ::: "memory");
    __syncthreads();
    if (threadIdx.x == 0) {
        unsigned* bar = b.bar;
        __builtin_amdgcn_s_waitcnt(0);
        unsigned nloc = b.st[0], nx = b.st[1];
        if (nloc == 0u) { xcd_barrier_complete(bar, b.x, nloc, nx); b.st[0] = nloc; b.st[1] = nx; }
        const unsigned old = xb_add(&bar[XB_XSUB(b.x)], 1u);
        const unsigned gen = old / nloc;
        if (old + 1u == (gen + 1u) * nloc) {
            __builtin_amdgcn_fence(__ATOMIC_RELEASE, "agent");
            asm volatile("s_waitcnt vmcnt(0)" ::: "memory");
            const unsigned og = xb_add(&bar[XB_TOP], 1u);
            const unsigned tg = og / nx;
            if (og + 1u == (tg + 1u) * nx) xb_add(&bar[XB_TOPGEN], 1u);
            else XB_SPIN(xb_ld(&bar[XB_TOPGEN]) == tg, bar);
            __builtin_amdgcn_fence(__ATOMIC_ACQUIRE, "agent");
            xb_add(&bar[XB_XGEN(b.x)], 1u);
            asm volatile("s_waitcnt vmcnt(0)" ::: "memory");
        } else {
            XB_SPIN(xb_ld(&bar[XB_XGEN(b.x)]) == gen, bar);
            __builtin_amdgcn_fence(__ATOMIC_ACQUIRE, "agent");
            asm volatile("s_waitcnt vmcnt(0)" ::: "memory");
        }
    }
    __syncthreads();
}

namespace pg8 {
constexpr int BM = 256, BK = 64, HALF = 128, HTB = HALF * BK * 2, STAGE_BYTES = 8 * HTB, NXCD = 8, WGM = 8;
DI int lds_byte(int r, int c) { const int st = (r >> 4) * 2 + (c >> 5), rr = r & 15, cc = c & 31, ob = rr * 64 + cc * 2; return st * 1024 + (ob ^ (((ob >> 9) & 1) << 5)); }
DI void stage_rc(int b, int& R, int& C) { const int st = b / 1024, sb = b % 1024, swz = sb ^ (((sb >> 9) & 1) << 5); R = (st >> 1) * 16 + swz / 64; C = (st & 1) * 32 + (swz % 64) / 2; }
DI int perm32(int rho) { const int n = rho >> 4, i = rho & 15; return 8 * (i >> 2) + 4 * n + (i & 3); }
struct Unit { int pm, pn, e, x; };

DI bool static_unit(int i, int G, int c, int nM, int nN, int& pm, int& pn) {
    const int nwg = nM * nN; const long L = (long)i * G + c; if (L >= nwg) return false;
    int wgid = (int)L; { const int q = nwg / NXCD, r = nwg % NXCD, xcd = wgid % NXCD, off = wgid / NXCD; wgid = (xcd < r ? xcd * (q + 1) : r * (q + 1) + (xcd - r) * q) + off; }
    const int nig = WGM * nN, gid = wgid / nig, fm = gid * WGM, gsz = (nM - fm) < WGM ? (nM - fm) : WGM;
    pm = fm + ((wgid % nig) % gsz); pn = (wgid % nig) / gsz; return true;
}

template <class Epi, class Sched, bool ALIGN_EPI>
DI void gemm_phase(ldsp lds, const int K, const int lda, const int ldb, const Sched& S, const Epi& E) {
    int tid_ = threadIdx.x; asm volatile("" : "+v"(tid_));
    const int tid = tid_, wid = __builtin_amdgcn_readfirstlane(tid >> 6), lane = tid & 63, wr = wid >> 2, wc = wid & 3, fr = lane & 15, fq = lane >> 4;
    const int nt = K / BK;
    int sR[2], sC[2]; unsigned voffB[2];
#pragma unroll
    for (int i = 0; i < 2; ++i) { int R, C; stage_rc(tid * 16 + i * 8192, R, C); sR[i] = R; sC[i] = C; const int Rb = Epi::PERM ? ((R & ~31) + perm32(R & 31)) : R; voffB[i] = (unsigned)(Rb * ldb + C) * 2u; }
    unsigned vA[2][2], vAn[2][2];
    const size_t kstep = (size_t)(BK * 2);
    const size_t hstepB = (size_t)HALF * ldb * 2;
    const unsigned ldsw = (unsigned)wid * 1024u;
    const int aoff = lds_byte(wr * 64 + fr, fq * 8), boff = lds_byte(wc * 32 + fr, fq * 8);
#define PG8_SA(b, h) (((b) * 2 + (h)) * HTB)
#define PG8_SB(b, h) ((4 + (b) * 2 + (h)) * HTB)
#define PG8_STG(bufoff, p0, p1) do { \
        __builtin_amdgcn_global_load_lds((const unsigned*)(p0), (LAS unsigned*)(lds + (bufoff) + ldsw), 16, 0, 0); \
        __builtin_amdgcn_global_load_lds((const unsigned*)(p1), (LAS unsigned*)(lds + (bufoff) + ldsw + 8192), 16, 0, 0); } while (0)
#define PG8_STGB(bufoff, gbase) PG8_STG(bufoff, (gbase) + voffB[0], (gbase) + voffB[1])
#define PG8_STGA(bufoff, gbase, v, h) PG8_STG(bufoff, (gbase) + v[h][0], (gbase) + v[h][1])
#define PG8_LDA(dst, b, h) do { _Pragma("unroll") for (int m = 0; m < 4; ++m) _Pragma("unroll") for (int k = 0; k < 2; ++k) dst[m][k] = *(const LAS bf16x8*)(lds + PG8_SA(b, h) + aoff + m * 2048 + k * 1024); } while (0)
#define PG8_LDB(dst, b, h) do { _Pragma("unroll") for (int n = 0; n < 2; ++n) _Pragma("unroll") for (int k = 0; k < 2; ++k) dst[n][k] = *(const LAS bf16x8*)(lds + PG8_SB(b, h) + boff + n * 2048 + k * 1024); } while (0)
#define PG8_MMA(ai, bj, At, Bt) do { __builtin_amdgcn_s_setprio(1); _Pragma("unroll") for (int m = 0; m < 4; ++m) _Pragma("unroll") for (int n = 0; n < 2; ++n) _Pragma("unroll") for (int k = 0; k < 2; ++k) \
        acc[ai][bj][m][n] = __builtin_amdgcn_mfma_f32_16x16x32_bf16(Bt[n][k], At[m][k], acc[ai][bj][m][n], 0, 0, 0); __builtin_amdgcn_s_setprio(0); } while (0)
#define PG8_WAIT_V(n) asm volatile("s_waitcnt vmcnt(" #n ")" ::: "memory")
#define PG8_WAIT_L(n) asm volatile("s_waitcnt lgkmcnt(" #n ")" ::: "memory")
#define PG8_BAR __builtin_amdgcn_s_barrier()
#define PG8_SCHED __builtin_amdgcn_sched_barrier(0)
    Unit cur, nxt; int ui = 0;
    if (!S.next(0, cur)) return;
    f32x4 acc[2][2][4][2];
#pragma unroll
    for (int a = 0; a < 2; ++a)
#pragma unroll
        for (int b = 0; b < 2; ++b)
#pragma unroll
            for (int m = 0; m < 4; ++m)
#pragma unroll
                for (int n = 0; n < 2; ++n) acc[a][b][m][n] = (f32x4){0.f, 0.f, 0.f, 0.f};
    bf16x8 At[4][2], B0[2][2], B1[2][2];
    const char* cA = S.a_base(cur); const char* cB = S.b_base(cur);
    S.a_off(cur, sR, sC, lda, vA);
#pragma unroll
    for (int h = 0; h < 2; ++h)
#pragma unroll
        for (int i = 0; i < 2; ++i) vAn[h][i] = vA[h][i];
    PG8_STGB(PG8_SB(0, 0), cB); PG8_STGB(PG8_SB(0, 1), cB + hstepB); PG8_STGA(PG8_SA(0, 0), cA, vA, 0); PG8_STGA(PG8_SA(0, 1), cA, vA, 1);
    if (wr == 1) PG8_BAR;
    PG8_WAIT_V(2); PG8_BAR;
    PG8_STGB(PG8_SB(1, 0), cB + kstep); PG8_STGA(PG8_SA(1, 0), cA + kstep, vA, 0); PG8_STGB(PG8_SB(1, 1), cB + hstepB + kstep);
    PG8_WAIT_V(6); PG8_BAR;
    for (;;) {
        const bool has_next = S.next(ui + 1, nxt);
        const char* nA = has_next ? S.a_base(nxt) : cA; const char* nB = has_next ? S.b_base(nxt) : cB;
        if (Sched::GATHER) { if (has_next) S.a_off(nxt, sR, sC, lda, vAn); }
        for (int t = 0; t < nt; t += 2) {
            const bool last = (t == nt - 2);
            const char* a1 = cA + (size_t)(t + 1) * kstep;
            const char* a2 = last ? nA : cA + (size_t)(t + 2) * kstep; const char* b2 = last ? nB : cB + (size_t)(t + 2) * kstep;
            const char* a3 = a2 + kstep; const char* b3 = b2 + kstep;
            unsigned v2[2][2];
#pragma unroll
            for (int h = 0; h < 2; ++h)
#pragma unroll
                for (int i = 0; i < 2; ++i) v2[h][i] = (Sched::GATHER && last) ? vAn[h][i] : vA[h][i];
            PG8_LDB(B0, 0, 0); PG8_LDB(B1, 0, 1); PG8_SCHED; PG8_LDA(At, 0, 0); PG8_STGA(PG8_SA(1, 1), a1, vA, 1);
            PG8_WAIT_V(8); PG8_WAIT_L(0); PG8_BAR; PG8_MMA(0, 0, At, B0); PG8_MMA(0, 1, At, B1); PG8_BAR; PG8_SCHED;
            PG8_LDA(At, 0, 1); PG8_STGB(PG8_SB(0, 0), b2); PG8_STGB(PG8_SB(0, 1), b2 + hstepB); PG8_STGA(PG8_SA(0, 0), a2, v2, 0);
            PG8_WAIT_V(8); PG8_WAIT_L(0); PG8_BAR; PG8_MMA(1, 0, At, B0); PG8_MMA(1, 1, At, B1); PG8_BAR; PG8_SCHED;
            PG8_LDB(B0, 1, 0); PG8_LDB(B1, 1, 1); PG8_SCHED; PG8_LDA(At, 1, 0); PG8_STGA(PG8_SA(0, 1), a2, v2, 1);
            PG8_WAIT_V(8); PG8_WAIT_L(0); PG8_BAR; PG8_MMA(0, 0, At, B0); PG8_MMA(0, 1, At, B1); PG8_BAR; PG8_SCHED;
            PG8_LDA(At, 1, 1); PG8_STGB(PG8_SB(1, 0), b3); PG8_STGB(PG8_SB(1, 1), b3 + hstepB); PG8_STGA(PG8_SA(1, 0), a3, v2, 0);
            PG8_WAIT_V(8); PG8_WAIT_L(0); PG8_BAR; PG8_MMA(1, 0, At, B0); PG8_MMA(1, 1, At, B1); PG8_BAR; PG8_SCHED;
        }
        if constexpr (ALIGN_EPI) { if (wr == 0) PG8_BAR; }
        E(acc, cur, wr, wc, fr, fq);
        if (!has_next) break;
#pragma unroll
        for (int a = 0; a < 2; ++a)
#pragma unroll
            for (int b = 0; b < 2; ++b)
#pragma unroll
                for (int m = 0; m < 4; ++m)
#pragma unroll
                    for (int n = 0; n < 2; ++n) acc[a][b][m][n] = (f32x4){0.f, 0.f, 0.f, 0.f};
        cur = nxt; cA = nA; cB = nB; ++ui;
#pragma unroll
        for (int h = 0; h < 2; ++h)
#pragma unroll
            for (int i = 0; i < 2; ++i) vA[h][i] = vAn[h][i];
        if constexpr (ALIGN_EPI) { if (wr == 1) PG8_BAR; }
    }
    PG8_WAIT_V(0);
    if constexpr (!ALIGN_EPI) { if (wr == 0) PG8_BAR; }
    PG8_BAR;
#undef PG8_SA
#undef PG8_SB
#undef PG8_STG
#undef PG8_STGB
#undef PG8_STGA
#undef PG8_LDA
#undef PG8_LDB
#undef PG8_MMA
#undef PG8_WAIT_V
#undef PG8_WAIT_L
#undef PG8_BAR
#undef PG8_SCHED
}

struct SchedDense {
    static constexpr bool GATHER = false;
    const char* A; const char* B; int nM, nN, G, c, lda, ldb;
    DI bool next(int i, Unit& u) const { u.e = 0; u.x = 0; return static_unit(i, G, c, nM, nN, u.pm, u.pn); }
    DI const char* a_base(const Unit& u) const { return A + (size_t)u.pm * 256 * lda * 2; }
    DI const char* b_base(const Unit& u) const { return B + (size_t)u.pn * 256 * ldb * 2; }
    DI void a_off(const Unit&, const int (&R)[2], const int (&C)[2], int lda_, unsigned (&v)[2][2]) const {
#pragma unroll
        for (int h = 0; h < 2; ++h)
#pragma unroll
            for (int i = 0; i < 2; ++i) v[h][i] = (unsigned)((h * 128 + R[i]) * lda_ + C[i]) * 2u;
    }
};
struct SchedKV {
    static constexpr bool GATHER = false;
    const char* memn; const char* wkv; int G, c, first;
    DI bool next(int i, Unit& u) const {
        int cc = c - first; if (cc < 0) cc += G; const int L = i * G + cc; if (L >= 16) return false;
        u.e = L >> 2; u.x = (L >> 1) & 1; const int j = L & 1; u.pm = u.x ? j : 0; u.pn = u.x ? 0 : j; return true;
    }
    DI const char* a_base(const Unit& u) const { return u.x ? wkv + (size_t)u.e * 1024 * 1024 * 2 + (size_t)(512 + u.pm * 256) * 1024 * 2 : memn + (size_t)u.e * 256 * 1024 * 2; }
    DI const char* b_base(const Unit& u) const { return u.x ? memn + (size_t)u.e * 256 * 1024 * 2 : wkv + (size_t)u.e * 1024 * 1024 * 2 + (size_t)(u.pn * 256) * 1024 * 2; }
    DI void a_off(const Unit&, const int (&R)[2], const int (&C)[2], int lda_, unsigned (&v)[2][2]) const {
#pragma unroll
        for (int h = 0; h < 2; ++h)
#pragma unroll
            for (int i = 0; i < 2; ++i) v[h][i] = (unsigned)((h * 128 + R[i]) * lda_ + C[i]) * 2u;
    }
};
template <bool UP> struct SchedMoe {
    static constexpr bool GATHER = UP;
    const char* A; const char* B; size_t bstride; const int* toke; volatile LAS unsigned* lc; int nN, G, c, lda, ldb;
    DI bool next(int i, Unit& u) const {
        const int T = __builtin_amdgcn_readfirstlane((int)lc[LC_TB + 8]);
        if (!static_unit(i, G, c, T, nN, u.pm, u.pn)) return false;
        int e = 0, tbe = 0;
#pragma unroll
        for (int j = 1; j < 8; ++j) { const int tbj = __builtin_amdgcn_readfirstlane((int)lc[LC_TB + j]); if (u.pm >= tbj) { e = j; tbe = tbj; } }
        u.e = e; u.x = (u.pm - tbe) * 256; return true;
    }
    DI const char* a_base(const Unit& u) const { return UP ? A : A + (size_t)u.pm * 256 * lda * 2; }
    DI const char* b_base(const Unit& u) const { return B + (size_t)u.e * bstride + (size_t)u.pn * 256 * ldb * 2; }
    DI void a_off(const Unit& u, const int (&R)[2], const int (&C)[2], int lda_, unsigned (&v)[2][2]) const {
        const int cnt = __builtin_amdgcn_readfirstlane((int)lc[LC_CNT + u.e]);
#pragma unroll
        for (int h = 0; h < 2; ++h)
#pragma unroll
            for (int i = 0; i < 2; ++i) {
                if (UP) { const int pos = u.x + h * 128 + R[i]; const int tok = pos < cnt ? (toke[u.e * SEQ + pos] & 0xFFFFF) : 0; v[h][i] = (unsigned)(tok * lda_ + C[i]) * 2u; }
                else v[h][i] = (unsigned)((h * 128 + R[i]) * lda_ + C[i]) * 2u;
            }
    }
};

struct EpiProj {
    static constexpr bool PERM = true;
    bf16* O; int ldc; int sig_pn;
    DI void operator()(const f32x4 (&acc)[2][2][4][2], const Unit& u, int wr, int wc, int fr, int fq) const {
        const int row0 = u.pm * BM + wr * 64 + fr, col0 = u.pn * BM + wc * 32 + 8 * fq; const bool sg = u.pn >= sig_pn;
#pragma unroll
        for (int ai = 0; ai < 2; ++ai)
#pragma unroll
            for (int m = 0; m < 4; ++m) { bf16* rowp = O + (size_t)(row0 + ai * HALF + m * 16) * ldc + col0;
#pragma unroll
                for (int bj = 0; bj < 2; ++bj) { f32x4 v0 = acc[ai][bj][m][0], v1 = acc[ai][bj][m][1];
                    if (sg) {
#pragma unroll
                        for (int q = 0; q < 4; ++q) { v0[q] = sigmoidf_(v0[q]); v1[q] = sigmoidf_(v1[q]); } }
                    u32x4 w; w.x = cvt_pk_bf16(v0[0], v0[1]); w.y = cvt_pk_bf16(v0[2], v0[3]); w.z = cvt_pk_bf16(v1[0], v1[1]); w.w = cvt_pk_bf16(v1[2], v1[3]);
                    *(u32x4*)(rowp + bj * HALF) = w; } }
    }
};
struct EpiKV {
    static constexpr bool PERM = true;
    bf16* km; bf16* vmt;
    DI void operator()(const f32x4 (&acc)[2][2][4][2], const Unit& u, int wr, int wc, int fr, int fq) const {
        bf16* O = u.x ? vmt + (size_t)u.e * 512 * 256 : km + (size_t)u.e * 256 * 512; const int ldc = u.x ? 256 : 512;
        const int row0 = u.pm * BM + wr * 64 + fr, col0 = u.pn * BM + wc * 32 + 8 * fq;
#pragma unroll
        for (int ai = 0; ai < 2; ++ai)
#pragma unroll
            for (int m = 0; m < 4; ++m) { bf16* rowp = O + (size_t)(row0 + ai * HALF + m * 16) * ldc + col0;
#pragma unroll
                for (int bj = 0; bj < 2; ++bj) { const f32x4 v0 = acc[ai][bj][m][0], v1 = acc[ai][bj][m][1];
                    u32x4 w; w.x = cvt_pk_bf16(v0[0], v0[1]); w.y = cvt_pk_bf16(v0[2], v0[3]); w.z = cvt_pk_bf16(v1[0], v1[1]); w.w = cvt_pk_bf16(v1[2], v1[3]);
                    *(u32x4*)(rowp + bj * HALF) = w; } }
    }
};
template <bool FIRST> struct EpiBranch {
    static constexpr bool PERM = true;
    bf16* Mg; const bf16* gates; int ldg; int goff;
    DI void operator()(const f32x4 (&acc)[2][2][4][2], const Unit& u, int wr, int wc, int fr, int fq) const {
        const int row0 = u.pm * BM + wr * 64 + fr, col0 = u.pn * BM + wc * 32 + 8 * fq;
#pragma unroll
        for (int ai = 0; ai < 2; ++ai)
#pragma unroll
            for (int m = 0; m < 4; ++m) { const size_t row = (size_t)(row0 + ai * HALF + m * 16);
#pragma unroll
                for (int bj = 0; bj < 2; ++bj) { const f32x4 v0 = acc[ai][bj][m][0], v1 = acc[ai][bj][m][1];
                    const u32x4 g = *(const u32x4*)(gates + row * ldg + goff + col0 + bj * HALF);
                    bf16* mp = Mg + row * DM + col0 + bj * HALF;
                    float o[8];
                    if (FIRST) {
#pragma unroll
                        for (int q = 0; q < 8; ++q) o[q] = 0.f;
                    } else { const u32x4 old = *(const u32x4*)mp;
                        o[0] = bflo(old.x); o[1] = bfhi(old.x); o[2] = bflo(old.y); o[3] = bfhi(old.y); o[4] = bflo(old.z); o[5] = bfhi(old.z); o[6] = bflo(old.w); o[7] = bfhi(old.w); }
                    o[0] += bflo(g.x) * v0[0]; o[1] += bfhi(g.x) * v0[1]; o[2] += bflo(g.y) * v0[2]; o[3] += bfhi(g.y) * v0[3];
                    o[4] += bflo(g.z) * v1[0]; o[5] += bfhi(g.z) * v1[1]; o[6] += bflo(g.w) * v1[2]; o[7] += bfhi(g.w) * v1[3];
                    u32x4 w; w.x = cvt_pk_bf16(o[0], o[1]); w.y = cvt_pk_bf16(o[2], o[3]); w.z = cvt_pk_bf16(o[4], o[5]); w.w = cvt_pk_bf16(o[6], o[7]);
                    *(u32x4*)mp = w; } }
    }
};
struct EpiResF32 {
    static constexpr bool PERM = false;
    const float* in; float* out;
    DI void operator()(const f32x4 (&acc)[2][2][4][2], const Unit& u, int wr, int wc, int fr, int fq) const {
        const int row0 = u.pm * BM + wr * 64 + fr, col0 = u.pn * BM + wc * 32 + 4 * fq;
#pragma unroll
        for (int ai = 0; ai < 2; ++ai)
#pragma unroll
            for (int m = 0; m < 4; ++m) { const size_t off = (size_t)(row0 + ai * HALF + m * 16) * DM + col0;
#pragma unroll
                for (int bj = 0; bj < 2; ++bj)
#pragma unroll
                    for (int n = 0; n < 2; ++n) { const f32x4 b = *(const f32x4*)(in + off + bj * HALF + n * 16); *(f32x4*)(out + off + bj * HALF + n * 16) = b + acc[ai][bj][m][n]; } }
    }
};
template <bool MOE> struct EpiSwiglu {
    static constexpr bool PERM = true;
    bf16* H; int ldh; const float* gatee; volatile LAS unsigned* lc;
    DI void operator()(const f32x4 (&acc)[2][2][4][2], const Unit& u, int wr, int wc, int fr, int fq) const {
        const int r0 = wr * 64 + fr, col0 = u.pn * HALF + wc * 32 + 8 * fq;
        int cnt = 0; if (MOE) cnt = __builtin_amdgcn_readfirstlane((int)lc[LC_CNT + u.e]);
#pragma unroll
        for (int ai = 0; ai < 2; ++ai)
#pragma unroll
            for (int m = 0; m < 4; ++m) { const int r = r0 + ai * HALF + m * 16;
                float rg = 1.f; if (MOE) { const int pos = u.x + r; rg = pos < cnt ? gatee[u.e * SEQ + pos] : 0.f; }
                const f32x4 g0 = acc[ai][0][m][0], g1 = acc[ai][0][m][1], u0 = acc[ai][1][m][0], u1 = acc[ai][1][m][1];
                float o[8];
#pragma unroll
                for (int q = 0; q < 4; ++q) { o[q] = siluf_(g0[q]) * u0[q] * rg; o[4 + q] = siluf_(g1[q]) * u1[q] * rg; }
                u32x4 w; w.x = cvt_pk_bf16(o[0], o[1]); w.y = cvt_pk_bf16(o[2], o[3]); w.z = cvt_pk_bf16(o[4], o[5]); w.w = cvt_pk_bf16(o[6], o[7]);
                *(u32x4*)(H + (size_t)(u.pm * BM + r) * ldh + col0) = w; }
    }
};
struct EpiMoeDown {
    static constexpr bool PERM = true;
    bf16* ys; const int* toke; volatile LAS unsigned* lc;
    DI void operator()(const f32x4 (&acc)[2][2][4][2], const Unit& u, int wr, int wc, int fr, int fq) const {
        const int r0 = wr * 64 + fr, col0 = u.pn * BM + wc * 32 + 8 * fq; const int cnt = __builtin_amdgcn_readfirstlane((int)lc[LC_CNT + u.e]);
#pragma unroll
        for (int ai = 0; ai < 2; ++ai)
#pragma unroll
            for (int m = 0; m < 4; ++m) { const int pos = u.x + r0 + ai * HALF + m * 16;
                if (pos < cnt) { const int tk = toke[u.e * SEQ + pos]; bf16* rowp = ys + ((size_t)(tk >> 20) * SEQ + (size_t)(tk & 0xFFFFF)) * DM + col0;
#pragma unroll
                    for (int bj = 0; bj < 2; ++bj) { const f32x4 v0 = acc[ai][bj][m][0], v1 = acc[ai][bj][m][1];
                        u32x4 w; w.x = cvt_pk_bf16(v0[0], v0[1]); w.y = cvt_pk_bf16(v0[2], v0[3]); w.z = cvt_pk_bf16(v1[0], v1[1]); w.w = cvt_pk_bf16(v1[2], v1[3]);
                        *(u32x4*)(rowp + bj * HALF) = w; } } }
    }
};
}

struct Args { const float* in[22]; float* out; unsigned char* ws; };
struct Frame {
    ldsp lds; volatile LAS unsigned* lc; unsigned* ctl;
    int tid, lane, wave, vcu, G;
    unsigned char* ws;
    const __attribute__((address_space(4))) Args* ka;
};
DI void refresh(Frame& F) {
    int t = threadIdx.x; asm volatile("" : "+v"(t)); F.tid = t; F.lane = t & 63; F.wave = __builtin_amdgcn_readfirstlane(t >> 6);
    const __attribute__((address_space(4))) Args* ka = (const __attribute__((address_space(4))) Args*)__builtin_amdgcn_kernarg_segment_ptr(); asm volatile("" : "+s"(ka)); F.ka = ka;
    unsigned char* w = ka->ws; F.ws = w; F.ctl = (unsigned*)(w + WS_CTL);
}
enum { I_X = 0, I_MEM, I_NORM_MIX, I_W_IN, I_CONV, I_BIF, I_MLSTM_NORM, I_NORM_MEM, I_W_MEM_KV, I_W_BR_M, I_W_BR_D, I_W_BR_X, I_W_OUT, I_NORM_FFN,
       I_FFN_G, I_FFN_U, I_FFN_D, I_ROUTER, I_MOE_G, I_MOE_U, I_MOE_D, I_NORM_FINAL };

DI void cvt_item(const float* src, int sld, int scol0, bf16* dst, int dld, int drow0, int k0, float scale, LAS float* scr, int lane) {
    f32x4 v[16];
    const float* s0 = src + (size_t)(k0 + (lane >> 4)) * sld + scol0 + 4 * (lane & 15);
#pragma unroll
    for (int i = 0; i < 16; ++i) v[i] = *(const f32x4*)(s0 + (size_t)(4 * i) * sld);
#pragma unroll
    for (int i = 0; i < 16; ++i) { LAS float* p = scr + (4 * i + (lane >> 4)) * 65 + 4 * (lane & 15); p[0] = v[i].x * scale; p[1] = v[i].y * scale; p[2] = v[i].z * scale; p[3] = v[i].w * scale; }
    LDS_WAIT(); asm volatile("" ::: "memory");
    const int c = lane & 7;
#pragma unroll
    for (int j = 0; j < 8; ++j) { const int n = (lane >> 3) + 8 * j; const LAS float* s = scr + (8 * c) * 65 + n;
        u32x4 o; o.x = cvt_pk_bf16(s[0], s[65]); o.y = cvt_pk_bf16(s[2 * 65], s[3 * 65]); o.z = cvt_pk_bf16(s[4 * 65], s[5 * 65]); o.w = cvt_pk_bf16(s[6 * 65], s[7 * 65]);
        *(u32x4*)(dst + (size_t)(drow0 + n) * dld + k0 + 8 * c) = o; }
    LDS_WAIT(); asm volatile("" ::: "memory");
}
DI void prologue_convert(Frame& F) {
    LAS float* scr = (LAS float*)(F.lds + F.wave * 16640);
    const int gw = F.vcu * 8 + F.wave, NGW = F.G * 8, lane = F.lane;
    unsigned char* ws = F.ws;
    constexpr int PER_L = 1984 + 256 + 128 + 64 + 128 + 256, N_L = 4 * PER_L, PER_D = 3 * 704, N_D = 2 * PER_D, PER_E = 3 * 896, N_E = 16 * PER_E;
    for (int it = gw; it < N_L + N_D + N_E; it += NGW) {
        int r = it;
        if (r < N_L) { const int l = r / PER_L; r -= l * PER_L;
            if (r < 1984) { const int kb = r / 124, nb = r % 124, n0 = nb * 64; const int scol = n0 < 2048 ? n0 : n0 + 8;
                const float sc = (n0 >= C_QD && n0 < C_KD) ? 0.125f : ((n0 >= C_QX && n0 < C_GT) ? RS128 : 1.0f);
                cvt_item(F.ka->in[I_W_IN] + (size_t)l * DM * IN_COLS, IN_COLS, scol, (bf16*)(ws + WS_WIN) + (size_t)l * PC * DM, DM, n0, kb * 64, sc, scr, lane); continue; }
            r -= 1984;
            if (r < 256) { const int kb = r >> 4, nb = r & 15; cvt_item(F.ka->in[I_W_MEM_KV] + (size_t)l * DM * DM, DM, nb * 64, (bf16*)(ws + WS_WKV) + (size_t)l * DM * DM, DM, nb * 64, kb * 64, 1.f, scr, lane); continue; }
            r -= 256;
            if (r < 128) { const int kb = r >> 4, nb = r & 15; cvt_item(F.ka->in[I_W_BR_M] + (size_t)l * 512 * DM, DM, nb * 64, (bf16*)(ws + WS_WBRM) + (size_t)l * DM * 512, 512, nb * 64, kb * 64, 1.f, scr, lane); continue; }
            r -= 128;
            if (r < 64) { const int kb = r >> 4, nb = r & 15; cvt_item(F.ka->in[I_W_BR_D] + (size_t)l * 256 * DM, DM, nb * 64, (bf16*)(ws + WS_WBRD) + (size_t)l * DM * 256, 256, nb * 64, kb * 64, 1.f, scr, lane); continue; }
            r -= 64;
            if (r < 128) { const int kb = r >> 4, nb = r & 15; cvt_item(F.ka->in[I_W_BR_X] + (size_t)l * 512 * DM, DM, nb * 64, (bf16*)(ws + WS_WBRX) + (size_t)l * DM * 512, 512, nb * 64, kb * 64, 1.f, scr, lane); continue; }
            r -= 128;
            { const int kb = r >> 4, nb = r & 15; cvt_item(F.ka->in[I_W_OUT] + (size_t)l * DM * DM, DM, nb * 64, (bf16*)(ws + WS_WOUT) + (size_t)l * DM * DM, DM, nb * 64, kb * 64, 1.f, scr, lane); continue; }
        }
        r -= N_L;
        if (r < N_D) { const int j = r / PER_D; r -= j * PER_D;
            if (r < 1408) { const int up = r >= 704; if (up) r -= 704; const int kb = r / 44, nb = r % 44, n0 = nb * 64; const int drow = 256 * (n0 >> 7) + (n0 & 127) + (up ? 128 : 0);
                cvt_item(F.ka->in[up ? I_FFN_U : I_FFN_G] + (size_t)j * DM * DFF, DFF, n0, (bf16*)(ws + WS_FGU + (size_t)j * SZ_FGU), DM, drow, kb * 64, 1.f, scr, lane); continue; }
            r -= 1408;
            { const int kb = r >> 4, nb = r & 15; cvt_item(F.ka->in[I_FFN_D] + (size_t)j * DFF * DM, DM, nb * 64, (bf16*)(ws + WS_FD + (size_t)j * SZ_FD), DFF, nb * 64, kb * 64, 1.f, scr, lane); continue; }
        }
        r -= N_D;
        { const int je = r / PER_E; r -= je * PER_E;
            if (r < 1792) { const int up = r >= 896; if (up) r -= 896; const int kb = r / 56, nb = r % 56, n0 = nb * 64; const int drow = 256 * (n0 >> 7) + (n0 & 127) + (up ? 128 : 0);
                cvt_item(F.ka->in[up ? I_MOE_U : I_MOE_G] + (size_t)je * DM * DFE, DFE, n0, (bf16*)(ws + WS_MGU + (size_t)je * SZ_MGU_E), DM, drow, kb * 64, 1.f, scr, lane); continue; }
            r -= 1792;
            { const int kb = r >> 4, nb = r & 15; cvt_item(F.ka->in[I_MOE_D] + (size_t)je * DFE * DM, DM, nb * 64, (bf16*)(ws + WS_MD + (size_t)je * SZ_MD_E), DFE, nb * 64, kb * 64, 1.f, scr, lane); continue; }
        }
    }
    for (int rw = gw; rw < 4 * NMEM; rw += NGW) { const int l = rw >> 8, m = rw & 255;
        const f32x4* xr = (const f32x4*)(F.ka->in[I_MEM] + (size_t)m * DM) + lane; const f32x4* gr = (const f32x4*)(F.ka->in[I_NORM_MEM] + (size_t)l * DM) + lane;
        f32x4 v[4]; float s = 0.f;
#pragma unroll
        for (int j = 0; j < 4; ++j) { v[j] = xr[64 * j]; s += (v[j].x * v[j].x + v[j].y * v[j].y) + (v[j].z * v[j].z + v[j].w * v[j].w); }
        const float rstd = 1.0f / sqrtf(wave_sum(s) * (1.f / DM) + EPS);
        u32x2* o8 = (u32x2*)((bf16*)(ws + WS_MEMN) + (size_t)rw * DM) + lane;
#pragma unroll
        for (int j = 0; j < 4; ++j) { const f32x4 g = gr[64 * j]; u32x2 w; w.x = cvt_pk_bf16(v[j].x * rstd * g.x, v[j].y * rstd * g.y); w.y = cvt_pk_bf16(v[j].z * rstd * g.z, v[j].w * rstd * g.w); o8[64 * j] = w; }
    }
}

DI void reduce8(float (&d)[8], int lane) {
    float r4[4], r2[2], p;
    { const bool hi = lane & 32;
#pragma unroll
      for (int i = 0; i < 4; ++i) { const float send = hi ? d[i] : d[i + 4], keep = hi ? d[i + 4] : d[i]; r4[i] = keep + __shfl_xor(send, 32); } }
    { const bool hi = lane & 16;
#pragma unroll
      for (int i = 0; i < 2; ++i) { const float send = hi ? r4[i] : r4[i + 2], keep = hi ? r4[i + 2] : r4[i]; r2[i] = keep + __shfl_xor(send, 16); } }
    { const bool hi = lane & 8; const float send = hi ? r2[0] : r2[1], keep = hi ? r2[1] : r2[0]; p = keep + __shfl_xor(send, 8); }
    p += __shfl_xor(p, 4); p += __shfl_xor(p, 2); p += __shfl_xor(p, 1);
#pragma unroll
    for (int i = 0; i < 8; ++i) d[i] = __shfl(p, ((i >> 2) & 1) * 32 + ((i >> 1) & 1) * 16 + (i & 1) * 8);
}
template <bool ADD_YS, bool WRITE_X, int DOTS, bool FINAL>
DI void norm_phase(Frame& F, const float* xin, float* xout, const float* gain, bf16* U, float* outF, const float* wsm, int wld, const float* bias8, int moe_j) {
    const int lane = F.lane;
    f32x4 g[4];
#pragma unroll
    for (int j = 0; j < 4; ++j) g[j] = *((const f32x4*)gain + 64 * j + lane);
    float wreg[16][8];
    if (DOTS) {
#pragma unroll
        for (int j = 0; j < 4; ++j)
#pragma unroll
            for (int e = 0; e < 4; ++e) { const float* p = wsm + (size_t)(256 * j + 4 * lane + e) * wld; const f32x4 a = *(const f32x4*)p, b = *(const f32x4*)(p + 4);
                wreg[j * 4 + e][0] = a.x; wreg[j * 4 + e][1] = a.y; wreg[j * 4 + e][2] = a.z; wreg[j * 4 + e][3] = a.w; wreg[j * 4 + e][4] = b.x; wreg[j * 4 + e][5] = b.y; wreg[j * 4 + e][6] = b.z; wreg[j * 4 + e][7] = b.w; }
    }
    const bf16* ys = (const bf16*)(F.ws + WS_YS);
    LAS int* sel_e = (LAS int*)(F.lds); LAS int* sel_lp = sel_e + 128; LAS float* sel_g = (LAS float*)(sel_lp + 128);
    for (int rb = F.vcu; rb < SEQ / 64; rb += F.G) {
        if (DOTS == 2) { if (F.tid < 8) F.lc[LC_LC + F.tid] = 0u; __syncthreads(); }
        for (int i = 0; i < 8; ++i) {
            const int rl = F.wave * 8 + i, row = rb * 64 + rl;
            f32x4 v[4]; float ss = 0.f;
#pragma unroll
            for (int j = 0; j < 4; ++j) { v[j] = *((const f32x4*)(xin + (size_t)row * DM) + 64 * j + lane);
                if (ADD_YS) { const u32x2 y0 = *((const u32x2*)(ys + (size_t)row * DM) + 64 * j + lane), y1 = *((const u32x2*)(ys + (size_t)(SEQ + row) * DM) + 64 * j + lane);
                    v[j].x += bflo(y0.x) + bflo(y1.x); v[j].y += bfhi(y0.x) + bfhi(y1.x); v[j].z += bflo(y0.y) + bflo(y1.y); v[j].w += bfhi(y0.y) + bfhi(y1.y); }
                if (WRITE_X) *((f32x4*)(xout + (size_t)row * DM) + 64 * j + lane) = v[j];
                ss += (v[j].x * v[j].x + v[j].y * v[j].y) + (v[j].z * v[j].z + v[j].w * v[j].w); }
            const float rstd = 1.0f / sqrtf(wave_sum(ss) * (1.f / DM) + EPS);
#pragma unroll
            for (int j = 0; j < 4; ++j) { v[j] = v[j] * g[j];
                if (FINAL) *((f32x4*)(outF + (size_t)row * DM) + 64 * j + lane) = v[j] * rstd;
                else { u32x2 w; w.x = cvt_pk_bf16(v[j].x * rstd, v[j].y * rstd); w.y = cvt_pk_bf16(v[j].z * rstd, v[j].w * rstd); *((u32x2*)(U + (size_t)row * DM) + 64 * j + lane) = w; } }
            if (DOTS) {
                float d[8];
#pragma unroll
                for (int c = 0; c < 8; ++c) d[c] = 0.f;
#pragma unroll
                for (int j = 0; j < 4; ++j)
#pragma unroll
                    for (int c = 0; c < 8; ++c) d[c] += v[j].x * wreg[j * 4 + 0][c] + v[j].y * wreg[j * 4 + 1][c] + v[j].z * wreg[j * 4 + 2][c] + v[j].w * wreg[j * 4 + 3][c];
                reduce8(d, lane);
#pragma unroll
                for (int c = 0; c < 8; ++c) d[c] *= rstd;
                if (DOTS == 1) {
                    if (lane < 8) { float val = 0.f;
#pragma unroll
                        for (int c = 0; c < 8; ++c) val = (lane == c) ? d[c] : val;
                        val += bias8[lane];
                        if (lane >= 4) val = fminf(val, 0.f) - __logf(1.0f + __expf(-fabsf(val)));
                        ((float*)(F.ws + WS_IFG))[(size_t)row * 8 + lane] = val; }
                } else {
                    int e0 = 0; float l0 = d[0];
#pragma unroll
                    for (int c = 1; c < 8; ++c) if (d[c] > l0) { l0 = d[c]; e0 = c; }
                    int e1 = -1; float l1 = -3.0e38f;
#pragma unroll
                    for (int c = 0; c < 8; ++c) if (c != e0 && d[c] > l1) { l1 = d[c]; e1 = c; }
                    const float g0 = 1.0f / (1.0f + __expf(l1 - l0)), g1 = 1.0f - g0;
                    if (lane < 2) { const int e = lane ? e1 : e0;
                        const unsigned lp = __hip_atomic_fetch_add((LAS unsigned*)&F.lc[LC_LC + e], 1u, __ATOMIC_RELAXED, __HIP_MEMORY_SCOPE_WORKGROUP);
                        sel_e[rl * 2 + lane] = e; sel_lp[rl * 2 + lane] = (int)lp; sel_g[rl * 2 + lane] = lane ? g1 : g0; }
                }
            }
        }
        if (DOTS == 2) {
            __syncthreads();
            if (F.tid < 8) { const unsigned n = F.lc[LC_LC + F.tid]; F.lc[LC_BASE + F.tid] = xb_add(F.ctl + CW_MOE + (moe_j * 8 + F.tid) * 64, n); }
            __syncthreads();
            if (F.tid < 128) { const int e = sel_e[F.tid], pos = (int)F.lc[LC_BASE + e] + sel_lp[F.tid];
                ((int*)(F.ws + WS_TOKE))[e * SEQ + pos] = (rb * 64 + (F.tid >> 1)) | ((F.tid & 1) << 20);
                ((float*)(F.ws + WS_GATEE))[e * SEQ + pos] = sel_g[F.tid]; }
            __syncthreads();
        }
    }
}

DI bf16x8 ld_bf16x8(const bf16* p) { return __builtin_bit_cast(bf16x8, *(const u32x4*)p); }
DI bf16x8 pack_p(const f32x4& a, const f32x4& b) { u32x4 w; w.x = cvt_pk_bf16(a[0], a[1]); w.y = cvt_pk_bf16(a[2], a[3]); w.z = cvt_pk_bf16(b[0], b[1]); w.w = cvt_pk_bf16(b[2], b[3]); return __builtin_bit_cast(bf16x8, w); }
DI bf16x8 lds_frag_perm(ldsp rowp, int koff_bytes) {
    const u32x2 lo = *(const LAS u32x2*)(rowp + koff_bytes), hi = *(const LAS u32x2*)(rowp + koff_bytes + 32);
    u32x4 w; w.x = lo.x; w.y = lo.y; w.z = hi.x; w.w = hi.y; return __builtin_bit_cast(bf16x8, w);
}

DI void memattn_phase(Frame& F, int l) {
    ldsp Ks = F.lds, Vt = F.lds + 69632;
    const bf16* proj = (const bf16*)(F.ws + WS_PROJ); bf16* hx_out = (bf16*)(F.ws + WS_HX);
    const int tid = F.tid, lane = F.lane, fr = lane & 15, fq = lane >> 4;
    for (int unit = F.vcu; unit < 256; unit += F.G) {
        const int hx = unit >> 6, rb = unit & 63;
        const bf16* km = (const bf16*)(F.ws + WS_KM) + (size_t)l * 256 * 512 + hx * 128;
        const bf16* vt = (const bf16*)(F.ws + WS_VMT) + (size_t)l * 512 * 256 + (size_t)hx * 128 * 256;
#pragma unroll
        for (int it = 0; it < 8; ++it) { const int i = tid + it * 512, r = i >> 4, c8 = i & 15; *(LAS u32x4*)(Ks + r * 272 + c8 * 16) = *(const u32x4*)(km + (size_t)r * 512 + c8 * 8); }
#pragma unroll
        for (int it = 0; it < 8; ++it) { const int i = tid + it * 512, r = i >> 5, c8 = i & 31; *(LAS u32x4*)(Vt + r * 528 + c8 * 16) = *(const u32x4*)(vt + (size_t)r * 256 + c8 * 8); }
        __syncthreads();
        for (int pass = 0; pass < 2; ++pass) {
            const int row = rb * 256 + F.wave * 32 + pass * 16 + fr;
            bf16x8 q[4];
#pragma unroll
            for (int ks = 0; ks < 4; ++ks) q[ks] = ld_bf16x8(proj + (size_t)row * PC + C_QX + hx * 128 + ks * 32 + fq * 8);
            f32x4 s[16];
#pragma unroll
            for (int t = 0; t < 16; ++t) { s[t] = (f32x4){0.f, 0.f, 0.f, 0.f};
#pragma unroll
                for (int ks = 0; ks < 4; ++ks) s[t] = MFMA16(*(const LAS bf16x8*)(Ks + (16 * t + fr) * 272 + (ks * 32 + fq * 8) * 2), q[ks], s[t]); }
            float mx = -3.0e38f;
#pragma unroll
            for (int t = 0; t < 16; ++t) mx = fmaxf(mx, fmaxf(fmaxf(s[t][0], s[t][1]), fmaxf(s[t][2], s[t][3])));
            mx = fmaxf(mx, __shfl_xor(mx, 16)); mx = fmaxf(mx, __shfl_xor(mx, 32));
            float sum = 0.f;
#pragma unroll
            for (int t = 0; t < 16; ++t)
#pragma unroll
                for (int r = 0; r < 4; ++r) { s[t][r] = fexp(s[t][r] - mx); sum += s[t][r]; }
            sum += __shfl_xor(sum, 16); sum += __shfl_xor(sum, 32);
            f32x4 o[8];
#pragma unroll
            for (int tv = 0; tv < 8; ++tv) o[tv] = (f32x4){0.f, 0.f, 0.f, 0.f};
#pragma unroll
            for (int k2 = 0; k2 < 8; ++k2) { const bf16x8 pf = pack_p(s[2 * k2], s[2 * k2 + 1]);
#pragma unroll
                for (int tv = 0; tv < 8; ++tv) o[tv] = MFMA16(lds_frag_perm(Vt + (16 * tv + fr) * 528, (32 * k2 + 4 * fq) * 2), pf, o[tv]); }
            const float inv = 1.0f / sum;
#pragma unroll
            for (int tv = 0; tv < 8; ++tv) { u32x2 w; w.x = cvt_pk_bf16(o[tv][0] * inv, o[tv][1] * inv); w.y = cvt_pk_bf16(o[tv][2] * inv, o[tv][3] * inv);
                *(u32x2*)(hx_out + (size_t)row * 512 + hx * 128 + 16 * tv + 4 * fq) = w; }
        }
        __syncthreads();
    }
}

DI void dilated_phase(Frame& F) {
    ldsp Kd = F.lds, Vdt = F.lds + 36864;
    const bf16* proj = (const bf16*)(F.ws + WS_PROJ); bf16* od = (bf16*)(F.ws + WS_OD); float* lse = (float*)(F.ws + WS_LSE);
    const int tid = F.tid, lane = F.lane, fr = lane & 15, fq = lane >> 4, w = F.wave;
    for (int ud = F.vcu; ud < 1536; ud += F.G) {
        const int g = ud >> 9, rem = ud & 511, hh = rem >> 7, blk = rem & 127;
        const int sh = 2 * g, nbs = 7 - sh, r = blk >> nbs, sb = blk & ((1 << nbs) - 1), s0 = sb * 128;
        const int gh = g * 4 + hh, colq = C_QD + gh * 64, colk = C_KD + gh * 64, colv = C_VD + gh * 64;
#pragma unroll
        for (int it = 0; it < 4; ++it) { const int i = tid + it * 512, jl = i >> 3, c8 = i & 7, sp = s0 - 128 + jl; u32x4 v = (u32x4){0u, 0u, 0u, 0u};
            if (sp >= 0) v = *(const u32x4*)(proj + (size_t)((sp << sh) + r) * PC + colk + c8 * 8);
            *(LAS u32x4*)(Kd + jl * 144 + c8 * 16) = v; }
#pragma unroll
        for (int it = 0; it < 4; ++it) { const int i = tid + it * 512, jl = i & 255, c8 = i >> 8, sp = s0 - 128 + jl; u32x4 v = (u32x4){0u, 0u, 0u, 0u};
            if (sp >= 0) v = *(const u32x4*)(proj + (size_t)((sp << sh) + r) * PC + colv + c8 * 8);
            LAS bf16* d = (LAS bf16*)(Vdt + (c8 * 8) * 560 + jl * 2);
            d[0] = (bf16)(v.x & 0xffff); d[280] = (bf16)(v.x >> 16); d[560] = (bf16)(v.y & 0xffff); d[840] = (bf16)(v.y >> 16);
            d[1120] = (bf16)(v.z & 0xffff); d[1400] = (bf16)(v.z >> 16); d[1680] = (bf16)(v.w & 0xffff); d[1960] = (bf16)(v.w >> 16); }
        for (int i = tid; i < 64 * 12; i += 512) { const int rr = i / 12, ww = i % 12; *(LAS unsigned*)(Vdt + rr * 560 + 512 + ww * 4) = 0u; }
        __syncthreads();
        {
            const int qs = s0 + 16 * w + fr; const size_t qtok = (size_t)((qs << sh) + r);
            bf16x8 q[2];
#pragma unroll
            for (int ks = 0; ks < 2; ++ks) q[ks] = ld_bf16x8(proj + qtok * PC + colq + ks * 32 + fq * 8);
            f32x4 s[10];
#pragma unroll
            for (int t = 0; t < 9; ++t) { s[t] = (f32x4){0.f, 0.f, 0.f, 0.f};
#pragma unroll
                for (int ks = 0; ks < 2; ++ks) s[t] = MFMA16(*(const LAS bf16x8*)(Kd + (16 * w + 16 * t + fr) * 144 + (ks * 32 + fq * 8) * 2), q[ks], s[t]); }
            s[9] = (f32x4){0.f, 0.f, 0.f, 0.f};
            float mx = -3.0e38f;
#pragma unroll
            for (int t = 0; t < 9; ++t)
#pragma unroll
                for (int rg = 0; rg < 4; ++rg) { const int jj = 16 * t + 4 * fq + rg; const bool ok = (jj >= fr) && (jj <= 128 + fr) && (s0 - 128 + 16 * w + jj >= 0);
                    s[t][rg] = ok ? s[t][rg] : -1.0e30f; mx = fmaxf(mx, s[t][rg]); }
            mx = fmaxf(mx, __shfl_xor(mx, 16)); mx = fmaxf(mx, __shfl_xor(mx, 32));
            float sum = 0.f;
#pragma unroll
            for (int t = 0; t < 9; ++t)
#pragma unroll
                for (int rg = 0; rg < 4; ++rg) { s[t][rg] = fexp(s[t][rg] - mx); sum += s[t][rg]; }
            sum += __shfl_xor(sum, 16); sum += __shfl_xor(sum, 32);
            f32x4 o[4];
#pragma unroll
            for (int tv = 0; tv < 4; ++tv) o[tv] = (f32x4){0.f, 0.f, 0.f, 0.f};
#pragma unroll
            for (int k2 = 0; k2 < 5; ++k2) { const bf16x8 pf = pack_p(s[2 * k2], s[2 * k2 + 1]);
#pragma unroll
                for (int tv = 0; tv < 4; ++tv) o[tv] = MFMA16(lds_frag_perm(Vdt + (16 * tv + fr) * 560, (16 * w + 32 * k2 + 4 * fq) * 2), pf, o[tv]); }
            const float inv = 1.0f / sum;
#pragma unroll
            for (int tv = 0; tv < 4; ++tv) { u32x2 ww; ww.x = cvt_pk_bf16(o[tv][0] * inv, o[tv][1] * inv); ww.y = cvt_pk_bf16(o[tv][2] * inv, o[tv][3] * inv);
                *(u32x2*)(od + qtok * 768 + gh * 64 + 16 * tv + 4 * fq) = ww; }
            if (fq == 0) lse[qtok * 12 + gh] = mx + __logf(sum);
        }
        __syncthreads();
    }
}

DI void gate_scan(const float* ifg, int t0, int h, int lane, float& a0, float& a1, float& cum0, float& cum1, float& total, float& maxa) {
    const float* p0 = ifg + (size_t)(t0 + 2 * lane) * 8; const float i0 = p0[h], lf0 = p0[4 + h], i1 = p0[8 + h], lf1 = p0[12 + h];
    const float s = lf0 + lf1; float incl = s;
#pragma unroll
    for (int off = 1; off < 64; off <<= 1) { const float t = __shfl_up(incl, off); if (lane >= off) incl += t; }
    const float excl = incl - s; cum0 = excl + lf0; cum1 = incl; a0 = i0 - cum0; a1 = i1 - cum1;
    total = __shfl(incl, 63); maxa = wave_max(fmaxf(a0, a1));
}
DI void mlstm_delta_phase(Frame& F, int l) {
    ldsp KT = F.lds, VT = F.lds + 34816; LAS float* w_s = (LAS float*)(F.lds + 69632);
    const bf16* proj = (const bf16*)(F.ws + WS_PROJ); bf16* qkc = (bf16*)(F.ws + WS_QKC); const float* ifg = (const float*)(F.ws + WS_IFG);
    const float* convw = F.ka->in[I_CONV] + (size_t)l * 4 * 1024;
    const int tid = F.tid, lane = F.lane, fr = lane & 15, fq = lane >> 4, w = F.wave;
    for (int unit = F.vcu; unit < 512; unit += F.G) {
        const int c = unit >> 2, h = unit & 3, t0 = c * 128;
        if (w == 0) { float a0, a1, c0, c1, total, maxa; gate_scan(ifg, t0, h, lane, a0, a1, c0, c1, total, maxa);
            w_s[2 * lane] = fexp(a0 - maxa); w_s[2 * lane + 1] = fexp(a1 - maxa);
            if (lane == 0) { float* sm = (float*)(F.ws + WS_SUMM) + (c * 4 + h) * 2; sm[0] = total; sm[1] = maxa; } }
        { const int cs = tid & 15, rg = tid >> 4, l0 = rg * 4;
#pragma unroll
          for (int which = 0; which < 2; ++which) { const int ch = which * 512 + h * 128 + cs * 8;
            float cw[4][8];
#pragma unroll
            for (int j = 0; j < 4; ++j) { const f32x4 a = *(const f32x4*)(convw + j * 1024 + ch), b = *(const f32x4*)(convw + j * 1024 + ch + 4);
                cw[j][0] = a.x; cw[j][1] = a.y; cw[j][2] = a.z; cw[j][3] = a.w; cw[j][4] = b.x; cw[j][5] = b.y; cw[j][6] = b.z; cw[j][7] = b.w; }
            u32x4 xr[7];
#pragma unroll
            for (int i = 0; i < 7; ++i) { const int row = t0 + l0 - 3 + i; xr[i] = (u32x4){0u, 0u, 0u, 0u}; if (row >= 0) xr[i] = *(const u32x4*)(proj + (size_t)row * PC + ch); }
#pragma unroll
            for (int o = 0; o < 4; ++o) { float acc[8];
#pragma unroll
                for (int e = 0; e < 8; ++e) acc[e] = 0.f;
#pragma unroll
                for (int j = 0; j < 4; ++j) { const u32x4 x = xr[o + j];
                    acc[0] += cw[j][0] * bflo(x.x); acc[1] += cw[j][1] * bfhi(x.x); acc[2] += cw[j][2] * bflo(x.y); acc[3] += cw[j][3] * bfhi(x.y);
                    acc[4] += cw[j][4] * bflo(x.z); acc[5] += cw[j][5] * bfhi(x.z); acc[6] += cw[j][6] * bflo(x.w); acc[7] += cw[j][7] * bfhi(x.w); }
#pragma unroll
                for (int e = 0; e < 8; ++e) { acc[e] = siluf_(acc[e]); if (which) acc[e] *= RS128; }
                u32x4 ww; ww.x = cvt_pk_bf16(acc[0], acc[1]); ww.y = cvt_pk_bf16(acc[2], acc[3]); ww.z = cvt_pk_bf16(acc[4], acc[5]); ww.w = cvt_pk_bf16(acc[6], acc[7]);
                *(u32x4*)(qkc + (size_t)(t0 + l0 + o) * 1024 + ch) = ww;
                if (which) { LAS bf16* d = (LAS bf16*)(KT + (cs * 8) * 272 + (l0 + o) * 2);
                    d[0] = (bf16)(ww.x & 0xffff); d[136] = (bf16)(ww.x >> 16); d[272] = (bf16)(ww.y & 0xffff); d[408] = (bf16)(ww.y >> 16);
                    d[544] = (bf16)(ww.z & 0xffff); d[680] = (bf16)(ww.z >> 16); d[816] = (bf16)(ww.w & 0xffff); d[952] = (bf16)(ww.w >> 16); } } } }
        __syncthreads();
#pragma unroll
        for (int it = 0; it < 4; ++it) { const int i = tid + it * 512, lr = i & 127, c8 = i >> 7; const u32x4 v = *(const u32x4*)(proj + (size_t)(t0 + lr) * PC + C_VM + h * 128 + c8 * 8); const float ww = w_s[lr];
            const unsigned p0 = cvt_pk_bf16(bflo(v.x) * ww, bfhi(v.x) * ww), p1 = cvt_pk_bf16(bflo(v.y) * ww, bfhi(v.y) * ww), p2 = cvt_pk_bf16(bflo(v.z) * ww, bfhi(v.z) * ww), p3 = cvt_pk_bf16(bflo(v.w) * ww, bfhi(v.w) * ww);
            LAS bf16* d = (LAS bf16*)(VT + (c8 * 8) * 272 + lr * 2);
            d[0] = (bf16)(p0 & 0xffff); d[136] = (bf16)(p0 >> 16); d[272] = (bf16)(p1 & 0xffff); d[408] = (bf16)(p1 >> 16);
            d[544] = (bf16)(p2 & 0xffff); d[680] = (bf16)(p2 >> 16); d[816] = (bf16)(p3 & 0xffff); d[952] = (bf16)(p3 >> 16); }
        __syncthreads();
        { f32x4 acc[8];
#pragma unroll
          for (int t = 0; t < 8; ++t) { acc[t] = (f32x4){0.f, 0.f, 0.f, 0.f};
#pragma unroll
            for (int ks = 0; ks < 4; ++ks) acc[t] = MFMA16(*(const LAS bf16x8*)(KT + (16 * t + fr) * 272 + (ks * 32 + fq * 8) * 2), *(const LAS bf16x8*)(VT + (16 * w + fr) * 272 + (ks * 32 + fq * 8) * 2), acc[t]); }
          float* dl = (float*)(F.ws + WS_DELTA) + ((size_t)(c * 4 + h) * 128 + 16 * w + fr) * 128 + 4 * fq;
#pragma unroll
          for (int t = 0; t < 8; ++t) *(f32x4*)(dl + 16 * t) = acc[t];
        }
        if (tid < 128) { float s = 0.f;
#pragma unroll 4
            for (int j = 0; j < 16; ++j) { const u32x4 k8 = *(const LAS u32x4*)(KT + tid * 272 + j * 16); const LAS float* wp = w_s + j * 8;
                s += bflo(k8.x) * wp[0] + bfhi(k8.x) * wp[1] + bflo(k8.y) * wp[2] + bfhi(k8.y) * wp[3] + bflo(k8.z) * wp[4] + bfhi(k8.z) * wp[5] + bflo(k8.w) * wp[6] + bfhi(k8.w) * wp[7]; }
            ((float*)(F.ws + WS_ND))[(c * 4 + h) * 128 + tid] = s; }
        __syncthreads();
    }
}
DI void scan_phase(Frame& F) {
    LAS float* dec = (LAS float*)F.lds; LAS float* scl = dec + 512;
    const int tid = F.tid, lane = F.lane, w = F.wave;
    if (w < 4) { const int h = w; const float* sm = (const float*)(F.ws + WS_SUMM);
        const float tot0 = sm[((2 * lane) * 4 + h) * 2], mxa0 = sm[((2 * lane) * 4 + h) * 2 + 1], tot1 = sm[((2 * lane + 1) * 4 + h) * 2], mxa1 = sm[((2 * lane + 1) * 4 + h) * 2 + 1];
        const float s = tot0 + tot1; float incl = s;
#pragma unroll
        for (int off = 1; off < 64; off <<= 1) { const float t = __shfl_up(incl, off); if (lane >= off) incl += t; }
        const float excl = incl - s, T0 = excl + tot0, T1 = incl;
        const float b0 = mxa0 - excl, b1 = mxa1 - T0; float inclm = fmaxf(b0, b1);
#pragma unroll
        for (int off = 1; off < 64; off <<= 1) { const float t = __shfl_up(inclm, off); if (lane >= off) inclm = fmaxf(inclm, t); }
        float exclm = __shfl_up(inclm, 1); if (lane == 0) exclm = -1.0e30f;
        const float m0 = T0 + fmaxf(exclm, b0), m1 = T1 + inclm;
        float mprev = __shfl_up(m1, 1); if (lane == 0) mprev = -1.0e30f;
        const float A0 = fmaxf(mprev, mxa0), A1 = fmaxf(m0, mxa1);
        dec[h * 128 + 2 * lane] = fexp(mprev - A0); scl[h * 128 + 2 * lane] = fexp(mxa0 - A0);
        dec[h * 128 + 2 * lane + 1] = fexp(m0 - A1); scl[h * 128 + 2 * lane + 1] = fexp(mxa1 - A1);
        if (F.vcu == 0) { float* mst = (float*)(F.ws + WS_MST); mst[(2 * lane) * 4 + h] = mprev; mst[(2 * lane + 1) * 4 + h] = m0; }
    }
    __syncthreads();
    if (w < 4) {
        const float* delta = (const float*)(F.ws + WS_DELTA); bf16* cst = (bf16*)(F.ws + WS_CST);
        const float* nd = (const float*)(F.ws + WS_ND); float* nst = (float*)(F.ws + WS_NST);
        for (int e = F.vcu * 256 + tid; e < 65536 + 512; e += F.G * 256) {
            if (e < 65536) { const int h = e >> 14, vd = e & 16383; float C = 0.f;
                for (int c0 = 0; c0 < 128; c0 += 16) { float dv[16];
#pragma unroll
                    for (int j = 0; j < 16; ++j) dv[j] = delta[(size_t)((c0 + j) * 4 + h) * 16384 + vd];
#pragma unroll
                    for (int j = 0; j < 16; ++j) { cst[(size_t)((c0 + j) * 4 + h) * 16384 + vd] = (bf16)(cvt_pk_bf16(C, 0.f) & 0xffff); C = dec[h * 128 + c0 + j] * C + scl[h * 128 + c0 + j] * dv[j]; } }
            } else { const int idx = e - 65536, h = idx >> 7, d = idx & 127; float n = 0.f;
                for (int c = 0; c < 128; ++c) { nst[(c * 4 + h) * 128 + d] = n; n = dec[h * 128 + c] * n + scl[h * 128 + c] * nd[(c * 4 + h) * 128 + d]; } }
        }
    } else {
        const bf16* od = (const bf16*)(F.ws + WS_OD); const float* lse = (const float*)(F.ws + WS_LSE); bf16* hd = (bf16*)(F.ws + WS_HD);
        const int hh = lane >> 4, dv4 = (lane & 15) * 4;
        for (int tok = F.vcu * 4 + (w - 4); tok < SEQ; tok += F.G * 4) {
            const float l0 = lse[(size_t)tok * 12 + hh], l1 = lse[(size_t)tok * 12 + 4 + hh], l2 = lse[(size_t)tok * 12 + 8 + hh];
            const float mx = fmaxf(l0, fmaxf(l1, l2)); float w0 = fexp(l0 - mx), w1 = fexp(l1 - mx), w2 = fexp(l2 - mx); const float inv = 1.0f / (w0 + w1 + w2); w0 *= inv; w1 *= inv; w2 *= inv;
            const u32x2 o0 = *(const u32x2*)(od + (size_t)tok * 768 + hh * 64 + dv4), o1 = *(const u32x2*)(od + (size_t)tok * 768 + 256 + hh * 64 + dv4), o2 = *(const u32x2*)(od + (size_t)tok * 768 + 512 + hh * 64 + dv4);
            u32x2 r; r.x = cvt_pk_bf16(w0 * bflo(o0.x) + w1 * bflo(o1.x) + w2 * bflo(o2.x), w0 * bfhi(o0.x) + w1 * bfhi(o1.x) + w2 * bfhi(o2.x));
            r.y = cvt_pk_bf16(w0 * bflo(o0.y) + w1 * bflo(o1.y) + w2 * bflo(o2.y), w0 * bfhi(o0.y) + w1 * bfhi(o1.y) + w2 * bfhi(o2.y));
            *(u32x2*)(hd + (size_t)tok * 256 + hh * 64 + dv4) = r;
        }
    }
    __syncthreads();
}
DI void mlstm_out_phase(Frame& F, int l) {
    ldsp Ks = F.lds, Vt = F.lds + 34816, Cs = F.lds + 73984;
    LAS float* a_s = (LAS float*)(F.lds + 113152); LAS float* A_s = a_s + 128; LAS float* wi_s = A_s + 128; LAS float* emr_s = wi_s + 128;
    const bf16* proj = (const bf16*)(F.ws + WS_PROJ); const bf16* qkc = (const bf16*)(F.ws + WS_QKC); const float* ifg = (const float*)(F.ws + WS_IFG);
    const bf16* cst = (const bf16*)(F.ws + WS_CST); const float* nst = (const float*)(F.ws + WS_NST); bf16* hm = (bf16*)(F.ws + WS_HM);
    const float* gain = F.ka->in[I_MLSTM_NORM] + (size_t)l * 512;
    const int tid = F.tid, lane = F.lane, fr = lane & 15, fq = lane >> 4, w = F.wave;
    for (int unit = F.vcu; unit < 512; unit += F.G) {
        const int c = unit >> 2, h = unit & 3, t0 = c * 128;
        if (w == 0) { float a0, a1, c0, c1, total, maxa; gate_scan(ifg, t0, h, lane, a0, a1, c0, c1, total, maxa);
            const float m_in = ((const float*)(F.ws + WS_MST))[c * 4 + h];
            float inclm = fmaxf(a0, a1);
#pragma unroll
            for (int off = 1; off < 64; off <<= 1) { const float t = __shfl_up(inclm, off); if (lane >= off) inclm = fmaxf(inclm, t); }
            float exclm = __shfl_up(inclm, 1); if (lane == 0) exclm = -3.0e38f;
            const float A0 = fmaxf(fmaxf(exclm, a0), m_in), A1 = fmaxf(inclm, m_in);
            a_s[2 * lane] = a0; a_s[2 * lane + 1] = a1; A_s[2 * lane] = A0; A_s[2 * lane + 1] = A1;
            wi_s[2 * lane] = fexp(m_in - A0); wi_s[2 * lane + 1] = fexp(m_in - A1);
            emr_s[2 * lane] = fexp(-(c0 + A0)); emr_s[2 * lane + 1] = fexp(-(c1 + A1)); }
#pragma unroll
        for (int it = 0; it < 4; ++it) { const int i = tid + it * 512, j = i >> 4, c8 = i & 15; *(LAS u32x4*)(Ks + j * 272 + c8 * 16) = *(const u32x4*)(qkc + (size_t)(t0 + j) * 1024 + 512 + h * 128 + c8 * 8); }
#pragma unroll
        for (int it = 0; it < 4; ++it) { const int i = tid + it * 512, j = i & 127, c8 = i >> 7; const u32x4 v = *(const u32x4*)(proj + (size_t)(t0 + j) * PC + C_VM + h * 128 + c8 * 8);
            LAS bf16* d = (LAS bf16*)(Vt + (c8 * 8) * 272 + j * 2);
            d[0] = (bf16)(v.x & 0xffff); d[136] = (bf16)(v.x >> 16); d[272] = (bf16)(v.y & 0xffff); d[408] = (bf16)(v.y >> 16);
            d[544] = (bf16)(v.z & 0xffff); d[680] = (bf16)(v.z >> 16); d[816] = (bf16)(v.w & 0xffff); d[952] = (bf16)(v.w >> 16); }
#pragma unroll
        for (int it = 0; it < 4; ++it) { const int i = tid + it * 512, v = i >> 4, c8 = i & 15; *(LAS u32x4*)(Cs + v * 272 + c8 * 16) = *(const u32x4*)(cst + ((size_t)(c * 4 + h) * 128 + v) * 128 + c8 * 8); }
        if (tid < 128) { *(LAS bf16*)(Vt + 128 * 272 + tid * 2) = (bf16)0x3F80; *(LAS bf16*)(Cs + 128 * 272 + tid * 2) = (bf16)(cvt_pk_bf16(nst[(c * 4 + h) * 128 + tid], 0.f) & 0xffff); }
        for (int i = tid; i < 15 * 64; i += 512) { const int rr = 129 + i / 64, ww = i % 64; *(LAS unsigned*)(Vt + rr * 272 + ww * 4) = 0u; *(LAS unsigned*)(Cs + rr * 272 + ww * 4) = 0u; }
        __syncthreads();
        {
            const int lrow = 16 * w + fr; const size_t trow = (size_t)(t0 + lrow);
            bf16x8 q[4];
#pragma unroll
            for (int ks = 0; ks < 4; ++ks) q[ks] = ld_bf16x8(qkc + trow * 1024 + h * 128 + ks * 32 + fq * 8);
            f32x4 s[8];
#pragma unroll
            for (int t = 0; t < 8; ++t) { s[t] = (f32x4){0.f, 0.f, 0.f, 0.f};
                if (t <= w) {
#pragma unroll
                    for (int ks = 0; ks < 4; ++ks) s[t] = MFMA16(*(const LAS bf16x8*)(Ks + (16 * t + fr) * 272 + (ks * 32 + fq * 8) * 2), q[ks], s[t]);
                    const f32x4 a4 = *(const LAS f32x4*)(a_s + 16 * t + 4 * fq); const float Al = A_s[lrow];
#pragma unroll
                    for (int rg = 0; rg < 4; ++rg) { const int j = 16 * t + 4 * fq + rg; s[t][rg] = (j <= lrow) ? s[t][rg] * fexp(a4[rg] - Al) : 0.f; } } }
            const float wi = wi_s[lrow];
            bf16x8 qs[4];
#pragma unroll
            for (int ks = 0; ks < 4; ++ks) { const u32x4 x = __builtin_bit_cast(u32x4, q[ks]); u32x4 y;
                y.x = cvt_pk_bf16(bflo(x.x) * wi, bfhi(x.x) * wi); y.y = cvt_pk_bf16(bflo(x.y) * wi, bfhi(x.y) * wi); y.z = cvt_pk_bf16(bflo(x.z) * wi, bfhi(x.z) * wi); y.w = cvt_pk_bf16(bflo(x.w) * wi, bfhi(x.w) * wi);
                qs[ks] = __builtin_bit_cast(bf16x8, y); }
            f32x4 o[9];
#pragma unroll
            for (int tv = 0; tv < 9; ++tv) { o[tv] = (f32x4){0.f, 0.f, 0.f, 0.f};
#pragma unroll
                for (int ks = 0; ks < 4; ++ks) o[tv] = MFMA16(*(const LAS bf16x8*)(Cs + (16 * tv + fr) * 272 + (ks * 32 + fq * 8) * 2), qs[ks], o[tv]); }
#pragma unroll
            for (int k2 = 0; k2 < 4; ++k2) if (2 * k2 <= w) { const bf16x8 pf = pack_p(s[2 * k2], s[2 * k2 + 1]);
#pragma unroll
                for (int tv = 0; tv < 9; ++tv) o[tv] = MFMA16(lds_frag_perm(Vt + (16 * tv + fr) * 272, (32 * k2 + 4 * fq) * 2), pf, o[tv]); }
            const float den = __shfl(o[8][0], fr);
            const float inv = 1.0f / fmaxf(fabsf(den), emr_s[lrow]);
            float sm = 0.f;
#pragma unroll
            for (int tv = 0; tv < 8; ++tv) { o[tv] = o[tv] * inv; sm += (o[tv][0] + o[tv][1]) + (o[tv][2] + o[tv][3]); }
            sm += __shfl_xor(sm, 16); sm += __shfl_xor(sm, 32);
            const float mu = sm * (1.f / 128.f); float vs = 0.f;
#pragma unroll
            for (int tv = 0; tv < 8; ++tv) { o[tv] = o[tv] - mu; vs += (o[tv][0] * o[tv][0] + o[tv][1] * o[tv][1]) + (o[tv][2] * o[tv][2] + o[tv][3] * o[tv][3]); }
            vs += __shfl_xor(vs, 16); vs += __shfl_xor(vs, 32);
            const float rstd = 1.0f / sqrtf(vs * (1.f / 128.f) + EPS);
#pragma unroll
            for (int tv = 0; tv < 8; ++tv) { const int col = h * 128 + 16 * tv + 4 * fq; const f32x4 gn = *(const f32x4*)(gain + col); const u32x2 og = *(const u32x2*)(proj + trow * PC + C_OM + col);
                const float r0 = o[tv][0] * rstd * gn.x * sigmoidf_(bflo(og.x)), r1 = o[tv][1] * rstd * gn.y * sigmoidf_(bfhi(og.x)), r2 = o[tv][2] * rstd * gn.z * sigmoidf_(bflo(og.y)), r3 = o[tv][3] * rstd * gn.w * sigmoidf_(bfhi(og.y));
                u32x2 ww; ww.x = cvt_pk_bf16(r0, r1); ww.y = cvt_pk_bf16(r2, r3); *(u32x2*)(hm + trow * 512 + col) = ww; }
        }
        __syncthreads();
    }
}

#define PH() refresh(F); unsigned char* const ws = F.ws; (void)ws
#define P_XRES ((float*)(ws + WS_XRES))
#define P_U ((bf16*)(ws + WS_U))
#define P_PROJ ((bf16*)(ws + WS_PROJ))
#define P_MERGED ((bf16*)(ws + WS_MERGED))
#define GRID_BAR() do { refresh(F); XcdBarrier bar_; bar_.bar = F.ctl + CW_BAR; bar_.x = xb_xcc_id(); bar_.st = F.lc + LC_BAR; xcd_barrier(bar_); } while (0)
template <int l> DI void layer_body(Frame& F) {
    const int G = F.G, cid = (int)blockIdx.x;
        if (l > 0) {
            PH();
            const float* wsm = F.ka->in[I_W_IN] + (size_t)l * DM * IN_COLS + 2048;
            if (l == 2) norm_phase<true, true, 1, false>(F, P_XRES, P_XRES, F.ka->in[I_NORM_MIX] + l * DM, P_U, nullptr, wsm, IN_COLS, F.ka->in[I_BIF] + l * 8, 0);
            else norm_phase<false, false, 1, false>(F, P_XRES, nullptr, F.ka->in[I_NORM_MIX] + l * DM, P_U, nullptr, wsm, IN_COLS, F.ka->in[I_BIF] + l * 8, 0);
            GRID_BAR();
        }
        { PH(); pg8::SchedDense S{(const char*)P_U, (const char*)(ws + WS_WIN + (size_t)l * SZ_WIN), SEQ / 256, PC / 256, G, cid, DM, DM};
          pg8::EpiProj E{P_PROJ, PC, C_GT / 256};
          pg8::gemm_phase<pg8::EpiProj, pg8::SchedDense, true>(F.lds, DM, DM, DM, S, E); }
        if (l == 0) { PH(); pg8::SchedKV S{(const char*)(ws + WS_MEMN), (const char*)(ws + WS_WKV), G, cid, 192 % G};
          pg8::EpiKV E{(bf16*)(ws + WS_KM), (bf16*)(ws + WS_VMT)};
          pg8::gemm_phase<pg8::EpiKV, pg8::SchedKV, false>(F.lds, DM, DM, DM, S, E); }
        GRID_BAR();
        { PH(); memattn_phase(F, l); }
        { PH(); dilated_phase(F); }
        { PH(); mlstm_delta_phase(F, l); }
        GRID_BAR();
        { PH(); scan_phase(F); }
        GRID_BAR();
        { PH(); mlstm_out_phase(F, l); }
        GRID_BAR();
        { PH(); pg8::SchedDense S{(const char*)(ws + WS_HM), (const char*)(ws + WS_WBRM + (size_t)l * DM * 512 * 2), SEQ / 256, 4, G, cid, 512, 512};
          pg8::EpiBranch<true> E{P_MERGED, P_PROJ, PC, C_GT};
          pg8::gemm_phase<pg8::EpiBranch<true>, pg8::SchedDense, false>(F.lds, 512, 512, 512, S, E); }
        { PH(); pg8::SchedDense S{(const char*)(ws + WS_HD), (const char*)(ws + WS_WBRD + (size_t)l * DM * 256 * 2), SEQ / 256, 4, G, cid, 256, 256};
          pg8::EpiBranch<false> E{P_MERGED, P_PROJ, PC, C_GT + 1024};
          pg8::gemm_phase<pg8::EpiBranch<false>, pg8::SchedDense, false>(F.lds, 256, 256, 256, S, E); }
        { PH(); pg8::SchedDense S{(const char*)(ws + WS_HX), (const char*)(ws + WS_WBRX + (size_t)l * DM * 512 * 2), SEQ / 256, 4, G, cid, 512, 512};
          pg8::EpiBranch<false> E{P_MERGED, P_PROJ, PC, C_GT + 2048};
          pg8::gemm_phase<pg8::EpiBranch<false>, pg8::SchedDense, false>(F.lds, 512, 512, 512, S, E); }
        GRID_BAR();
        { PH(); pg8::SchedDense S{(const char*)P_MERGED, (const char*)(ws + WS_WOUT + (size_t)l * DM * DM * 2), SEQ / 256, 4, G, cid, DM, DM};
          pg8::EpiResF32 E{(l == 0) ? F.ka->in[I_X] : (const float*)P_XRES, P_XRES};
          pg8::gemm_phase<pg8::EpiResF32, pg8::SchedDense, false>(F.lds, DM, DM, DM, S, E); }
        GRID_BAR();
        const int j = l >> 1;
        if (l & 1) {
            { PH(); norm_phase<false, false, 2, false>(F, P_XRES, nullptr, F.ka->in[I_NORM_FFN] + l * DM, P_U, nullptr, F.ka->in[I_ROUTER] + (size_t)j * DM * 8, 8, nullptr, j); }
            GRID_BAR();
            { PH();
              if (F.tid < 8) F.lc[LC_CNT + F.tid] = xb_ld(F.ctl + CW_MOE + (j * 8 + F.tid) * 64);
              __syncthreads();
              if (F.tid == 0) { unsigned t = 0;
                  for (int e = 0; e < 8; ++e) { F.lc[LC_TB + e] = t; t += (F.lc[LC_CNT + e] + 255u) >> 8; }
                  F.lc[LC_TB + 8] = t; }
              __syncthreads();
              pg8::SchedMoe<true> S{(const char*)P_U, (const char*)(ws + WS_MGU + (size_t)j * 8 * SZ_MGU_E), SZ_MGU_E, (const int*)(ws + WS_TOKE), F.lc, 2 * DFE / 256, G, cid, DM, DM};
              pg8::EpiSwiglu<true> E{P_PROJ, DFE, (const float*)(ws + WS_GATEE), F.lc};
              pg8::gemm_phase<pg8::EpiSwiglu<true>, pg8::SchedMoe<true>, true>(F.lds, DM, DM, DM, S, E); }
            GRID_BAR();
            { PH(); pg8::SchedMoe<false> S{(const char*)P_PROJ, (const char*)(ws + WS_MD + (size_t)j * 8 * SZ_MD_E), SZ_MD_E, (const int*)(ws + WS_TOKE), F.lc, 4, G, cid, DFE, DFE};
              pg8::EpiMoeDown E{(bf16*)(ws + WS_YS), (const int*)(ws + WS_TOKE), F.lc};
              pg8::gemm_phase<pg8::EpiMoeDown, pg8::SchedMoe<false>, true>(F.lds, DFE, DFE, DFE, S, E); }
            GRID_BAR();
        } else {
            { PH(); norm_phase<false, false, 0, false>(F, P_XRES, nullptr, F.ka->in[I_NORM_FFN] + l * DM, P_U, nullptr, nullptr, 0, nullptr, 0); }
            GRID_BAR();
            { PH(); pg8::SchedDense S{(const char*)P_U, (const char*)(ws + WS_FGU + (size_t)j * SZ_FGU), SEQ / 256, 2 * DFF / 256, G, cid, DM, DM};
              pg8::EpiSwiglu<false> E{P_PROJ, DFF, nullptr, F.lc};
              pg8::gemm_phase<pg8::EpiSwiglu<false>, pg8::SchedDense, true>(F.lds, DM, DM, DM, S, E); }
            GRID_BAR();
            { PH(); pg8::SchedDense S{(const char*)P_PROJ, (const char*)(ws + WS_FD + (size_t)j * SZ_FD), SEQ / 256, 4, G, cid, DFF, DFF};
              pg8::EpiResF32 E{P_XRES, P_XRES};
              pg8::gemm_phase<pg8::EpiResF32, pg8::SchedDense, false>(F.lds, DFF, DFF, DFF, S, E); }
            GRID_BAR();
        }
}
__global__ void __launch_bounds__(512, 2) fwd_kernel(Args args_unused) {
    extern __shared__ __attribute__((aligned(16))) unsigned char lds_raw[];
    Frame F;
    F.lds = (ldsp)lds_raw; F.lc = (volatile LAS unsigned*)(F.lds + LDSCTL_OFF);
    F.G = gridDim.x; { const int bx = blockIdx.x; F.vcu = (F.G % 8 == 0) ? (bx % 8) * (F.G / 8) + bx / 8 : bx; }
    refresh(F);
    for (int u = F.tid; u < (LDS_BYTES - LDSCTL_OFF) / 4; u += 512) F.lc[u] = 0u;
    __syncthreads();
    (void)xcd_barrier_post(F.ctl + CW_BAR, F.lc + LC_BAR);
    const int G = F.G, cid = (int)blockIdx.x;

    { PH(); prologue_convert(F); }
    { PH(); norm_phase<false, false, 1, false>(F, F.ka->in[I_X], nullptr, F.ka->in[I_NORM_MIX], P_U, nullptr, F.ka->in[I_W_IN] + 2048, IN_COLS, F.ka->in[I_BIF], 0); }
    GRID_BAR();

    layer_body<0>(F); layer_body<1>(F); layer_body<2>(F); layer_body<3>(F);
    { PH(); norm_phase<true, false, 0, true>(F, P_XRES, nullptr, F.ka->in[I_NORM_FINAL], nullptr, F.ka->out, nullptr, 0, nullptr, 0); }
}

extern "C" void kernel_launch(void* const* d_in, const int* in_sizes, int n_in, void* d_out, int out_size, void* d_ws, size_t ws_size, hipStream_t stream) {
    static int grid = 0;
    if (grid == 0) {
        if (n_in != 22 || out_size != SEQ * DM || ws_size < WS_END) { fprintf(stderr, "kernel_launch: unexpected problem (n_in %d, out %d, ws %zu < %zu)\n", n_in, out_size, ws_size, (size_t)WS_END); grid = -1; return; }
        int dev = 0, cus = 0;
        if (hipGetDevice(&dev) != hipSuccess || hipDeviceGetAttribute(&cus, hipDeviceAttributeMultiprocessorCount, dev) != hipSuccess) { grid = -1; return; }
        if (hipFuncSetAttribute((const void*)fwd_kernel, hipFuncAttributeMaxDynamicSharedMemorySize, LDS_BYTES) != hipSuccess) { fprintf(stderr, "kernel_launch: hipFuncSetAttribute failed\n"); grid = -1; return; }
        int per_cu = 0;
        if (hipOccupancyMaxActiveBlocksPerMultiprocessor(&per_cu, (const void*)fwd_kernel, 512, LDS_BYTES) != hipSuccess || per_cu < 1) { fprintf(stderr, "kernel_launch: occupancy query says %d\n", per_cu); }
        (void)hipGetLastError();
        grid = cus;
    }
    if (grid < 0) return;
    (void)hipMemsetAsync((char*)d_ws + WS_CTL, 0, CTL_ZERO_BYTES, stream);
    Args a{};
    for (int i = 0; i < 22; ++i) a.in[i] = (const float*)d_in[i];
    a.out = (float*)d_out; a.ws = (unsigned char*)d_ws;
    hipLaunchKernelGGL(fwd_kernel, dim3(grid), dim3(512), LDS_BYTES, stream, a);
}
```

```cpp
#include <hip/hip_runtime.h>
#include <cstdio>
#include <cstdint>

#define LAS __attribute__((address_space(3)))
#define GAS __attribute__((address_space(1)))
#define DI __device__ __forceinline__
typedef unsigned short bf16;
typedef short bf16x8 __attribute__((ext_vector_type(8)));
typedef short bf16x4 __attribute__((ext_vector_type(4)));
typedef float f32x4 __attribute__((ext_vector_type(4)));
typedef float f32x2 __attribute__((ext_vector_type(2)));
typedef unsigned u32x4 __attribute__((ext_vector_type(4)));
typedef unsigned u32x2 __attribute__((ext_vector_type(2)));
typedef LAS unsigned char* ldsp;

constexpr int SEQ = 16384, DM = 1024, DEPTH = 4, NMEM = 256;
constexpr int IN_COLS = 7944, PC = 7936;
constexpr int C_QM = 0, C_KM = 512, C_VM = 1024, C_OM = 1536, C_QD = 2048, C_KD = 2816, C_VD = 3584, C_QX = 4352, C_GT = 4864;
constexpr int DFF = 2816, DFE = 3584, NEXP = 8;
constexpr float EPS = 1e-6f;
constexpr float RS128 = 0.08838834764831845f;
constexpr float LOG2E = 1.4426950408889634f;

constexpr size_t MiB = 1u << 20;
constexpr size_t WS_CTL = 0, CTL_ZERO_BYTES = 1 * MiB;
constexpr size_t WS_IFG = 1 * MiB;
constexpr size_t WS_LSE = 2 * MiB;
constexpr size_t WS_SUMM = 3 * MiB;
constexpr size_t WS_MST = 3 * MiB + 65536;
constexpr size_t WS_ND = 3 * MiB + 262144;
constexpr size_t WS_NST = 3 * MiB + 524288;
constexpr size_t WS_TOKE = 4 * MiB;
constexpr size_t WS_GATEE = 4 * MiB + 524288;
constexpr size_t WS_MEMN = 6 * MiB;
constexpr size_t WS_KM = 8 * MiB;
constexpr size_t WS_VMT = 9 * MiB;
constexpr size_t WS_WIN = 16 * MiB;
constexpr size_t SZ_WIN = (size_t)8192 * DM;
constexpr size_t WS_WKV = 80 * MiB;
constexpr size_t WS_WBRM = 88 * MiB;
constexpr size_t WS_WBRD = 92 * MiB;
constexpr size_t WS_WBRX = 94 * MiB;
constexpr size_t WS_WOUT = 98 * MiB;
constexpr size_t WS_FGU = 106 * MiB;
constexpr size_t SZ_FGU = (size_t)2 * DFF * DM * 2;
constexpr size_t WS_FD = 128 * MiB;
constexpr size_t SZ_FD = (size_t)DM * DFF * 2;
constexpr size_t WS_MGU = 139 * MiB;
constexpr size_t SZ_MGU_E = (size_t)2 * DFE * DM;
constexpr size_t WS_MD = 363 * MiB;
constexpr size_t SZ_MD_E = (size_t)DM * DFE;
constexpr size_t WS_XRES = 475 * MiB;
constexpr size_t WS_U = 539 * MiB;
constexpr size_t WS_PROJ = 571 * MiB;
constexpr size_t WS_MQ = WS_PROJ;
constexpr size_t WS_DQ = WS_PROJ + 64 * MiB;
constexpr size_t WS_XQ = WS_PROJ + 136 * MiB;
constexpr size_t WS_GT = WS_PROJ + 152 * MiB;
constexpr size_t WS_WINB = WS_MGU + 112 * MiB;
constexpr size_t WS_U8 = WS_MD + 56 * MiB;
constexpr size_t WS_U8S = WS_PROJ + 120 * MiB;
constexpr size_t WS_QKC = 819 * MiB;
constexpr size_t WS_DELTA = 851 * MiB;
constexpr size_t WS_YS = 819 * MiB;
constexpr size_t WS_CST = 883 * MiB;
constexpr size_t WS_OD = 899 * MiB;
constexpr size_t WS_MERGED = 883 * MiB;
constexpr size_t WS_HCAT = 923 * MiB;
constexpr int HCW = 1280;
constexpr size_t WS_HM = 923 * MiB;
constexpr size_t WS_HD = 939 * MiB;
constexpr size_t WS_HX = 947 * MiB;
constexpr size_t WS_END = 963 * MiB;
static_assert(WS_WIN + 4 * SZ_WIN <= WS_WKV && WS_FGU + 2 * SZ_FGU <= WS_FD && WS_FD + 2 * SZ_FD <= WS_MGU && WS_MGU + 16 * SZ_MGU_E <= WS_MD && WS_MD + 16 * SZ_MD_E <= WS_XRES, "weights map");
static_assert(WS_PROJ + (size_t)SEQ * PC * 2 <= WS_QKC && (size_t)34816 * DFE * 2 <= (size_t)SEQ * PC * 2, "proj map");
constexpr int CW_BAR = 4096;
constexpr int CW_RS = 65536;
constexpr float RS_FIX = 16777216.0f, RS_UNFIX = 1.0f / 16777216.0f;
typedef unsigned long long u64;
constexpr int CW_MOE = 16384;

constexpr int SCR_BYTES = 139264;
constexpr int LDSCTL_OFF = SCR_BYTES;
constexpr int LDS_BYTES = 147456;
constexpr int LC_BAR = 8, LC_TB = 16, LC_CNT = 32, LC_LC = 48, LC_BASE = 64;

DI float bf2f(unsigned v) { return __uint_as_float(v << 16); }
DI float bflo(unsigned w) { return __uint_as_float(w << 16); }
DI float bfhi(unsigned w) { return __uint_as_float(w & 0xffff0000u); }
DI unsigned cvt_pk_bf16(float lo, float hi) { unsigned r; asm volatile("v_cvt_pk_bf16_f32 %0, %1, %2" : "=v"(r) : "v"(lo), "v"(hi)); return r; }
DI float fexp2(float x) { return __builtin_amdgcn_exp2f(x); }
DI float fexp(float x) { return __builtin_amdgcn_exp2f(x * LOG2E); }
DI float frcp(float x) { return __builtin_amdgcn_rcpf(x); }
DI float sigmoidf_(float x) { return frcp(1.0f + fexp(-x)); }
DI float siluf_(float x) { return x * sigmoidf_(x); }
DI float shx(float v, int o, int lane) { return __int_as_float(__builtin_amdgcn_ds_bpermute((lane ^ o) << 2, __float_as_int(v))); }
DI float shidx(float v, int src, int lane) { (void)lane; return __int_as_float(__builtin_amdgcn_ds_bpermute(src << 2, __float_as_int(v))); }
DI float shup(float v, int d, int lane) { return __int_as_float(__builtin_amdgcn_ds_bpermute((lane >= d ? lane - d : lane) << 2, __float_as_int(v))); }
DI float wave_sum(float v, int lane) {
#pragma unroll
    for (int o = 1; o < 64; o <<= 1) v += shx(v, o, lane);
    return v;
}
DI float wave_max(float v, int lane) {
#pragma unroll
    for (int o = 1; o < 64; o <<= 1) v = fmaxf(v, shx(v, o, lane));
    return v;
}
typedef int v8i __attribute__((ext_vector_type(8)));
typedef int v4i __attribute__((ext_vector_type(4)));
DI float clamp448(float x) { return __builtin_amdgcn_fmed3f(x, -448.0f, 448.0f); }
DI unsigned pk4_fp8(float a, float b, float c, float d) {
    int p = 0; p = __builtin_amdgcn_cvt_pk_fp8_f32(clamp448(a), clamp448(b), p, false); p = __builtin_amdgcn_cvt_pk_fp8_f32(clamp448(c), clamp448(d), p, true); return (unsigned)p;
}
DI unsigned pk4_u8(const f32x4& g) {
    const unsigned a = (unsigned)(g[0] * 255.0f + 0.5f), b = (unsigned)(g[1] * 255.0f + 0.5f), c = (unsigned)(g[2] * 255.0f + 0.5f), d = (unsigned)(g[3] * 255.0f + 0.5f);
    return a | (b << 8) | (c << 16) | (d << 24);
}
DI float gate_u8(unsigned w, int k) { return fmaxf((float)((w >> (8 * k)) & 0xffu), 0.5f); }
constexpr float S_U8 = 127.0f / 6.0f;
constexpr float S_XB8 = 12.7f;
constexpr float S_W8I = 32.0f * (127.0f / 5.5f);
DI unsigned pk4_i8(float a, float b, float c, float d) {
    const int qa = (int)__builtin_rintf(__builtin_amdgcn_fmed3f(a, -127.0f, 127.0f)), qb = (int)__builtin_rintf(__builtin_amdgcn_fmed3f(b, -127.0f, 127.0f));
    const int qc = (int)__builtin_rintf(__builtin_amdgcn_fmed3f(c, -127.0f, 127.0f)), qd = (int)__builtin_rintf(__builtin_amdgcn_fmed3f(d, -127.0f, 127.0f));
    return (unsigned)(qa & 255) | ((unsigned)(qb & 255) << 8) | ((unsigned)(qc & 255) << 16) | ((unsigned)qd << 24);
}
constexpr float W8_UP = 32.0f, W8_DN = 64.0f;
DI void st16_wt(void* p, u32x4 v) { asm volatile("global_store_dwordx4 %0, %1, off sc1\n\ts_nop 2" :: "v"(p), "v"(v) : "memory"); }
DI void st16_wt(void* p, f32x4 v) { asm volatile("global_store_dwordx4 %0, %1, off sc1\n\ts_nop 2" :: "v"(p), "v"(v) : "memory"); }
#define LDS_WAIT() asm volatile("s_waitcnt lgkmcnt(0)" ::: "memory")
#define VM_WAIT() asm volatile("s_waitcnt vmcnt(0)" ::: "memory")
#define MFMA16(a, b, c) __builtin_amdgcn_mfma_f32_16x16x32_bf16((a), (b), (c), 0, 0, 0)

#define XB_TMO      128
#define XB_XCNT(j)  (256  + 64 * (j))
#define XB_XSUB(j)  (1280 + 64 * (j))
#define XB_XGEN(j)  (2304 + 64 * (j))
#define XB_TOP      3328
#define XB_TOPGEN   3392
#define XCD_BAR_WORDS 3456
#define XB_SPIN_CAP (1u << 18)
DI unsigned xb_ld(unsigned* p)              { return __hip_atomic_load(p, __ATOMIC_RELAXED, __HIP_MEMORY_SCOPE_AGENT); }
DI unsigned xb_add(unsigned* p, unsigned v) { return __hip_atomic_fetch_add(p, v, __ATOMIC_RELAXED, __HIP_MEMORY_SCOPE_AGENT); }
DI unsigned xb_xcc_id() { return (unsigned)__builtin_amdgcn_s_getreg((3 << 11) | 20) & 0xFu; }
#define XB_SPIN(cond, bar) do { unsigned _sp = 0; while (cond) { __builtin_amdgcn_s_sleep(1); \
    if ((++_sp & 255u) == 0u) { if (xb_ld(&(bar)[XB_TMO])) break; if (_sp > XB_SPIN_CAP) { atomicAdd(&(bar)[XB_TMO], 1u); break; } } } } while (0)
struct XcdBarrier { unsigned* bar; unsigned x; volatile LAS unsigned* st; };
DI XcdBarrier xcd_barrier_post(unsigned* bar, volatile LAS unsigned* st) {
    XcdBarrier b; b.bar = bar; b.x = xb_xcc_id(); b.st = st;
    if (threadIdx.x == 0) (void)xb_add(&bar[XB_XCNT(b.x)], 1u);
    return b;
}
DI void xcd_barrier_complete(unsigned* bar, unsigned x, unsigned& nloc, unsigned& nx) {
    const unsigned G = gridDim.x * gridDim.y * gridDim.z;
    unsigned sum, cnt, mine, sp = 0u;
    for (;;) {
        sum = 0u; cnt = 0u; mine = 0u;
#pragma unroll 1
        for (unsigned j = 0; j < 16; ++j) { const unsigned c = xb_ld(&bar[XB_XCNT(j)]); sum += c; cnt += (c > 0u) ? 1u : 0u; mine = (j == x) ? c : mine; }
        if (sum == G) break;
        __builtin_amdgcn_s_sleep(1);
        if ((++sp & 255u) == 0u) { if (xb_ld(&bar[XB_TMO])) break; if (sp > XB_SPIN_CAP) { atomicAdd(&bar[XB_TMO], 1u); break; } }
    }
    nloc = mine > 0u ? mine : 1u; nx = cnt > 0u ? cnt : 1u;
}
DI void xcd_barrier(const XcdBarrier& b) {
    asm volatile("s_waitcnt vmcnt(0)" ::: "memory");
    __syncthreads();
    if (threadIdx.x == 0) {
        unsigned* bar = b.bar;
        __builtin_amdgcn_s_waitcnt(0);
        unsigned nloc = b.st[0], nx = b.st[1];
        if (nloc == 0u) { xcd_barrier_complete(bar, b.x, nloc, nx); b.st[0] = nloc; b.st[1] = nx; }
        const unsigned old = xb_add(&bar[XB_XSUB(b.x)], 1u);
        const unsigned gen = old / nloc;
        if (old + 1u == (gen + 1u) * nloc) {
            __builtin_amdgcn_fence(__ATOMIC_RELEASE, "agent");
            asm volatile("s_waitcnt vmcnt(0)" ::: "memory");
            const unsigned og = xb_add(&bar[XB_TOP], 1u);
            const unsigned tg = og / nx;
            if (og + 1u == (tg + 1u) * nx) xb_add(&bar[XB_TOPGEN], 1u);
            else XB_SPIN(xb_ld(&bar[XB_TOPGEN]) == tg, bar);
            __builtin_amdgcn_fence(__ATOMIC_ACQUIRE, "agent");
            xb_add(&bar[XB_XGEN(b.x)], 1u);
            asm volatile("s_waitcnt vmcnt(0)" ::: "memory");
        } else {
            XB_SPIN(xb_ld(&bar[XB_XGEN(b.x)]) == gen, bar);
            __builtin_amdgcn_fence(__ATOMIC_ACQUIRE, "agent");
            asm volatile("s_waitcnt vmcnt(0)" ::: "memory");
        }
    }
    __syncthreads();
}

namespace pg8 {
constexpr int BM = 256, BK = 64, HALF = 128, HTB = HALF * BK * 2, STAGE_BYTES = 8 * HTB, NXCD = 8, WGM = 8;
DI int lds_byte(int r, int c) { const int st = (r >> 4) * 2 + (c >> 5), rr = r & 15, cc = c & 31, ob = rr * 64 + cc * 2; return st * 1024 + (ob ^ (((ob >> 9) & 1) << 5)); }
DI void stage_rc(int b, int& R, int& C) { const int st = b / 1024, sb = b % 1024, swz = sb ^ (((sb >> 9) & 1) << 5); R = (st >> 1) * 16 + swz / 64; C = (st & 1) * 32 + (swz % 64) / 2; }
DI int perm32(int rho) { const int n = rho >> 4, i = rho & 15; return 8 * (i >> 2) + 4 * n + (i & 3); }
struct Unit { int pm, pn, e, x; };

DI bool static_unit(int i, int G, int c, int nM, int nN, int& pm, int& pn) {
    const int nwg = nM * nN; const long L = (long)i * G + c; if (L >= nwg) return false;
    int wgid = (int)L; { const int q = nwg / NXCD, r = nwg % NXCD, xcd = wgid % NXCD, off = wgid / NXCD; wgid = (xcd < r ? xcd * (q + 1) : r * (q + 1) + (xcd - r) * q) + off; }
    const int nig = WGM * nN, gid = wgid / nig, fm = gid * WGM, gsz = (nM - fm) < WGM ? (nM - fm) : WGM;
    pm = fm + ((wgid % nig) % gsz); pn = (wgid % nig) / gsz; return true;
}

template <class Epi, class Sched, bool ALIGN_EPI, int QM = 0  >
DI void gemm_phase(ldsp lds, const int K, const int lda, const int ldb, const Sched& S, const Epi& E) {
    int tid_ = threadIdx.x; asm volatile("" : "+v"(tid_));
    const int tid = tid_, wid = __builtin_amdgcn_readfirstlane(tid >> 6), lane = tid & 63, wr = wid >> 2, wc = wid & 3, fr = lane & 15, fq = lane >> 4;
    const int nt = K / BK; constexpr bool F8 = (QM == 1);
    unsigned voffB[2];
#pragma unroll
    for (int i = 0; i < 2; ++i) { int R, C; stage_rc(tid * 16 + i * 8192, R, C); const int Rb = Epi::PERM ? ((R & ~31) + perm32(R & 31)) : R; voffB[i] = (unsigned)(Rb * ldb + C) * 2u; }
    unsigned vA[2][2], vAn[2][2];
    const size_t kstep = (size_t)(BK * 2);
    const size_t hstepB = (size_t)HALF * ldb * 2;
    const unsigned ldsw = (unsigned)wid * 1024u;
    const int aoff = lds_byte(wr * 64 + fr, fq * 8), boff = lds_byte(wc * 32 + fr, fq * 8);
#define PG8_SA(b, h) (((b) * 2 + (h)) * HTB)
#define PG8_SB(b, h) ((4 + (b) * 2 + (h)) * HTB)
#define PG8_STG(bufoff, p0, p1) do { \
        __builtin_amdgcn_global_load_lds((const unsigned*)(p0), (LAS unsigned*)(lds + (bufoff) + ldsw), 16, 0, 0); \
        __builtin_amdgcn_global_load_lds((const unsigned*)(p1), (LAS unsigned*)(lds + (bufoff) + ldsw + 8192), 16, 0, 0); } while (0)
#define PG8_STGB(bufoff, gbase) PG8_STG(bufoff, (gbase) + voffB[0], (gbase) + voffB[1])
#define PG8_STGA(bufoff, gbase, v, h) PG8_STG(bufoff, (gbase) + v[h][0], (gbase) + v[h][1])
#define PG8_LD16(off_) (*(const LAS v4i*)(lds + (off_)))
#define PG8_LDA(dst, b, h) do { if constexpr (F8) { _Pragma("unroll") for (int m = 0; m < 4; ++m) dst##8[m] = __builtin_shufflevector(PG8_LD16(PG8_SA(b, h) + aoff + m * 2048), PG8_LD16(PG8_SA(b, h) + aoff + m * 2048 + 1024), 0, 1, 2, 3, 4, 5, 6, 7); } \
        else { _Pragma("unroll") for (int m = 0; m < 4; ++m) _Pragma("unroll") for (int k = 0; k < 2; ++k) dst[m][k] = *(const LAS bf16x8*)(lds + PG8_SA(b, h) + aoff + m * 2048 + k * 1024); } } while (0)
#define PG8_LDB(dst, b, h) do { if constexpr (F8) { _Pragma("unroll") for (int n = 0; n < 2; ++n) dst##8[n] = __builtin_shufflevector(PG8_LD16(PG8_SB(b, h) + boff + n * 2048), PG8_LD16(PG8_SB(b, h) + boff + n * 2048 + 1024), 0, 1, 2, 3, 4, 5, 6, 7); } \
        else { _Pragma("unroll") for (int n = 0; n < 2; ++n) _Pragma("unroll") for (int k = 0; k < 2; ++k) dst[n][k] = *(const LAS bf16x8*)(lds + PG8_SB(b, h) + boff + n * 2048 + k * 1024); } } while (0)
#define PG8_MMA(ai, bj, At, Bt) do { __builtin_amdgcn_s_setprio(1); _Pragma("unroll") for (int m = 0; m < 4; ++m) _Pragma("unroll") for (int n = 0; n < 2; ++n) { \
        if constexpr (F8)   \
            asm volatile("v_mfma_scale_f32_16x16x128_f8f6f4 %0, %1, %2, %0, %3, %3 op_sel_hi:[0,0,0]" : "+v"(acc[ai][bj][m][n]) : "v"(Bt##8[n]), "v"(At##8[m]), "v"(sc127));   \
        else if constexpr (QM == 2) { _Pragma("unroll") for (int k = 0; k < 2; ++k) acc[ai][bj][m][n] = __builtin_bit_cast(f32x4, __builtin_amdgcn_mfma_i32_16x16x64_i8(__builtin_bit_cast(v4i, Bt[n][k]), __builtin_bit_cast(v4i, At[m][k]), __builtin_bit_cast(v4i, acc[ai][bj][m][n]), 0, 0, 0)); } \
        else { _Pragma("unroll") for (int k = 0; k < 2; ++k) acc[ai][bj][m][n] = __builtin_amdgcn_mfma_f32_16x16x32_bf16(Bt[n][k], At[m][k], acc[ai][bj][m][n], 0, 0, 0); } } \
        __builtin_amdgcn_s_setprio(0); } while (0)
#define PG8_WAIT_V(n) asm volatile("s_waitcnt vmcnt(" #n ")" ::: "memory")
#define PG8_WAIT_L(n) asm volatile("s_waitcnt lgkmcnt(" #n ")" ::: "memory")
#define PG8_BAR __builtin_amdgcn_s_barrier()
#define PG8_SCHED __builtin_amdgcn_sched_barrier(0)
    Unit cur, nxt; int ui = 0;
    if (!S.next(0, cur)) return;
    f32x4 acc[2][2][4][2];
#pragma unroll
    for (int a = 0; a < 2; ++a)
#pragma unroll
        for (int b = 0; b < 2; ++b)
#pragma unroll
            for (int m = 0; m < 4; ++m)
#pragma unroll
                for (int n = 0; n < 2; ++n) acc[a][b][m][n] = (f32x4){0.f, 0.f, 0.f, 0.f};
    int sc127 = 0x7f7f7f7f; asm volatile("" : "+v"(sc127));
    bf16x8 At[4][2], B0[2][2], B1[2][2];
    v8i At8[4], B08[2], B18[2];
    const char* cA = S.a_base(cur); const char* cB = S.b_base(cur);
    S.a_off(cur, tid, lda, vA);
#pragma unroll
    for (int h = 0; h < 2; ++h)
#pragma unroll
        for (int i = 0; i < 2; ++i) vAn[h][i] = vA[h][i];
    PG8_STGB(PG8_SB(0, 0), cB); PG8_STGB(PG8_SB(0, 1), cB + hstepB); PG8_STGA(PG8_SA(0, 0), cA, vA, 0); PG8_STGA(PG8_SA(0, 1), cA, vA, 1);
    if (wr == 1) PG8_BAR;
    PG8_WAIT_V(2); PG8_BAR;
    PG8_STGB(PG8_SB(1, 0), cB + kstep); PG8_STGA(PG8_SA(1, 0), cA + kstep, vA, 0); PG8_STGB(PG8_SB(1, 1), cB + hstepB + kstep);
    PG8_WAIT_V(6); PG8_BAR;
    for (;;) {
        const bool has_next = S.next(ui + 1, nxt);
        const char* nA = has_next ? S.a_base(nxt) : cA; const char* nB = has_next ? S.b_base(nxt) : cB;
        if (Sched::GATHER) { if (has_next) S.a_off(nxt, tid, lda, vAn); }
        for (int t = 0; t < nt; t += 2) {
            if constexpr (Epi::HOOK) E.hook(acc, cur, t, wr, wc, fr, fq);
            const bool last = (t == nt - 2);
            const char* a1 = cA + (size_t)(t + 1) * kstep;
            const char* a2 = last ? nA : cA + (size_t)(t + 2) * kstep; const char* b2 = last ? nB : cB + (size_t)(t + 2) * kstep;
            const char* a3 = a2 + kstep; const char* b3 = b2 + kstep;
            PG8_LDB(B0, 0, 0); PG8_LDB(B1, 0, 1); PG8_SCHED; PG8_LDA(At, 0, 0); PG8_STGA(PG8_SA(1, 1), a1, vA, 1);
            if (Sched::GATHER && last) {
#pragma unroll
                for (int h = 0; h < 2; ++h)
#pragma unroll
                    for (int i = 0; i < 2; ++i) vA[h][i] = vAn[h][i]; }
            PG8_WAIT_V(8); PG8_WAIT_L(0); PG8_BAR; PG8_MMA(0, 0, At, B0); PG8_MMA(0, 1, At, B1); PG8_BAR; PG8_SCHED;
            PG8_LDA(At, 0, 1); PG8_STGB(PG8_SB(0, 0), b2); PG8_STGB(PG8_SB(0, 1), b2 + hstepB); PG8_STGA(PG8_SA(0, 0), a2, vA, 0);
            PG8_WAIT_V(8); PG8_WAIT_L(0); PG8_BAR; PG8_MMA(1, 0, At, B0); PG8_MMA(1, 1, At, B1); PG8_BAR; PG8_SCHED;
            PG8_LDB(B0, 1, 0); PG8_LDB(B1, 1, 1); PG8_SCHED; PG8_LDA(At, 1, 0); PG8_STGA(PG8_SA(0, 1), a2, vA, 1);
            PG8_WAIT_V(8); PG8_WAIT_L(0); PG8_BAR; PG8_MMA(0, 0, At, B0); PG8_MMA(0, 1, At, B1); PG8_BAR; PG8_SCHED;
            PG8_LDA(At, 1, 1); PG8_STGB(PG8_SB(1, 0), b3); PG8_STGB(PG8_SB(1, 1), b3 + hstepB); PG8_STGA(PG8_SA(1, 0), a3, vA, 0);
            PG8_WAIT_V(8); PG8_WAIT_L(0); PG8_BAR; PG8_MMA(1, 0, At, B0); PG8_MMA(1, 1, At, B1); PG8_BAR; PG8_SCHED;
        }
        if constexpr (ALIGN_EPI) { if (wr == 0) PG8_BAR; }
        if constexpr (F8) asm volatile("s_nop 15\n\ts_nop 15" ::: "memory");
        if constexpr (QM == 2) {
#pragma unroll
            for (int a = 0; a < 2; ++a)
#pragma unroll
                for (int b = 0; b < 2; ++b)
#pragma unroll
                    for (int m = 0; m < 4; ++m)
#pragma unroll
                        for (int n = 0; n < 2; ++n) { const v4i iv = __builtin_bit_cast(v4i, acc[a][b][m][n]); acc[a][b][m][n] = (f32x4){(float)iv[0], (float)iv[1], (float)iv[2], (float)iv[3]}; } }
        E(acc, cur, wr, wc, fr, fq);
        if (!has_next) break;
#pragma unroll
        for (int a = 0; a < 2; ++a)
#pragma unroll
            for (int b = 0; b < 2; ++b)
#pragma unroll
                for (int m = 0; m < 4; ++m)
#pragma unroll
                    for (int n = 0; n < 2; ++n) acc[a][b][m][n] = (f32x4){0.f, 0.f, 0.f, 0.f};
        cur = nxt; cA = nA; cB = nB; ++ui;
#pragma unroll
        for (int h = 0; h < 2; ++h)
#pragma unroll
            for (int i = 0; i < 2; ++i) vA[h][i] = vAn[h][i];
        if constexpr (ALIGN_EPI) { if (wr == 1) PG8_BAR; }
    }
    PG8_WAIT_V(0);
    if constexpr (!ALIGN_EPI) { if (wr == 0) PG8_BAR; }
    PG8_BAR;
#undef PG8_SA
#undef PG8_SB
#undef PG8_STG
#undef PG8_STGB
#undef PG8_STGA
#undef PG8_LD16
#undef PG8_LDA
#undef PG8_LDB
#undef PG8_MMA
#undef PG8_WAIT_V
#undef PG8_WAIT_L
#undef PG8_BAR
#undef PG8_SCHED
}

struct SchedDense {
    static constexpr bool GATHER = false;
    const char* A; const char* B; int nM, nN, G, c, lda, ldb;
    DI bool next(int i, Unit& u) const { u.e = 0; u.x = 0; return static_unit(i, G, c, nM, nN, u.pm, u.pn); }
    DI const char* a_base(const Unit& u) const { return A + (size_t)u.pm * 256 * lda * 2; }
    DI const char* b_base(const Unit& u) const { return B + (size_t)u.pn * 256 * ldb * 2; }
    DI void a_off(const Unit&, int tid, int lda_, unsigned (&v)[2][2]) const {
#pragma unroll
        for (int i = 0; i < 2; ++i) { int R, C; stage_rc(tid * 16 + i * 8192, R, C);
#pragma unroll
            for (int h = 0; h < 2; ++h) v[h][i] = (unsigned)((h * 128 + R) * lda_ + C) * 2u; }
    }
};
template <int MODE> struct SchedProj {
    static constexpr bool GATHER = false;
    const char* A; const char* B; int G, c, lda, ldb;
    DI bool next(int i, Unit& u) const { u.x = 0; if (!static_unit(i, G, c, SEQ / 256, MODE == 2 ? 32 : (MODE == 1 ? 20 : 12), u.pm, u.pn)) return false;
        const int p = u.pn; u.e = MODE == 2 ? p : (MODE == 1 ? (p < 4 ? p + 4 : (p < 7 ? p + 10 : (p == 7 ? 18 : p + 11))) : (p < 4 ? p : (p < 10 ? p + 4 : (p == 10 ? 17 : 31)))); return true; }
    DI const char* a_base(const Unit& u) const { return A + (size_t)u.pm * 256 * lda * 2; }
    DI const char* b_base(const Unit& u) const { return B + (size_t)u.e * 256 * ldb * 2; }
    DI void a_off(const Unit&, int tid, int lda_, unsigned (&v)[2][2]) const {
#pragma unroll
        for (int i = 0; i < 2; ++i) { int R, C; stage_rc(tid * 16 + i * 8192, R, C);
#pragma unroll
            for (int h = 0; h < 2; ++h) v[h][i] = (unsigned)((h * 128 + R) * lda_ + C) * 2u; }
    }
};
struct SchedKV {
    static constexpr bool GATHER = false;
    const char* memn; const char* wkv; int G, c, first;
    DI bool next(int i, Unit& u) const {
        int cc = c - first; if (cc < 0) cc += G; const int L = i * G + cc; if (L >= 16) return false;
        u.e = L >> 2; u.x = (L >> 1) & 1; const int j = L & 1; u.pm = u.x ? j : 0; u.pn = u.x ? 0 : j; return true;
    }
    DI const char* a_base(const Unit& u) const { return u.x ? wkv + (size_t)u.e * 1024 * 1024 * 2 + (size_t)(512 + u.pm * 256) * 1024 * 2 : memn + (size_t)u.e * 256 * 1024 * 2; }
    DI const char* b_base(const Unit& u) const { return u.x ? memn + (size_t)u.e * 256 * 1024 * 2 : wkv + (size_t)u.e * 1024 * 1024 * 2 + (size_t)(u.pn * 256) * 1024 * 2; }
    DI void a_off(const Unit&, int tid, int lda_, unsigned (&v)[2][2]) const {
#pragma unroll
        for (int i = 0; i < 2; ++i) { int R, C; stage_rc(tid * 16 + i * 8192, R, C);
#pragma unroll
            for (int h = 0; h < 2; ++h) v[h][i] = (unsigned)((h * 128 + R) * lda_ + C) * 2u; }
    }
};
template <bool UP> struct SchedMoe {
    static constexpr bool GATHER = false;
    const char* A; const char* B; size_t bstride; volatile LAS unsigned* lc; int nN, G, c, lda, ldb;
    DI bool next(int i, Unit& u) const {
        const int T = __builtin_amdgcn_readfirstlane((int)lc[LC_TB + 8]);
        if (!static_unit(i, G, c, T, nN, u.pm, u.pn)) return false;
        int e = 0, tbe = 0;
#pragma unroll
        for (int j = 1; j < 8; ++j) { const int tbj = __builtin_amdgcn_readfirstlane((int)lc[LC_TB + j]); if (u.pm >= tbj) { e = j; tbe = tbj; } }
        u.e = e; u.x = (u.pm - tbe) * 256; return true;
    }
    DI const char* a_base(const Unit& u) const { return UP ? A + ((size_t)u.e * SEQ + u.x) * lda * 2 : A + (size_t)u.pm * 256 * lda * 2; }
    DI const char* b_base(const Unit& u) const { return B + (size_t)u.e * bstride + (size_t)u.pn * 256 * ldb * 2; }
    DI void a_off(const Unit&, int tid, int lda_, unsigned (&v)[2][2]) const {
#pragma unroll
        for (int i = 0; i < 2; ++i) { int R, C; stage_rc(tid * 16 + i * 8192, R, C);
#pragma unroll
            for (int h = 0; h < 2; ++h) v[h][i] = (unsigned)((h * 128 + R) * lda_ + C) * 2u; }
    }
};

struct EpiProj {
    static constexpr bool PERM = true, HOOK = false;
    bf16* mq; bf16* dq; bf16* xq; bf16* gt; float* ifg; const float* bias8; float sc; const u64* rs; float qd;
    DI void operator()(const f32x4 (&acc)[2][2][4][2], const Unit& u, int wr, int wc, int fr, int fq) const {
        const int row0 = u.pm * BM + wr * 64 + fr; const int pn = u.e;
        float rsc[2][4];
#pragma unroll
        for (int ai = 0; ai < 2; ++ai)
#pragma unroll
            for (int m = 0; m < 4; ++m) rsc[ai][m] = rs ? (float)rs[row0 + ai * HALF + m * 16] * RS_UNFIX : 0.f;
#pragma unroll
        for (int ai = 0; ai < 2; ++ai)
#pragma unroll
            for (int m = 0; m < 4; ++m) rsc[ai][m] = rs ? sc / sqrtf(rsc[ai][m] * (1.f / DM) + EPS) : sc;
        if (pn == 31) {
            if (wc == 0 && fq == 0) { const f32x4 bi = *(const f32x4*)bias8, bf = *(const f32x4*)(bias8 + 4);
#pragma unroll
                for (int ai = 0; ai < 2; ++ai)
#pragma unroll
                    for (int m = 0; m < 4; ++m) { float* p = ifg + (size_t)(row0 + ai * HALF + m * 16) * 8; f32x4 vi = acc[ai][0][m][0] * rsc[ai][m] + bi, vf = acc[ai][0][m][1] * rsc[ai][m] + bf;
#pragma unroll
                        for (int q = 0; q < 4; ++q) vf[q] = fminf(vf[q], 0.f) - __logf(1.0f + __expf(-fabsf(vf[q])));
                        *(f32x4*)p = vi; *(f32x4*)(p + 4) = vf; } }
            return; }
        const bool sg = pn >= 19; const float scl = (pn == 17 || pn == 18) ? RS128 : ((pn >= 8 && pn < 11) ? qd : 1.0f);
#pragma unroll
        for (int bj = 0; bj < 2; ++bj) {
            bf16* base; int rstride; int sh = 0;
            if (pn < 8) { const int sel = pn >> 1, h = (pn & 1) * 2 + bj; base = mq + (size_t)(sel * 4 + h) * SEQ * 128 + wc * 32 + 8 * fq; rstride = 128; }
            else if (pn < 17) { const int t = pn - 8, sel = t / 3, gh = (t % 3) * 4 + bj * 2 + (wc >> 1); sh = 2 * (gh >> 2); base = dq + (size_t)(sel * 12 + gh) * SEQ * 64 + (wc & 1) * 32 + 8 * fq; rstride = 64; }
            else if (pn < 19) { const int hx = (pn - 17) * 2 + bj; base = xq + (size_t)hx * SEQ * 128 + wc * 32 + 8 * fq; rstride = 128; }
            else {
                unsigned char* gb = (unsigned char*)gt + (pn - 19) * 256 + bj * 128 + wc * 32 + 8 * fq;
#pragma unroll
                for (int ai = 0; ai < 2; ++ai)
#pragma unroll
                    for (int m = 0; m < 4; ++m) { const int row = row0 + ai * HALF + m * 16;
                        f32x4 v0 = acc[ai][bj][m][0] * rsc[ai][m], v1 = acc[ai][bj][m][1] * rsc[ai][m];
#pragma unroll
                        for (int q = 0; q < 4; ++q) { v0[q] = sigmoidf_(v0[q]); v1[q] = sigmoidf_(v1[q]); }
                        u32x2 w; w.x = pk4_u8(v0); w.y = pk4_u8(v1); *(u32x2*)(gb + (size_t)row * 3072) = w; }
                continue; }
#pragma unroll
            for (int ai = 0; ai < 2; ++ai)
#pragma unroll
                for (int m = 0; m < 4; ++m) { const int row = row0 + ai * HALF + m * 16; const int pos = ((row & ((1 << sh) - 1)) << (14 - sh)) + (row >> sh);
                    f32x4 v0 = acc[ai][bj][m][0] * (scl * rsc[ai][m]), v1 = acc[ai][bj][m][1] * (scl * rsc[ai][m]);
                    if (sg) {
#pragma unroll
                        for (int q = 0; q < 4; ++q) { v0[q] = sigmoidf_(v0[q]); v1[q] = sigmoidf_(v1[q]); } }
                    u32x4 w; w.x = cvt_pk_bf16(v0[0], v0[1]); w.y = cvt_pk_bf16(v0[2], v0[3]); w.z = cvt_pk_bf16(v1[0], v1[1]); w.w = cvt_pk_bf16(v1[2], v1[3]);
                    st16_wt(base + (size_t)pos * rstride, w); } }
    }
};
struct EpiKV {
    static constexpr bool PERM = true, HOOK = false;
    bf16* km; bf16* vmt;
    DI void operator()(const f32x4 (&acc)[2][2][4][2], const Unit& u, int wr, int wc, int fr, int fq) const {
        bf16* O = u.x ? vmt + (size_t)u.e * 512 * 256 : km + (size_t)u.e * 256 * 512; const int ldc = u.x ? 256 : 512;
        const int row0 = u.pm * BM + wr * 64 + fr, col0 = u.pn * BM + wc * 32 + 8 * fq;
#pragma unroll
        for (int ai = 0; ai < 2; ++ai)
#pragma unroll
            for (int m = 0; m < 4; ++m) { bf16* rowp = O + (size_t)(row0 + ai * HALF + m * 16) * ldc + col0;
#pragma unroll
                for (int bj = 0; bj < 2; ++bj) { const f32x4 v0 = acc[ai][bj][m][0], v1 = acc[ai][bj][m][1];
                    u32x4 w; w.x = cvt_pk_bf16(v0[0], v0[1]); w.y = cvt_pk_bf16(v0[2], v0[3]); w.z = cvt_pk_bf16(v1[0], v1[1]); w.w = cvt_pk_bf16(v1[2], v1[3]);
                    *(u32x4*)(rowp + bj * HALF) = w; } }
    }
};
struct EpiBranchFused {
    static constexpr bool PERM = true, HOOK = true;
    bf16* Mg; const unsigned char* gates;
    DI void hook(f32x4 (&acc)[2][2][4][2], const Unit& u, int t, int wr, int wc, int fr, int fq) const {
        if (t != 8 && t != 12) return;
        const int gnum = (t == 8) ? 0 : 1024;
        const unsigned char* gp0 = gates + (size_t)(u.pm * BM + wr * 64 + fr) * 3072 + u.pn * BM + wc * 32 + 8 * fq + gnum;
#pragma unroll
        for (int ai = 0; ai < 2; ++ai)
#pragma unroll
            for (int mp = 0; mp < 2; ++mp) {
                u32x2 gn[2][2], gd[2][2];
#pragma unroll
                for (int mm = 0; mm < 2; ++mm)
#pragma unroll
                    for (int bj = 0; bj < 2; ++bj) { const unsigned char* gp = gp0 + (size_t)(ai * HALF + (2 * mp + mm) * 16) * 3072 + bj * HALF; gn[mm][bj] = *(const u32x2*)gp; gd[mm][bj] = *(const u32x2*)(gp + 1024); }
#pragma unroll
                for (int mm = 0; mm < 2; ++mm)
#pragma unroll
                    for (int bj = 0; bj < 2; ++bj) { const int m = 2 * mp + mm; const u32x2 n2 = gn[mm][bj], d2 = gd[mm][bj];
                        f32x4 v0 = acc[ai][bj][m][0], v1 = acc[ai][bj][m][1];
#pragma unroll
                        for (int q = 0; q < 4; ++q) { v0[q] *= gate_u8(n2.x, q) * frcp(gate_u8(d2.x, q)); v1[q] *= gate_u8(n2.y, q) * frcp(gate_u8(d2.y, q)); }
                        acc[ai][bj][m][0] = v0; acc[ai][bj][m][1] = v1; }
                asm volatile("" : "+v"(acc[ai][0][2 * mp][0]), "+v"(acc[ai][1][2 * mp + 1][1]) :: "memory"); }
    }
    DI void operator()(const f32x4 (&acc)[2][2][4][2], const Unit& u, int wr, int wc, int fr, int fq) const {
        const int row0 = u.pm * BM + wr * 64 + fr, col0 = u.pn * BM + wc * 32 + 8 * fq;
#pragma unroll
        for (int ai = 0; ai < 2; ++ai) { u32x2 g[4][2];
#pragma unroll
            for (int m = 0; m < 4; ++m)
#pragma unroll
                for (int bj = 0; bj < 2; ++bj) g[m][bj] = *(const u32x2*)(gates + (size_t)(row0 + ai * HALF + m * 16) * 3072 + 2048 + col0 + bj * HALF);
#pragma unroll
            for (int m = 0; m < 4; ++m) { const size_t row = (size_t)(row0 + ai * HALF + m * 16);
#pragma unroll
                for (int bj = 0; bj < 2; ++bj) { f32x4 v0 = acc[ai][bj][m][0], v1 = acc[ai][bj][m][1];
#pragma unroll
                    for (int q = 0; q < 4; ++q) { v0[q] *= gate_u8(g[m][bj].x, q) * (1.0f / 255.0f); v1[q] *= gate_u8(g[m][bj].y, q) * (1.0f / 255.0f); }
                    u32x4 w; w.x = cvt_pk_bf16(v0[0], v0[1]); w.y = cvt_pk_bf16(v0[2], v0[3]); w.z = cvt_pk_bf16(v1[0], v1[1]); w.w = cvt_pk_bf16(v1[2], v1[3]);
                    st16_wt(Mg + row * DM + col0 + bj * HALF, w); } } }
    }
};
template <int XB, bool IN_F32> struct EpiRes {
    static constexpr bool PERM = true, HOOK = false;
    const void* in; bf16* out; float sc; const float* gain; unsigned char* xb; u64* rs;
    DI void operator()(const f32x4 (&acc)[2][2][4][2], const Unit& u, int wr, int wc, int fr, int fq) const {
        const int row0 = u.pm * BM + wr * 64 + fr, col0 = u.pn * BM + wc * 32 + 8 * fq;
        f32x4 gv[2][2];
        if (XB) {
#pragma unroll
            for (int bj = 0; bj < 2; ++bj)
#pragma unroll
                for (int n = 0; n < 2; ++n) gv[bj][n] = *(const f32x4*)(gain + col0 + bj * HALF + 4 * n); }
        constexpr int MB = 2;
#pragma unroll
        for (int ai = 0; ai < 2; ++ai)
#pragma unroll
          for (int m0 = 0; m0 < 4; m0 += MB) { f32x4 b[MB][2][2];
#pragma unroll
            for (int mm = 0; mm < MB; ++mm) { const size_t off = (size_t)(row0 + ai * HALF + (m0 + mm) * 16) * DM + col0;
#pragma unroll
                for (int bj = 0; bj < 2; ++bj) {
                    if (IN_F32) { b[mm][bj][0] = *(const f32x4*)((const float*)in + off + bj * HALF); b[mm][bj][1] = *(const f32x4*)((const float*)in + off + bj * HALF + 4); }
                    else { const u32x4 r = *(const u32x4*)((const bf16*)in + off + bj * HALF); b[mm][bj][0] = (f32x4){bflo(r.x), bfhi(r.x), bflo(r.y), bfhi(r.y)}; b[mm][bj][1] = (f32x4){bflo(r.z), bfhi(r.z), bflo(r.w), bfhi(r.w)}; } } }
#pragma unroll
            for (int mm = 0; mm < MB; ++mm) { const int m = m0 + mm; const int row = row0 + ai * HALF + m * 16; const size_t off = (size_t)row * DM + col0; float ss = 0.f;
#pragma unroll
                for (int bj = 0; bj < 2; ++bj) { const f32x4 s0 = b[mm][bj][0] + acc[ai][bj][m][0] * sc, s1 = b[mm][bj][1] + acc[ai][bj][m][1] * sc;
                    u32x4 w; w.x = cvt_pk_bf16(s0[0], s0[1]); w.y = cvt_pk_bf16(s0[2], s0[3]); w.z = cvt_pk_bf16(s1[0], s1[1]); w.w = cvt_pk_bf16(s1[2], s1[3]);
                    st16_wt(out + off + bj * HALF, w);
                    if (XB) { const f32x4 v0 = (f32x4){bflo(w.x), bfhi(w.x), bflo(w.y), bfhi(w.y)}, v1 = (f32x4){bflo(w.z), bfhi(w.z), bflo(w.w), bfhi(w.w)};
                        ss += ((v0[0] * v0[0] + v0[1] * v0[1]) + (v0[2] * v0[2] + v0[3] * v0[3])) + ((v1[0] * v1[0] + v1[1] * v1[1]) + (v1[2] * v1[2] + v1[3] * v1[3]));
                        const f32x4 g0 = v0 * gv[bj][0], g1 = v1 * gv[bj][1];
                        if (XB == 1) { u32x4 x; x.x = cvt_pk_bf16(g0[0], g0[1]); x.y = cvt_pk_bf16(g0[2], g0[3]); x.z = cvt_pk_bf16(g1[0], g1[1]); x.w = cvt_pk_bf16(g1[2], g1[3]); *(u32x4*)(xb + (off + bj * HALF) * 2) = x; }
                        else { u32x2 x; x.x = pk4_i8(g0[0] * S_XB8, g0[1] * S_XB8, g0[2] * S_XB8, g0[3] * S_XB8); x.y = pk4_i8(g1[0] * S_XB8, g1[1] * S_XB8, g1[2] * S_XB8, g1[3] * S_XB8); *(u32x2*)(xb + off + bj * HALF) = x; } } }
                if (XB) { const int lane = (fq << 4) | fr; ss += shx(ss, 16, lane); ss += shx(ss, 32, lane);
                    if (fq == 0) (void)__hip_atomic_fetch_add(rs + row, (u64)(ss * RS_FIX), __ATOMIC_RELAXED, __HIP_MEMORY_SCOPE_AGENT); } } }
    }
};
template <bool MOE, bool H8 = MOE> struct EpiSwiglu {
    static constexpr bool PERM = true, HOOK = false;
    unsigned char* H; int ldh; const float* gatee; volatile LAS unsigned* lc; float sc; const u64* rs;
    DI void operator()(const f32x4 (&acc)[2][2][4][2], const Unit& u, int wr, int wc, int fr, int fq) const {
        const int r0 = wr * 64 + fr, col0 = u.pn * HALF + wc * 32 + 8 * fq;
        int cnt = 0; if (MOE) cnt = __builtin_amdgcn_readfirstlane((int)lc[LC_CNT + u.e]);
        float rgs[2][4];
#pragma unroll
        for (int ai = 0; ai < 2; ++ai)
#pragma unroll
            for (int m = 0; m < 4; ++m) { rgs[ai][m] = 1.f; if (MOE) { const int pos = u.x + r0 + ai * HALF + m * 16; rgs[ai][m] = pos < cnt ? gatee[u.e * SEQ + pos] : 0.f; }
                else if (rs) rgs[ai][m] = (float)rs[u.pm * BM + r0 + ai * HALF + m * 16] * RS_UNFIX; }
#pragma unroll
        for (int ai = 0; ai < 2; ++ai)
#pragma unroll
            for (int m = 0; m < 4; ++m) { const int r = r0 + ai * HALF + m * 16;
                const float rg = rgs[ai][m];
                const f32x4 g0 = acc[ai][0][m][0], g1 = acc[ai][0][m][1], u0 = acc[ai][1][m][0], u1 = acc[ai][1][m][1];
                float o[8];
                const float rsd = (!MOE && rs) ? sc / sqrtf(rg * (1.f / DM) + EPS) : sc, rgm = MOE ? rg : 1.f;
#pragma unroll
                for (int q = 0; q < 4; ++q) { o[q] = siluf_(g0[q] * rsd) * (u0[q] * rsd) * rgm; o[4 + q] = siluf_(g1[q] * rsd) * (u1[q] * rsd) * rgm; }
                if (H8) { u32x2 w; w.x = pk4_fp8(o[0], o[1], o[2], o[3]); w.y = pk4_fp8(o[4], o[5], o[6], o[7]); *(u32x2*)(H + (size_t)(u.pm * BM + r) * ldh + col0) = w; }
                else { u32x4 w; w.x = cvt_pk_bf16(o[0], o[1]); w.y = cvt_pk_bf16(o[2], o[3]); w.z = cvt_pk_bf16(o[4], o[5]); w.w = cvt_pk_bf16(o[6], o[7]); st16_wt(H + ((size_t)(u.pm * BM + r) * ldh + col0) * 2, w); } }
    }
};
struct EpiMoeDown {
    static constexpr bool PERM = true, HOOK = false;
    bf16* ys; const int* toke; volatile LAS unsigned* lc; float sc;
    DI void operator()(const f32x4 (&acc)[2][2][4][2], const Unit& u, int wr, int wc, int fr, int fq) const {
        const int r0 = wr * 64 + fr, col0 = u.pn * BM + wc * 32 + 8 * fq; const int cnt = __builtin_amdgcn_readfirstlane((int)lc[LC_CNT + u.e]);
        int tks[2][4];
#pragma unroll
        for (int ai = 0; ai < 2; ++ai)
#pragma unroll
            for (int m = 0; m < 4; ++m) { const int pos = u.x + r0 + ai * HALF + m * 16; tks[ai][m] = pos < cnt ? toke[u.e * SEQ + pos] : 0; }
#pragma unroll
        for (int ai = 0; ai < 2; ++ai)
#pragma unroll
            for (int m = 0; m < 4; ++m) { const int pos = u.x + r0 + ai * HALF + m * 16;
                if (pos < cnt) { const int tk = tks[ai][m]; bf16* rowp = ys + ((size_t)(tk >> 20) * SEQ + (size_t)(tk & 0xFFFFF)) * DM + col0;
#pragma unroll
                    for (int bj = 0; bj < 2; ++bj) { const f32x4 v0 = acc[ai][bj][m][0] * sc, v1 = acc[ai][bj][m][1] * sc;
                        u32x4 w; w.x = cvt_pk_bf16(v0[0], v0[1]); w.y = cvt_pk_bf16(v0[2], v0[3]); w.z = cvt_pk_bf16(v1[0], v1[1]); w.w = cvt_pk_bf16(v1[2], v1[3]);
                        st16_wt(rowp + bj * HALF, w); } } }
    }
};
}

struct Args { const float* in[22]; float* out; unsigned char* ws; };
struct Frame {
    ldsp lds; volatile LAS unsigned* lc; unsigned* ctl;
    int tid, lane, wave, vcu, G;
    unsigned char* ws;
    unsigned long long pacc;
    const __attribute__((address_space(4))) Args* ka;
};
DI void refresh(Frame& F) {
    int t = threadIdx.x; asm volatile("" : "+v"(t)); F.tid = t; F.lane = t & 63; F.wave = __builtin_amdgcn_readfirstlane(t >> 6);
    const __attribute__((address_space(4))) Args* ka = (const __attribute__((address_space(4))) Args*)__builtin_amdgcn_kernarg_segment_ptr(); asm volatile("" : "+s"(ka)); F.ka = ka;
    unsigned char* w = ka->ws; F.ws = w; F.ctl = (unsigned*)(w + WS_CTL);
    int vc = F.vcu, gg = F.G; asm volatile("" : "+s"(vc), "+s"(gg)); F.vcu = vc; F.G = gg;
}
enum { I_X = 0, I_MEM, I_NORM_MIX, I_W_IN, I_CONV, I_BIF, I_MLSTM_NORM, I_NORM_MEM, I_W_MEM_KV, I_W_BR_M, I_W_BR_D, I_W_BR_X, I_W_OUT, I_NORM_FFN,
       I_FFN_G, I_FFN_U, I_FFN_D, I_ROUTER, I_MOE_G, I_MOE_U, I_MOE_D, I_NORM_FINAL };

DI void cvt_item(const float* src, int sld, int scol0, bf16* dst, int dld, int drow0, int k0, float scale, LAS float* scr, int lane) {
    f32x4 v[16];
    const float* s0 = src + (size_t)(k0 + (lane >> 4)) * sld + scol0 + 4 * (lane & 15);
#pragma unroll
    for (int i = 0; i < 16; ++i) v[i] = __builtin_nontemporal_load((const f32x4*)(s0 + (size_t)(4 * i) * sld));
#pragma unroll
    for (int i = 0; i < 16; ++i) { LAS float* p = scr + (4 * i + (lane >> 4)) * 65 + 4 * (lane & 15); p[0] = v[i].x * scale; p[1] = v[i].y * scale; p[2] = v[i].z * scale; p[3] = v[i].w * scale; }
    LDS_WAIT(); asm volatile("" ::: "memory");
    const int c = lane & 7;
#pragma unroll
    for (int j = 0; j < 8; ++j) { const int n = (lane >> 3) + 8 * j; const LAS float* s = scr + (8 * c) * 65 + n;
        u32x4 o; o.x = cvt_pk_bf16(s[0], s[65]); o.y = cvt_pk_bf16(s[2 * 65], s[3 * 65]); o.z = cvt_pk_bf16(s[4 * 65], s[5 * 65]); o.w = cvt_pk_bf16(s[6 * 65], s[7 * 65]);
        *(u32x4*)(dst + (size_t)(drow0 + n) * dld + k0 + 8 * c) = o; }
    LDS_WAIT(); asm volatile("" ::: "memory");
}
DI bool proj_tile_bf16(int t) { return t < 4 || (t >= 8 && t < 14) || t == 17 || t == 31; }
constexpr int NBF = 0;
constexpr int D8_MASK = 2;
constexpr int DD8_MASK = 2;
constexpr int N_DEFER = 9;
template <bool I8 = false> DI void cvt_item8(const float* src, int sld, int scol0, unsigned char* dst, int dld, int drow0, int k0, float scale, LAS float* scr, int lane) {
    f32x4 v[16];
    const float* s0 = src + (size_t)(k0 + (lane >> 4)) * sld + scol0 + 4 * (lane & 15);
#pragma unroll
    for (int i = 0; i < 16; ++i) v[i] = __builtin_nontemporal_load((const f32x4*)(s0 + (size_t)(4 * i) * sld));
#pragma unroll
    for (int i = 0; i < 16; ++i) { LAS float* p = scr + (4 * i + (lane >> 4)) * 65 + 4 * (lane & 15); p[0] = v[i].x * scale; p[1] = v[i].y * scale; p[2] = v[i].z * scale; p[3] = v[i].w * scale; }
    LDS_WAIT(); asm volatile("" ::: "memory");
    const int c = lane & 3;
#pragma unroll
    for (int j = 0; j < 4; ++j) { const int n = (lane >> 2) + 16 * j; const LAS float* s = scr + (16 * c) * 65 + n;
        u32x4 o;
        if (I8) { o.x = pk4_i8(s[0], s[65], s[2 * 65], s[3 * 65]); o.y = pk4_i8(s[4 * 65], s[5 * 65], s[6 * 65], s[7 * 65]); o.z = pk4_i8(s[8 * 65], s[9 * 65], s[10 * 65], s[11 * 65]); o.w = pk4_i8(s[12 * 65], s[13 * 65], s[14 * 65], s[15 * 65]); }
        else { o.x = pk4_fp8(s[0], s[65], s[2 * 65], s[3 * 65]); o.y = pk4_fp8(s[4 * 65], s[5 * 65], s[6 * 65], s[7 * 65]); o.z = pk4_fp8(s[8 * 65], s[9 * 65], s[10 * 65], s[11 * 65]); o.w = pk4_fp8(s[12 * 65], s[13 * 65], s[14 * 65], s[15 * 65]); }
        *(u32x4*)(dst + (size_t)(drow0 + n) * dld + k0 + 16 * c) = o; }
    LDS_WAIT(); asm volatile("" ::: "memory");
}
DI void prologue_convert(Frame& F) {
    LAS float* scr = (LAS float*)(F.lds + F.wave * 16640);
    const int gw = F.vcu * 8 + F.wave, NGW = F.G * 8, lane = F.lane;
    unsigned char* ws = F.ws;
    constexpr int PER_L = 2000 + 256 + 128 + 64 + 128 + 256, N_L = 4 * PER_L, PER_D = 3 * 704, N_D = 2 * PER_D, PER_E = 3 * 896, N_E = (16 - N_DEFER) * PER_E;
    for (int it = gw; it < N_L + N_D + N_E; it += NGW) {
        int r = it;
        if (r < N_L) { const int l = r / PER_L; r -= l * PER_L;
            if (r < 2000) { const int kb = r / 125, nb = r % 125, n0 = nb * 64; const int scol = n0 < 2048 ? n0 : (n0 < PC ? n0 + 8 : 2048);
                const float sc = (n0 >= C_QD && n0 < C_KD) ? 0.125f : 1.0f;
                if (l < NBF) cvt_item(F.ka->in[I_W_IN] + (size_t)l * DM * IN_COLS, IN_COLS, scol, (bf16*)(ws + WS_WINB + (size_t)l * 16 * MiB), DM, n0, kb * 64, sc, scr, lane);
                else cvt_item8<true>(F.ka->in[I_W_IN] + (size_t)l * DM * IN_COLS, IN_COLS, scol, ws + WS_WIN + (size_t)l * SZ_WIN, DM, n0, kb * 64, S_W8I, scr, lane);
                continue; }
            r -= 2000;
            if (r < 256) { const int kb = r >> 4, nb = r & 15; cvt_item(F.ka->in[I_W_MEM_KV] + (size_t)l * DM * DM, DM, nb * 64, (bf16*)(ws + WS_WKV) + (size_t)l * DM * DM, DM, nb * 64, kb * 64, 1.f, scr, lane); continue; }
            r -= 256;
            if (r < 128) { const int kb = r >> 4, nb = r & 15; cvt_item(F.ka->in[I_W_BR_M] + (size_t)l * 512 * DM, DM, nb * 64, (bf16*)(ws + WS_WBRM) + (size_t)l * DM * HCW, HCW, nb * 64, kb * 64, 1.f, scr, lane); continue; }
            r -= 128;
            if (r < 64) { const int kb = r >> 4, nb = r & 15; cvt_item(F.ka->in[I_W_BR_D] + (size_t)l * 256 * DM, DM, nb * 64, (bf16*)(ws + WS_WBRM) + (size_t)l * DM * HCW + 512, HCW, nb * 64, kb * 64, 1.f, scr, lane); continue; }
            r -= 64;
            if (r < 128) { const int kb = r >> 4, nb = r & 15; cvt_item(F.ka->in[I_W_BR_X] + (size_t)l * 512 * DM, DM, nb * 64, (bf16*)(ws + WS_WBRM) + (size_t)l * DM * HCW + 768, HCW, nb * 64, kb * 64, 1.f, scr, lane); continue; }
            r -= 128;
            { const int kb = r >> 4, nb = r & 15; cvt_item(F.ka->in[I_W_OUT] + (size_t)l * DM * DM, DM, nb * 64, (bf16*)(ws + WS_WOUT) + (size_t)l * DM * DM, DM, nb * 64, kb * 64, 1.f, scr, lane); continue; }
        }
        r -= N_L;
        if (r < N_D) { const int j = r / PER_D; r -= j * PER_D;
            if (r < 1408) { const int up = r >= 704; if (up) r -= 704; const int kb = r / 44, nb = r % 44, n0 = nb * 64; const int drow = 256 * (n0 >> 7) + (n0 & 127) + (up ? 128 : 0);
                if ((D8_MASK >> j) & 1) cvt_item8<true>(F.ka->in[up ? I_FFN_U : I_FFN_G] + (size_t)j * DM * DFF, DFF, n0, ws + WS_FGU + (size_t)j * SZ_FGU, DM, drow, kb * 64, S_W8I, scr, lane);
                else cvt_item(F.ka->in[up ? I_FFN_U : I_FFN_G] + (size_t)j * DM * DFF, DFF, n0, (bf16*)(ws + WS_FGU + (size_t)j * SZ_FGU), DM, drow, kb * 64, 1.f, scr, lane);
                continue; }
            r -= 1408;
            { const int kb = r >> 4, nb = r & 15;
              if ((DD8_MASK >> j) & 1) cvt_item8<false>(F.ka->in[I_FFN_D] + (size_t)j * DFF * DM, DM, nb * 64, ws + WS_FD + (size_t)j * SZ_FD, DFF, nb * 64, kb * 64, W8_DN, scr, lane);
              else cvt_item(F.ka->in[I_FFN_D] + (size_t)j * DFF * DM, DM, nb * 64, (bf16*)(ws + WS_FD + (size_t)j * SZ_FD), DFF, nb * 64, kb * 64, 1.f, scr, lane);
              continue; }
        }
        r -= N_D;
        { const int jx = r / PER_E; r -= jx * PER_E; const int je = jx < 4 ? jx : jx + 4;
            if (r < 1792) { const int up = r >= 896; if (up) r -= 896; const int kb = r / 56, nb = r % 56, n0 = nb * 64; const int drow = 256 * (n0 >> 7) + (n0 & 127) + (up ? 128 : 0);
                cvt_item8<true>(F.ka->in[up ? I_MOE_U : I_MOE_G] + (size_t)je * DM * DFE, DFE, n0, ws + WS_MGU + (size_t)je * SZ_MGU_E, DM, drow, kb * 64, S_W8I, scr, lane); continue; }
            r -= 1792;
            { const int kb = r >> 4, nb = r & 15; cvt_item8<false>(F.ka->in[I_MOE_D] + (size_t)je * DFE * DM, DM, nb * 64, ws + WS_MD + (size_t)je * SZ_MD_E, DFE, nb * 64, kb * 64, W8_DN, scr, lane); continue; }
        }
    }
    for (int rw = gw; rw < 4 * NMEM; rw += NGW) { const int l = rw >> 8, m = rw & 255;
        const f32x4* xr = (const f32x4*)(F.ka->in[I_MEM] + (size_t)m * DM) + lane; const f32x4* gr = (const f32x4*)(F.ka->in[I_NORM_MEM] + (size_t)l * DM) + lane;
        f32x4 v[4]; float s = 0.f;
#pragma unroll
        for (int j = 0; j < 4; ++j) { v[j] = xr[64 * j]; s += (v[j].x * v[j].x + v[j].y * v[j].y) + (v[j].z * v[j].z + v[j].w * v[j].w); }
        const float rstd = 1.0f / sqrtf(wave_sum(s, lane) * (1.f / DM) + EPS);
        u32x2* o8 = (u32x2*)((bf16*)(ws + WS_MEMN) + (size_t)rw * DM) + lane;
#pragma unroll
        for (int j = 0; j < 4; ++j) { const f32x4 g = gr[64 * j]; u32x2 w; w.x = cvt_pk_bf16(v[j].x * rstd * g.x, v[j].y * rstd * g.y); w.y = cvt_pk_bf16(v[j].z * rstd * g.z, v[j].w * rstd * g.w); o8[64 * j] = w; }
    }
}

DI void convert_moe_expert(Frame& F, int je0, int rank, int nranks, int nexp = 1) {
    LAS float* scr = (LAS float*)(F.lds + F.wave * 16640);
    const int lane = F.lane; unsigned char* ws = F.ws;
    for (int it = rank * 8 + F.wave; it < nexp * 3 * 896; it += nranks * 8) {
        const int je = je0 + it / (3 * 896); int r = it % (3 * 896);
        if (r < 1792) { const int up = r >= 896; if (up) r -= 896; const int kb = r / 56, nb = r % 56, n0 = nb * 64; const int drow = 256 * (n0 >> 7) + (n0 & 127) + (up ? 128 : 0);
            cvt_item8<true>(F.ka->in[up ? I_MOE_U : I_MOE_G] + (size_t)je * DM * DFE, DFE, n0, ws + WS_MGU + (size_t)je * SZ_MGU_E, DM, drow, kb * 64, S_W8I, scr, lane); continue; }
        r -= 1792;
        { const int kb = r >> 4, nb = r & 15; cvt_item8<false>(F.ka->in[I_MOE_D] + (size_t)je * DFE * DM, DM, nb * 64, ws + WS_MD + (size_t)je * SZ_MD_E, DFE, nb * 64, kb * 64, W8_DN, scr, lane); }
    }
}

DI void reduce8(float (&d)[8], int lane) {
    float r4[4], r2[2], p;
    { const bool hi = lane & 32;
#pragma unroll
      for (int i = 0; i < 4; ++i) { const float send = hi ? d[i] : d[i + 4], keep = hi ? d[i + 4] : d[i]; r4[i] = keep + shx(send, 32, lane); } }
    { const bool hi = lane & 16;
#pragma unroll
      for (int i = 0; i < 2; ++i) { const float send = hi ? r4[i] : r4[i + 2], keep = hi ? r4[i + 2] : r4[i]; r2[i] = keep + shx(send, 16, lane); } }
    { const bool hi = lane & 8; const float send = hi ? r2[0] : r2[1], keep = hi ? r2[1] : r2[0]; p = keep + shx(send, 8, lane); }
    p += shx(p, 4, lane); p += shx(p, 2, lane); p += shx(p, 1, lane);
#pragma unroll
    for (int i = 0; i < 8; ++i) d[i] = shidx(p, ((i >> 2) & 1) * 32 + ((i >> 1) & 1) * 16 + (i & 1) * 8, lane);
}
template <bool ADD_YS, bool WRITE_X, int DOTS, bool FINAL, int U8 = 0  , bool XINB = true  >
DI void norm_phase(Frame& F, const void* xin, bf16* xout, const float* gain, bf16* U, float* outF, const float* wsm, int wld, int moe_j) {
    constexpr int RB = DOTS ? (XINB ? 4 : 1) : (ADD_YS ? 2 : 4);
    const int lane = F.lane;
    f32x4 g[4];
#pragma unroll
    for (int j = 0; j < 4; ++j) g[j] = *((const f32x4*)gain + 64 * j + lane);
    float wreg[DOTS ? 16 : 1][8];
    if (DOTS) {
#pragma unroll
        for (int j = 0; j < 4; ++j)
#pragma unroll
            for (int e = 0; e < 4; ++e) { const float* p = wsm + (size_t)(256 * j + 4 * lane + e) * wld; const f32x4 a = *(const f32x4*)p, b = *(const f32x4*)(p + 4);
                wreg[j * 4 + e][0] = a.x; wreg[j * 4 + e][1] = a.y; wreg[j * 4 + e][2] = a.z; wreg[j * 4 + e][3] = a.w; wreg[j * 4 + e][4] = b.x; wreg[j * 4 + e][5] = b.y; wreg[j * 4 + e][6] = b.z; wreg[j * 4 + e][7] = b.w; }
    }
    const bf16* ys = (const bf16*)(F.ws + WS_YS);
    LAS int* sel_e = (LAS int*)(F.lds); LAS int* sel_lp = sel_e + 128; LAS float* sel_g = (LAS float*)(sel_lp + 128);
    for (int rb = F.vcu; rb < SEQ / 64; rb += F.G) {
        LAS unsigned* rowl = (LAS unsigned*)(F.lds + 4096) + F.wave * 2048;
        if (DOTS == 2) { if (F.tid < 8) F.lc[LC_LC + F.tid] = 0u; __syncthreads(); }
        for (int i0 = 0; i0 < 8; i0 += RB) {
            f32x4 v[RB][4]; u32x2 xraw[XINB ? RB : 1][4]; u32x2 y0[ADD_YS ? RB : 1][4], y1[ADD_YS ? RB : 1][4];
#pragma unroll
            for (int r = 0; r < RB; ++r) { const int row = rb * 64 + F.wave * 8 + i0 + r;
#pragma unroll
                for (int j = 0; j < 4; ++j) {
                    if (XINB) xraw[r][j] = __builtin_nontemporal_load((const u32x2*)((const bf16*)xin + (size_t)row * DM) + 64 * j + lane);
                    else v[r][j] = __builtin_nontemporal_load((const f32x4*)((const float*)xin + (size_t)row * DM) + 64 * j + lane);
                    if (ADD_YS) { y0[r][j] = __builtin_nontemporal_load((const u32x2*)(ys + (size_t)row * DM) + 64 * j + lane); y1[r][j] = __builtin_nontemporal_load((const u32x2*)(ys + (size_t)(SEQ + row) * DM) + 64 * j + lane); } } }
#pragma unroll
            for (int r = 0; r < RB; ++r) {
                const int rl = F.wave * 8 + i0 + r, row = rb * 64 + rl;
                float ss = 0.f;
#pragma unroll
                for (int j = 0; j < 4; ++j) {
                    if (XINB) { const u32x2 xr = xraw[r][j]; v[r][j] = (f32x4){bflo(xr.x), bfhi(xr.x), bflo(xr.y), bfhi(xr.y)}; }
                    if (ADD_YS) { v[r][j].x += bflo(y0[r][j].x) + bflo(y1[r][j].x); v[r][j].y += bfhi(y0[r][j].x) + bfhi(y1[r][j].x); v[r][j].z += bflo(y0[r][j].y) + bflo(y1[r][j].y); v[r][j].w += bfhi(y0[r][j].y) + bfhi(y1[r][j].y); }
                    if (WRITE_X) { u32x2 xw; xw.x = cvt_pk_bf16(v[r][j].x, v[r][j].y); xw.y = cvt_pk_bf16(v[r][j].z, v[r][j].w); *((u32x2*)(xout + (size_t)row * DM) + 64 * j + lane) = xw;
                        v[r][j] = (f32x4){bflo(xw.x), bfhi(xw.x), bflo(xw.y), bfhi(xw.y)}; }
                    ss += (v[r][j].x * v[r][j].x + v[r][j].y * v[r][j].y) + (v[r][j].z * v[r][j].z + v[r][j].w * v[r][j].w); }
                const float rstd = 1.0f / sqrtf(wave_sum(ss, lane) * (1.f / DM) + EPS);
#pragma unroll
                for (int j = 0; j < 4; ++j) { v[r][j] = v[r][j] * g[j];
                    if (FINAL) __builtin_nontemporal_store(v[r][j] * rstd, (f32x4*)(outF + (size_t)row * DM) + 64 * j + lane);
                    else if (DOTS == 2) rowl[(i0 + r) * 256 + 64 * j + lane] = pk4_i8(v[r][j].x * (rstd * S_U8), v[r][j].y * (rstd * S_U8), v[r][j].z * (rstd * S_U8), v[r][j].w * (rstd * S_U8));
                    else if (U8 == 1) *((unsigned*)((unsigned char*)U + (size_t)row * DM) + 64 * j + lane) = pk4_i8(v[r][j].x * (rstd * S_U8), v[r][j].y * (rstd * S_U8), v[r][j].z * (rstd * S_U8), v[r][j].w * (rstd * S_U8));
                    else { if (U8 == 2) *((unsigned*)(F.ws + WS_U8 + (size_t)row * DM) + 64 * j + lane) = pk4_i8(v[r][j].x * (rstd * S_U8), v[r][j].y * (rstd * S_U8), v[r][j].z * (rstd * S_U8), v[r][j].w * (rstd * S_U8)); u32x2 w; w.x = cvt_pk_bf16(v[r][j].x * rstd, v[r][j].y * rstd); w.y = cvt_pk_bf16(v[r][j].z * rstd, v[r][j].w * rstd); *((u32x2*)(U + (size_t)row * DM) + 64 * j + lane) = w; } }
                if (DOTS == 2) {
                    float d[8];
#pragma unroll
                    for (int c = 0; c < 8; ++c) d[c] = 0.f;
#pragma unroll
                    for (int j = 0; j < 4; ++j)
#pragma unroll
                        for (int c = 0; c < 8; ++c) d[c] += v[r][j].x * wreg[j * 4 + 0][c] + v[r][j].y * wreg[j * 4 + 1][c] + v[r][j].z * wreg[j * 4 + 2][c] + v[r][j].w * wreg[j * 4 + 3][c];
                    reduce8(d, lane);
                    int e0 = 0; float l0 = d[0];
#pragma unroll
                    for (int c = 1; c < 8; ++c) if (d[c] > l0) { l0 = d[c]; e0 = c; }
                    int e1 = -1; float l1 = -3.0e38f;
#pragma unroll
                    for (int c = 0; c < 8; ++c) if (c != e0 && d[c] > l1) { l1 = d[c]; e1 = c; }
                    const float g0 = 1.0f / (1.0f + __expf((l1 - l0) * rstd)), g1 = 1.0f - g0;
                    if (lane < 2) { const int e = lane ? e1 : e0;
                        const unsigned lp = __hip_atomic_fetch_add((LAS unsigned*)&F.lc[LC_LC + e], 1u, __ATOMIC_RELAXED, __HIP_MEMORY_SCOPE_WORKGROUP);
                        sel_e[rl * 2 + lane] = e; sel_lp[rl * 2 + lane] = (int)lp; sel_g[rl * 2 + lane] = lane ? g1 : g0; }
                }
            }
        }
        if (DOTS == 2) {
            __syncthreads();
            if (F.tid < 8) { const unsigned n = F.lc[LC_LC + F.tid]; F.lc[LC_BASE + F.tid] = xb_add(F.ctl + CW_MOE + (moe_j * 8 + F.tid) * 64, n); }
            __syncthreads();
            if (F.tid < 128) { const int e = sel_e[F.tid], pos = (int)F.lc[LC_BASE + e] + sel_lp[F.tid];
                ((int*)(F.ws + WS_TOKE))[e * SEQ + pos] = (rb * 64 + (F.tid >> 1)) | ((F.tid & 1) << 20);
                ((float*)(F.ws + WS_GATEE))[e * SEQ + pos] = sel_g[F.tid]; }
            unsigned char* u8s = F.ws + WS_U8S;
#pragma unroll
            for (int i = 0; i < 8; ++i)
#pragma unroll
                for (int sl = 0; sl < 2; ++sl) { const int si = (F.wave * 8 + i) * 2 + sl; const int e = sel_e[si], pos = (int)F.lc[LC_BASE + e] + sel_lp[si];
                    unsigned* dst = (unsigned*)(u8s + ((size_t)e * SEQ + pos) * DM) + lane;
#pragma unroll
                    for (int j = 0; j < 4; ++j) dst[64 * j] = rowl[i * 256 + 64 * j + lane]; }
            __syncthreads();
        }
    }
}

DI bf16x8 ld_bf16x8(const bf16* p) { return __builtin_bit_cast(bf16x8, *(const u32x4*)p); }
DI bf16x8 pack_p(const f32x4& a, const f32x4& b) { u32x4 w; w.x = cvt_pk_bf16(a[0], a[1]); w.y = cvt_pk_bf16(a[2], a[3]); w.z = cvt_pk_bf16(b[0], b[1]); w.w = cvt_pk_bf16(b[2], b[3]); return __builtin_bit_cast(bf16x8, w); }
DI bf16x8 lds_frag_perm(ldsp rowp, int koff_bytes) {
    const u32x2 lo = *(const LAS u32x2*)(rowp + koff_bytes), hi = *(const LAS u32x2*)(rowp + koff_bytes + 32);
    u32x4 w; w.x = lo.x; w.y = lo.y; w.z = hi.x; w.w = hi.y; return __builtin_bit_cast(bf16x8, w);
}

typedef short s16x4 __attribute__((ext_vector_type(4)));
DI bf16x8 lds_frag_tr(ldsp lo, ldsp hi) {
    const s16x4 a = __builtin_amdgcn_ds_read_tr16_b64_v4i16((LAS s16x4*)lo), b = __builtin_amdgcn_ds_read_tr16_b64_v4i16((LAS s16x4*)hi);
    return __builtin_shufflevector(a, b, 0, 1, 2, 3, 4, 5, 6, 7);
}
DI void memattn_phase(Frame& F, int l) {
    ldsp Ks = F.lds, Vt = F.lds + 69632;
    const bf16* xq = (const bf16*)(F.ws + WS_XQ); bf16* hx_out = (bf16*)(F.ws + WS_HCAT) + 768;
    const int tid = F.tid, lane = F.lane, fr = lane & 15, fq = lane >> 4;
    for (int unit = F.vcu; unit < 256; unit += F.G) {
        const int hx = unit >> 6, rb = unit & 63;
        const bf16* km = (const bf16*)(F.ws + WS_KM) + (size_t)l * 256 * 512 + hx * 128;
        const bf16* vt = (const bf16*)(F.ws + WS_VMT) + (size_t)l * 512 * 256 + (size_t)hx * 128 * 256;
#pragma unroll
        for (int it = 0; it < 8; ++it) { const int i = tid + it * 512, r = i >> 4, c8 = i & 15; *(LAS u32x4*)(Ks + r * 272 + c8 * 16) = *(const u32x4*)(km + (size_t)r * 512 + c8 * 8); }
#pragma unroll
        for (int it = 0; it < 8; ++it) { const int i = tid + it * 512, r = i >> 5, c8 = i & 31; *(LAS u32x4*)(Vt + r * 528 + c8 * 16) = *(const u32x4*)(vt + (size_t)r * 256 + c8 * 8); }
        __syncthreads();
        for (int pass = 0; pass < 2; ++pass) {
            const int row = rb * 256 + F.wave * 32 + pass * 16 + fr;
            bf16x8 q[4];
#pragma unroll
            for (int ks = 0; ks < 4; ++ks) q[ks] = ld_bf16x8(xq + ((size_t)hx * SEQ + row) * 128 + ks * 32 + fq * 8);
            f32x4 s[16];
#pragma unroll
            for (int t = 0; t < 16; ++t) { s[t] = (f32x4){0.f, 0.f, 0.f, 0.f};
#pragma unroll
                for (int ks = 0; ks < 4; ++ks) s[t] = MFMA16(*(const LAS bf16x8*)(Ks + (16 * t + fr) * 272 + (ks * 32 + fq * 8) * 2), q[ks], s[t]); }
            float mx = -3.0e38f;
#pragma unroll
            for (int t = 0; t < 16; ++t) mx = fmaxf(mx, fmaxf(fmaxf(s[t][0], s[t][1]), fmaxf(s[t][2], s[t][3])));
            mx = fmaxf(mx, shx(mx, 16, lane)); mx = fmaxf(mx, shx(mx, 32, lane));
            float sum = 0.f;
#pragma unroll
            for (int t = 0; t < 16; ++t)
#pragma unroll
                for (int r = 0; r < 4; ++r) { s[t][r] = fexp(s[t][r] - mx); sum += s[t][r]; }
            sum += shx(sum, 16, lane); sum += shx(sum, 32, lane);
            f32x4 o[8];
#pragma unroll
            for (int tv = 0; tv < 8; ++tv) o[tv] = (f32x4){0.f, 0.f, 0.f, 0.f};
#pragma unroll
            for (int k2 = 0; k2 < 8; ++k2) { const bf16x8 pf = pack_p(s[2 * k2], s[2 * k2 + 1]);
#pragma unroll
                for (int tv = 0; tv < 8; ++tv) o[tv] = MFMA16(lds_frag_perm(Vt + (16 * tv + fr) * 528, (32 * k2 + 4 * fq) * 2), pf, o[tv]); }
            const float inv = 1.0f / sum;
#pragma unroll
            for (int tv = 0; tv < 8; ++tv) { u32x2 w; w.x = cvt_pk_bf16(o[tv][0] * inv, o[tv][1] * inv); w.y = cvt_pk_bf16(o[tv][2] * inv, o[tv][3] * inv);
                *(u32x2*)(hx_out + (size_t)row * HCW + hx * 128 + 16 * tv + 4 * fq) = w; }
        }
        __syncthreads();
    }
}

#define DIL_DECODE(ud_, g_, r_, s0_, gh_, sh_) const int g_ = (ud_) >> 9, rem_##g_ = (ud_) & 511, sh_ = 2 * g_, nbs_##g_ = 7 - sh_, blk_##g_ = rem_##g_ & 127, \
        r_ = blk_##g_ >> nbs_##g_, s0_ = (blk_##g_ & ((1 << nbs_##g_) - 1)) * 128, gh_ = g_ * 4 + (rem_##g_ >> 7)
#define DIL_ISSUE(ud_) do { DIL_DECODE(ud_, gN, rN, s0N, ghN, shN); const size_t pb = (size_t)rN << (14 - shN); \
        _Pragma("unroll") for (int it = 0; it < 4; ++it) { const int i = tid + it * 512, jl = i >> 3, c8 = i & 7, sp = s0N - 128 + jl; kreg[it] = (u32x4){0u, 0u, 0u, 0u}; vreg[it] = (u32x4){0u, 0u, 0u, 0u}; \
            if (sp >= 0) { kreg[it] = *(const u32x4*)(dq + ((size_t)(12 + ghN) * SEQ + pb + sp) * 64 + c8 * 8); vreg[it] = *(const u32x4*)(dq + ((size_t)(24 + ghN) * SEQ + pb + sp) * 64 + c8 * 8); } } \
        { const bf16* qp = dq + ((size_t)ghN * SEQ + pb + s0N + 16 * w + fr) * 64 + fq * 8; qreg[0] = *(const u32x4*)qp; qreg[1] = *(const u32x4*)(qp + 32); } } while (0)
DI void dilated_phase(Frame& F) {
    ldsp Kd = F.lds, Vd = F.lds + 36864;
    const bf16* dq = (const bf16*)(F.ws + WS_DQ); bf16* od = (bf16*)(F.ws + WS_OD); float* lse = (float*)(F.ws + WS_LSE);
    const int tid = F.tid, lane = F.lane, fr = lane & 15, fq = lane >> 4, w = F.wave;
    for (int i = tid; i < 24 * 36; i += 512) *(LAS unsigned*)(Vd + 256 * 144 + i * 4) = 0u;
    u32x4 kreg[4], vreg[4], qreg[2];
    int ud = F.vcu;
    if (ud < 1536) DIL_ISSUE(ud);
    for (; ud < 1536; ud += F.G) {
        DIL_DECODE(ud, g, r, s0, gh, sh);
#pragma unroll
        for (int it = 0; it < 4; ++it) { const int i = tid + it * 512, jl = i >> 3, c8 = i & 7; *(LAS u32x4*)(Kd + jl * 144 + c8 * 16) = kreg[it]; *(LAS u32x4*)(Vd + jl * 144 + c8 * 16) = vreg[it]; }
        bf16x8 q[2]; q[0] = __builtin_bit_cast(bf16x8, qreg[0]); q[1] = __builtin_bit_cast(bf16x8, qreg[1]);
        __syncthreads();
        { const int un = ud + F.G; if (un < 1536) DIL_ISSUE(un); }
        {
            const int qs = s0 + 16 * w + fr; const size_t qtok = (size_t)((qs << sh) + r);
            f32x4 s[10];
#pragma unroll
            for (int t = 0; t < 9; ++t) { s[t] = (f32x4){0.f, 0.f, 0.f, 0.f};
#pragma unroll
                for (int ks = 0; ks < 2; ++ks) s[t] = MFMA16(*(const LAS bf16x8*)(Kd + (16 * w + 16 * t + fr) * 144 + (ks * 32 + fq * 8) * 2), q[ks], s[t]); }
            s[9] = (f32x4){0.f, 0.f, 0.f, 0.f};
            float mx = -3.0e38f;
#pragma unroll
            for (int t = 0; t < 9; ++t)
#pragma unroll
                for (int rg = 0; rg < 4; ++rg) { const int jj = 16 * t + 4 * fq + rg; const bool ok = (jj >= fr) && (jj <= 128 + fr) && (s0 - 128 + 16 * w + jj >= 0);
                    s[t][rg] = ok ? s[t][rg] : -1.0e30f; mx = fmaxf(mx, s[t][rg]); }
            mx = fmaxf(mx, shx(mx, 16, lane)); mx = fmaxf(mx, shx(mx, 32, lane));
            float sum = 0.f;
#pragma unroll
            for (int t = 0; t < 9; ++t)
#pragma unroll
                for (int rg = 0; rg < 4; ++rg) { s[t][rg] = fexp(s[t][rg] - mx); sum += s[t][rg]; }
            sum += shx(sum, 16, lane); sum += shx(sum, 32, lane);
            f32x4 o[4];
#pragma unroll
            for (int tv = 0; tv < 4; ++tv) o[tv] = (f32x4){0.f, 0.f, 0.f, 0.f};
#pragma unroll
            for (int k2 = 0; k2 < 5; ++k2) { const bf16x8 pf = pack_p(s[2 * k2], s[2 * k2 + 1]);
#pragma unroll
                for (int tv = 0; tv < 4; ++tv) { ldsp lo = Vd + (16 * w + 32 * k2 + 4 * fq + (fr >> 2)) * 144 + (16 * tv + 4 * (fr & 3)) * 2; o[tv] = MFMA16(lds_frag_tr(lo, lo + 16 * 144), pf, o[tv]); } }
            const float inv = 1.0f / sum;
#pragma unroll
            for (int tv = 0; tv < 4; ++tv) { u32x2 ww; ww.x = cvt_pk_bf16(o[tv][0] * inv, o[tv][1] * inv); ww.y = cvt_pk_bf16(o[tv][2] * inv, o[tv][3] * inv);
                *(u32x2*)(od + qtok * 768 + gh * 64 + 16 * tv + 4 * fq) = ww; }
            if (fq == 0) lse[qtok * 12 + gh] = mx + __logf(sum);
        }
        __syncthreads();
    }
}

DI void gate_scan(const float* ifg, int t0, int h, int lane, float& a0, float& a1, float& cum0, float& cum1, float& total, float& maxa) {
    const float* p0 = ifg + (size_t)(t0 + 2 * lane) * 8; const float i0 = p0[h], lf0 = p0[4 + h], i1 = p0[8 + h], lf1 = p0[12 + h];
    const float s = lf0 + lf1; float incl = s;
#pragma unroll
    for (int off = 1; off < 64; off <<= 1) { const float t = shup(incl, off, lane); if (lane >= off) incl += t; }
    const float excl = incl - s; cum0 = excl + lf0; cum1 = incl; a0 = i0 - cum0; a1 = i1 - cum1;
    total = shidx(incl, 63, lane); maxa = wave_max(fmaxf(a0, a1), lane);
}
DI void mlstm_delta_phase(Frame& F, int l) {
    ldsp Kimg = F.lds, Vimg = F.lds + 34816; LAS float* w_s = (LAS float*)(F.lds + 69632);
    const bf16* mq = (const bf16*)(F.ws + WS_MQ); bf16* qkc = (bf16*)(F.ws + WS_QKC); const float* ifg = (const float*)(F.ws + WS_IFG);
    const float* convw = F.ka->in[I_CONV] + (size_t)l * 4 * 1024;
    const int tid = F.tid, lane = F.lane, fr = lane & 15, fq = lane >> 4, w = F.wave;
    for (int unit = F.vcu; unit < 512; unit += F.G) {
        const int c = unit >> 2, h = unit & 3, t0 = c * 128;
        const int cs = tid & 15, rg = tid >> 4, l0 = rg * 4;
        u32x4 xrr[2][7], vv[4];
#pragma unroll
        for (int which = 0; which < 2; ++which)
#pragma unroll
            for (int i = 0; i < 7; ++i) { const int row = t0 + l0 - 3 + i; xrr[which][i] = (u32x4){0u, 0u, 0u, 0u}; if (row >= 0) xrr[which][i] = *(const u32x4*)(mq + ((size_t)(which * 4 + h) * SEQ + row) * 128 + cs * 8); }
#pragma unroll
        for (int it = 0; it < 4; ++it) { const int i = tid + it * 512, lr = i >> 4, c8 = i & 15; vv[it] = *(const u32x4*)(mq + ((size_t)(8 + h) * SEQ + t0 + lr) * 128 + c8 * 8); }
        f32x4 cwv[2][4][2];
#pragma unroll
        for (int which = 0; which < 2; ++which)
#pragma unroll
            for (int j = 0; j < 4; ++j) { const float* p = convw + j * 1024 + which * 512 + h * 128 + cs * 8; cwv[which][j][0] = *(const f32x4*)p; cwv[which][j][1] = *(const f32x4*)(p + 4); }
        if (w == 0) { float a0, a1, c0, c1, total, maxa; gate_scan(ifg, t0, h, lane, a0, a1, c0, c1, total, maxa);
            w_s[2 * lane] = fexp(a0 - maxa); w_s[2 * lane + 1] = fexp(a1 - maxa);
            if (lane == 0) { float* sm = (float*)(F.ws + WS_SUMM) + (c * 4 + h) * 2; sm[0] = total; sm[1] = maxa; } }
#pragma unroll
        for (int which = 0; which < 2; ++which) {
            float cw[4][8];
#pragma unroll
            for (int j = 0; j < 4; ++j) { const f32x4 a = cwv[which][j][0], b = cwv[which][j][1];
                cw[j][0] = a.x; cw[j][1] = a.y; cw[j][2] = a.z; cw[j][3] = a.w; cw[j][4] = b.x; cw[j][5] = b.y; cw[j][6] = b.z; cw[j][7] = b.w; }
            const u32x4 (&xr)[7] = xrr[which];
#pragma unroll
            for (int o = 0; o < 4; ++o) { float acc[8];
#pragma unroll
                for (int e = 0; e < 8; ++e) acc[e] = 0.f;
#pragma unroll
                for (int j = 0; j < 4; ++j) { const u32x4 x = xr[o + j];
                    acc[0] += cw[j][0] * bflo(x.x); acc[1] += cw[j][1] * bfhi(x.x); acc[2] += cw[j][2] * bflo(x.y); acc[3] += cw[j][3] * bfhi(x.y);
                    acc[4] += cw[j][4] * bflo(x.z); acc[5] += cw[j][5] * bfhi(x.z); acc[6] += cw[j][6] * bflo(x.w); acc[7] += cw[j][7] * bfhi(x.w); }
#pragma unroll
                for (int e = 0; e < 8; ++e) { acc[e] = siluf_(acc[e]); if (which) acc[e] *= RS128; }
                u32x4 ww; ww.x = cvt_pk_bf16(acc[0], acc[1]); ww.y = cvt_pk_bf16(acc[2], acc[3]); ww.z = cvt_pk_bf16(acc[4], acc[5]); ww.w = cvt_pk_bf16(acc[6], acc[7]);
                *(u32x4*)(qkc + ((size_t)(which * 4 + h) * SEQ + t0 + l0 + o) * 128 + cs * 8) = ww;
                if (which) *(LAS u32x4*)(Kimg + (l0 + o) * 272 + cs * 16) = ww; } }
        __syncthreads();
#pragma unroll
        for (int it = 0; it < 4; ++it) { const int i = tid + it * 512, lr = i >> 4, c8 = i & 15; const u32x4 v = vv[it]; const float ww = w_s[lr];
            u32x4 p; p.x = cvt_pk_bf16(bflo(v.x) * ww, bfhi(v.x) * ww); p.y = cvt_pk_bf16(bflo(v.y) * ww, bfhi(v.y) * ww); p.z = cvt_pk_bf16(bflo(v.z) * ww, bfhi(v.z) * ww); p.w = cvt_pk_bf16(bflo(v.w) * ww, bfhi(v.w) * ww);
            *(LAS u32x4*)(Vimg + lr * 272 + c8 * 16) = p; }
        __syncthreads();
        { f32x4 acc[8];
#pragma unroll
          for (int t = 0; t < 8; ++t) acc[t] = (f32x4){0.f, 0.f, 0.f, 0.f};
#pragma unroll
          for (int ks = 0; ks < 4; ++ks) { const int rowb = (32 * ks + 8 * fq + (fr >> 2)) * 272 + 8 * (fr & 3);
            ldsp vb = Vimg + rowb + 32 * w; const bf16x8 bfrag = lds_frag_tr(vb, vb + 4 * 272);
#pragma unroll
            for (int t = 0; t < 8; ++t) { ldsp ka = Kimg + rowb + 32 * t; acc[t] = MFMA16(lds_frag_tr(ka, ka + 4 * 272), bfrag, acc[t]); } }
          bf16* dl = (bf16*)(F.ws + WS_DELTA) + ((size_t)(c * 4 + h) * 128 + 16 * w + fr) * 128 + 4 * fq;
#pragma unroll
          for (int t = 0; t < 8; ++t) { u32x2 dw; dw.x = cvt_pk_bf16(acc[t][0], acc[t][1]); dw.y = cvt_pk_bf16(acc[t][2], acc[t][3]); *(u32x2*)(dl + 16 * t) = dw; }
        }
        if (tid < 128) { float sacc = 0.f;
#pragma unroll 8
            for (int j = 0; j < 128; ++j) sacc += w_s[j] * bf2f(*(const LAS bf16*)(Kimg + j * 272 + tid * 2));
            ((float*)(F.ws + WS_ND))[(c * 4 + h) * 128 + tid] = sacc; }
        __syncthreads();
    }
}
DI void scan_phase(Frame& F) {
    LAS float* dec = (LAS float*)F.lds; LAS float* scl = dec + 512;
    const int tid = F.tid, lane = F.lane, w = F.wave;
    if (w < 4) { const int h = w; const float* sm = (const float*)(F.ws + WS_SUMM);
        const float tot0 = sm[((2 * lane) * 4 + h) * 2], mxa0 = sm[((2 * lane) * 4 + h) * 2 + 1], tot1 = sm[((2 * lane + 1) * 4 + h) * 2], mxa1 = sm[((2 * lane + 1) * 4 + h) * 2 + 1];
        const float s = tot0 + tot1; float incl = s;
#pragma unroll
        for (int off = 1; off < 64; off <<= 1) { const float t = shup(incl, off, lane); if (lane >= off) incl += t; }
        const float excl = incl - s, T0 = excl + tot0, T1 = incl;
        const float b0 = mxa0 - excl, b1 = mxa1 - T0; float inclm = fmaxf(b0, b1);
#pragma unroll
        for (int off = 1; off < 64; off <<= 1) { const float t = shup(inclm, off, lane); if (lane >= off) inclm = fmaxf(inclm, t); }
        float exclm = shup(inclm, 1, lane); if (lane == 0) exclm = -1.0e30f;
        const float m0 = T0 + fmaxf(exclm, b0), m1 = T1 + inclm;
        float mprev = shup(m1, 1, lane); if (lane == 0) mprev = -1.0e30f;
        const float A0 = fmaxf(mprev, mxa0), A1 = fmaxf(m0, mxa1);
        dec[h * 128 + 2 * lane] = fexp(mprev - A0); scl[h * 128 + 2 * lane] = fexp(mxa0 - A0);
        dec[h * 128 + 2 * lane + 1] = fexp(m0 - A1); scl[h * 128 + 2 * lane + 1] = fexp(mxa1 - A1);
        if (F.vcu == 0) { float* mst = (float*)(F.ws + WS_MST); mst[(2 * lane) * 4 + h] = mprev; mst[(2 * lane + 1) * 4 + h] = m0; }
    }
    __syncthreads();
    if (w < 4) {
        const bf16* delta = (const bf16*)(F.ws + WS_DELTA); bf16* cst = (bf16*)(F.ws + WS_CST);
        const float* nd = (const float*)(F.ws + WS_ND); float* nst = (float*)(F.ws + WS_NST);
        for (int e = F.vcu * 256 + tid; e < 65536 + 512; e += F.G * 256) {
            if (e < 65536) { const int h = e >> 14, vd = e & 16383; float C = 0.f;
                for (int c0 = 0; c0 < 128; c0 += 32) { float dv[32];
#pragma unroll
                    for (int j = 0; j < 32; ++j) dv[j] = bf2f(delta[(size_t)((c0 + j) * 4 + h) * 16384 + vd]);
#pragma unroll
                    for (int j = 0; j < 32; ++j) { const float Cin = C; C = dec[h * 128 + c0 + j] * C + scl[h * 128 + c0 + j] * dv[j]; dv[j] = Cin; }
#pragma unroll
                    for (int j = 0; j < 32; ++j) cst[(size_t)((c0 + j) * 4 + h) * 16384 + vd] = (bf16)(cvt_pk_bf16(dv[j], 0.f) & 0xffff); }
            } else { const int idx = e - 65536, h = idx >> 7, d = idx & 127; float n = 0.f;
                for (int c0 = 0; c0 < 128; c0 += 32) { float dv[32];
#pragma unroll
                    for (int j = 0; j < 32; ++j) dv[j] = nd[((c0 + j) * 4 + h) * 128 + d];
#pragma unroll
                    for (int j = 0; j < 32; ++j) { const float nin = n; n = dec[h * 128 + c0 + j] * n + scl[h * 128 + c0 + j] * dv[j]; dv[j] = nin; }
#pragma unroll
                    for (int j = 0; j < 32; ++j) nst[((c0 + j) * 4 + h) * 128 + d] = dv[j]; } }
        }
    } else {
        const bf16* od = (const bf16*)(F.ws + WS_OD); const float* lse = (const float*)(F.ws + WS_LSE); bf16* hd = (bf16*)(F.ws + WS_HCAT) + 512;
        const int hh = lane >> 4, dv4 = (lane & 15) * 4;
        for (int tok = F.vcu * 4 + (w - 4); tok < SEQ; tok += F.G * 4) {
            const float l0 = lse[(size_t)tok * 12 + hh], l1 = lse[(size_t)tok * 12 + 4 + hh], l2 = lse[(size_t)tok * 12 + 8 + hh];
            const float mx = fmaxf(l0, fmaxf(l1, l2)); float w0 = fexp(l0 - mx), w1 = fexp(l1 - mx), w2 = fexp(l2 - mx); const float inv = 1.0f / (w0 + w1 + w2); w0 *= inv; w1 *= inv; w2 *= inv;
            const u32x2 o0 = *(const u32x2*)(od + (size_t)tok * 768 + hh * 64 + dv4), o1 = *(const u32x2*)(od + (size_t)tok * 768 + 256 + hh * 64 + dv4), o2 = *(const u32x2*)(od + (size_t)tok * 768 + 512 + hh * 64 + dv4);
            u32x2 r; r.x = cvt_pk_bf16(w0 * bflo(o0.x) + w1 * bflo(o1.x) + w2 * bflo(o2.x), w0 * bfhi(o0.x) + w1 * bfhi(o1.x) + w2 * bfhi(o2.x));
            r.y = cvt_pk_bf16(w0 * bflo(o0.y) + w1 * bflo(o1.y) + w2 * bflo(o2.y), w0 * bfhi(o0.y) + w1 * bfhi(o1.y) + w2 * bfhi(o2.y));
            *(u32x2*)(hd + (size_t)tok * HCW + hh * 64 + dv4) = r;
        }
    }
    __syncthreads();
}
DI void mlstm_out_phase(Frame& F, int l) {
    ldsp Ks = F.lds, Vimg = F.lds + 34816, Cs = F.lds + 73728;
    LAS float* a_s = (LAS float*)(F.lds + 113152); LAS float* A_s = a_s + 128; LAS float* wi_s = A_s + 128; LAS float* emr_s = wi_s + 128;
    const bf16* mq = (const bf16*)(F.ws + WS_MQ); const bf16* qkc = (const bf16*)(F.ws + WS_QKC); const float* ifg = (const float*)(F.ws + WS_IFG);
    const bf16* cst = (const bf16*)(F.ws + WS_CST); const float* nst = (const float*)(F.ws + WS_NST); bf16* hm = (bf16*)(F.ws + WS_HCAT);
    const float* gain = F.ka->in[I_MLSTM_NORM] + (size_t)l * 512;
    const int tid = F.tid, lane = F.lane, fr = lane & 15, fq = lane >> 4, w = F.wave;
    for (int unit = F.vcu; unit < 512; unit += F.G) {
        const int c = unit >> 2, h = unit & 3, t0 = c * 128;
        u32x4 kst[4], vst[4], cstr[4]; float nval = 0.f;
#pragma unroll
        for (int it = 0; it < 4; ++it) { const int i = tid + it * 512, j = i >> 4, c8 = i & 15;
            kst[it] = *(const u32x4*)(qkc + ((size_t)(4 + h) * SEQ + t0 + j) * 128 + c8 * 8);
            vst[it] = *(const u32x4*)(mq + ((size_t)(8 + h) * SEQ + t0 + j) * 128 + c8 * 8);
            cstr[it] = *(const u32x4*)(cst + ((size_t)(c * 4 + h) * 128 + j) * 128 + c8 * 8); }
        if (tid < 128) nval = nst[(c * 4 + h) * 128 + tid];
        const int lrow = 16 * w + fr; const size_t trow = (size_t)(t0 + lrow);
        bf16x8 q[4];
#pragma unroll
        for (int ks = 0; ks < 4; ++ks) q[ks] = ld_bf16x8(qkc + ((size_t)h * SEQ + trow) * 128 + ks * 32 + fq * 8);
        u32x2 ogv[8]; f32x4 gnv[8];
#pragma unroll
        for (int tv = 0; tv < 8; ++tv) { ogv[tv] = *(const u32x2*)(mq + ((size_t)(12 + h) * SEQ + trow) * 128 + 16 * tv + 4 * fq); gnv[tv] = *(const f32x4*)(gain + h * 128 + 16 * tv + 4 * fq); }
        if (w == 0) { float a0, a1, c0, c1, total, maxa; gate_scan(ifg, t0, h, lane, a0, a1, c0, c1, total, maxa);
            const float m_in = ((const float*)(F.ws + WS_MST))[c * 4 + h];
            float inclm = fmaxf(a0, a1);
#pragma unroll
            for (int off = 1; off < 64; off <<= 1) { const float t = shup(inclm, off, lane); if (lane >= off) inclm = fmaxf(inclm, t); }
            float exclm = shup(inclm, 1, lane); if (lane == 0) exclm = -3.0e38f;
            const float A0 = fmaxf(fmaxf(exclm, a0), m_in), A1 = fmaxf(inclm, m_in);
            a_s[2 * lane] = a0; a_s[2 * lane + 1] = a1; A_s[2 * lane] = A0; A_s[2 * lane + 1] = A1;
            wi_s[2 * lane] = fexp(m_in - A0); wi_s[2 * lane + 1] = fexp(m_in - A1);
            emr_s[2 * lane] = fexp(-(c0 + A0)); emr_s[2 * lane + 1] = fexp(-(c1 + A1)); }
#pragma unroll
        for (int it = 0; it < 4; ++it) { const int i = tid + it * 512, j = i >> 4, c8 = i & 15;
            *(LAS u32x4*)(Ks + j * 272 + c8 * 16) = kst[it]; *(LAS u32x4*)(Vimg + j * 304 + c8 * 16) = vst[it]; *(LAS u32x4*)(Cs + j * 272 + c8 * 16) = cstr[it]; }
        if (tid < 128) { unsigned z_ = 0u; asm volatile("" : "+v"(z_)); *(LAS u32x4*)(Vimg + tid * 304 + 256) = (u32x4){0x00003F80u + z_, z_, z_, z_}; *(LAS u32x4*)(Vimg + tid * 304 + 272) = (u32x4){z_, z_, z_, z_};
            *(LAS bf16*)(Cs + 128 * 272 + tid * 2) = (bf16)(cvt_pk_bf16(nval, 0.f) & 0xffff); }
        for (int i = tid; i < 15 * 64; i += 512) { const int rr = 129 + i / 64, ww = i % 64; *(LAS unsigned*)(Cs + rr * 272 + ww * 4) = 0u; }
        __syncthreads();
        {
            f32x4 s[8];
#pragma unroll
            for (int t = 0; t < 8; ++t) { s[t] = (f32x4){0.f, 0.f, 0.f, 0.f};
                if (t <= w) {
#pragma unroll
                    for (int ks = 0; ks < 4; ++ks) s[t] = MFMA16(*(const LAS bf16x8*)(Ks + (16 * t + fr) * 272 + (ks * 32 + fq * 8) * 2), q[ks], s[t]);
                    const f32x4 a4 = *(const LAS f32x4*)(a_s + 16 * t + 4 * fq); const float Al = A_s[lrow];
#pragma unroll
                    for (int rg = 0; rg < 4; ++rg) { const int j = 16 * t + 4 * fq + rg; s[t][rg] = (j <= lrow) ? s[t][rg] * fexp(a4[rg] - Al) : 0.f; } } }
            const float wi = wi_s[lrow];
            bf16x8 qs[4];
#pragma unroll
            for (int ks = 0; ks < 4; ++ks) { const u32x4 x = __builtin_bit_cast(u32x4, q[ks]); u32x4 y;
                y.x = cvt_pk_bf16(bflo(x.x) * wi, bfhi(x.x) * wi); y.y = cvt_pk_bf16(bflo(x.y) * wi, bfhi(x.y) * wi); y.z = cvt_pk_bf16(bflo(x.z) * wi, bfhi(x.z) * wi); y.w = cvt_pk_bf16(bflo(x.w) * wi, bfhi(x.w) * wi);
                qs[ks] = __builtin_bit_cast(bf16x8, y); }
            f32x4 o[9];
#pragma unroll
            for (int tv = 0; tv < 9; ++tv) { o[tv] = (f32x4){0.f, 0.f, 0.f, 0.f};
#pragma unroll
                for (int ks = 0; ks < 4; ++ks) o[tv] = MFMA16(*(const LAS bf16x8*)(Cs + (16 * tv + fr) * 272 + (ks * 32 + fq * 8) * 2), qs[ks], o[tv]); }
#pragma unroll
            for (int k2 = 0; k2 < 4; ++k2) if (2 * k2 <= w) { const bf16x8 pf = pack_p(s[2 * k2], s[2 * k2 + 1]);
#pragma unroll
                for (int tv = 0; tv < 9; ++tv) { ldsp lo = Vimg + (32 * k2 + 4 * fq + (fr >> 2)) * 304 + (16 * tv + 4 * (fr & 3)) * 2; o[tv] = MFMA16(lds_frag_tr(lo, lo + 16 * 304), pf, o[tv]); } }
            const float den = shidx(o[8][0], fr, lane);
            const float inv = 1.0f / fmaxf(fabsf(den), emr_s[lrow]);
            float sm = 0.f;
#pragma unroll
            for (int tv = 0; tv < 8; ++tv) { o[tv] = o[tv] * inv; sm += (o[tv][0] + o[tv][1]) + (o[tv][2] + o[tv][3]); }
            sm += shx(sm, 16, lane); sm += shx(sm, 32, lane);
            const float mu = sm * (1.f / 128.f); float vs = 0.f;
#pragma unroll
            for (int tv = 0; tv < 8; ++tv) { o[tv] = o[tv] - mu; vs += (o[tv][0] * o[tv][0] + o[tv][1] * o[tv][1]) + (o[tv][2] * o[tv][2] + o[tv][3] * o[tv][3]); }
            vs += shx(vs, 16, lane); vs += shx(vs, 32, lane);
            const float rstd = 1.0f / sqrtf(vs * (1.f / 128.f) + EPS);
#pragma unroll
            for (int tv = 0; tv < 8; ++tv) { const int col = h * 128 + 16 * tv + 4 * fq; const f32x4 gn = gnv[tv]; const u32x2 og = ogv[tv];
                const float r0 = o[tv][0] * rstd * gn.x * sigmoidf_(bflo(og.x)), r1 = o[tv][1] * rstd * gn.y * sigmoidf_(bfhi(og.x)), r2 = o[tv][2] * rstd * gn.z * sigmoidf_(bflo(og.y)), r3 = o[tv][3] * rstd * gn.w * sigmoidf_(bfhi(og.y));
                u32x2 ww; ww.x = cvt_pk_bf16(r0, r1); ww.y = cvt_pk_bf16(r2, r3); *(u32x2*)(hm + trow * HCW + col) = ww; }
        }
        __syncthreads();
    }
}

#define PH() refresh(F); unsigned char* const ws = F.ws; (void)ws
#define P_XRES ((bf16*)(ws + WS_XRES))
#define P_U ((bf16*)(ws + WS_U))
#define P_PROJ ((bf16*)(ws + WS_PROJ))
#define P_MERGED ((bf16*)(ws + WS_MERGED))
#ifndef PROBE_GROUP
#define PROBE_GROUP 0
#endif
#define PROBE_AMP 8
#define PB(g) unsigned long long pt0_ = 0; if (PROBE_GROUP == (g)) pt0_ = __builtin_amdgcn_s_memrealtime()
#define PE(g) do { if (PROBE_GROUP == (g)) F.pacc += __builtin_amdgcn_s_memrealtime() - pt0_; } while (0)
#define GRID_BAR() do { refresh(F); XcdBarrier bar_; bar_.bar = F.ctl + CW_BAR; bar_.x = xb_xcc_id(); bar_.st = F.lc + LC_BAR; xcd_barrier(bar_); } while (0)
template <int l> DI void layer_body(Frame& F) {
    const int G = F.G, cid = (int)blockIdx.x;
        if constexpr (l == 2) {
            PB(2); PH();
            norm_phase<true, true, 0, false, 1>(F, P_XRES, P_XRES, F.ka->in[I_NORM_MIX] + l * DM, (bf16*)(ws + WS_U8), nullptr, nullptr, 0, 0);
            GRID_BAR(); PE(2);
        }
        { PB(3);
        if constexpr (l < NBF) { PH(); pg8::SchedProj<2> S{(const char*)P_U, (const char*)(ws + WS_WINB + (size_t)l * 16 * MiB), G, cid, DM, DM};
          pg8::EpiProj E{(bf16*)(ws + WS_MQ), (bf16*)(ws + WS_DQ), (bf16*)(ws + WS_XQ), (bf16*)(ws + WS_GT), (float*)(ws + WS_IFG), F.ka->in[I_BIF] + l * 8, 1.0f, l == 1 ? (const u64*)(F.ctl + CW_RS) + 1 * SEQ : nullptr, 1.0f};
          pg8::gemm_phase<pg8::EpiProj, pg8::SchedProj<2>, true>(F.lds, DM, DM, DM, S, E); }
        else { PH(); pg8::SchedProj<2> S{(const char*)(ws + WS_U8), (const char*)(ws + WS_WIN + (size_t)l * SZ_WIN), G, cid, DM / 2, DM / 2};
          pg8::EpiProj E{(bf16*)(ws + WS_MQ), (bf16*)(ws + WS_DQ), (bf16*)(ws + WS_XQ), (bf16*)(ws + WS_GT), (float*)(ws + WS_IFG), F.ka->in[I_BIF] + l * 8, 1.0f / (((l == 1 || l == 3) ? S_XB8 : S_U8) * S_W8I), (l == 1 || l == 3) ? (const u64*)(F.ctl + CW_RS) + l * SEQ : nullptr, 0.125f};
          pg8::gemm_phase<pg8::EpiProj, pg8::SchedProj<2>, true, 2>(F.lds, DM / 2, DM / 2, DM / 2, S, E); }
        if (l == 0) { PH(); pg8::SchedKV S{(const char*)(ws + WS_MEMN), (const char*)(ws + WS_WKV), G, cid, 192 % G};
          pg8::EpiKV E{(bf16*)(ws + WS_KM), (bf16*)(ws + WS_VMT)};
          pg8::gemm_phase<pg8::EpiKV, pg8::SchedKV, false>(F.lds, DM, DM, DM, S, E); }
        if (l == 0) { PH(); int cc = cid - 192 % G; if (cc < 0) cc += G; if (cc >= 16 || G <= 16) convert_moe_expert(F, 4, G > 16 ? cc - 16 : cid, G > 16 ? G - 16 : G, 2); }
        GRID_BAR(); PE(3); }
        { PB(4);
        { PB(13); PH(); memattn_phase(F, l); PE(13); }
        { PB(14); PH(); dilated_phase(F); PE(14); }
        { PB(15); PH(); mlstm_delta_phase(F, l); PE(15); }
        GRID_BAR(); PE(4); }
        { PB(5); PH(); scan_phase(F);
        GRID_BAR(); PE(5); }
        { PB(6); PH(); mlstm_out_phase(F, l);
        GRID_BAR(); PE(6); }
        { PB(7);
        { PH(); pg8::SchedDense S{(const char*)(ws + WS_HCAT), (const char*)(ws + WS_WBRM + (size_t)l * DM * HCW * 2), SEQ / 256, 4, G, cid, HCW, HCW};
          pg8::EpiBranchFused E{P_MERGED, (const unsigned char*)(ws + WS_GT)};
          pg8::gemm_phase<pg8::EpiBranchFused, pg8::SchedDense, false>(F.lds, HCW, HCW, HCW, S, E); }
        GRID_BAR(); PE(7); }
        { PB(8);
        { PH(); pg8::SchedDense S{(const char*)P_MERGED, (const char*)(ws + WS_WOUT + (size_t)l * DM * DM * 2), SEQ / 256, 4, G, cid, DM, DM};
          constexpr int XBM = (l & 1) ? 0 : (((D8_MASK >> (l >> 1)) & 1) ? 2 : 1);
          pg8::EpiRes<XBM, l == 0> E{(l == 0) ? (const void*)F.ka->in[I_X] : (const void*)P_XRES, P_XRES, 1.0f, F.ka->in[I_NORM_FFN] + l * DM, XBM == 2 ? (unsigned char*)(ws + WS_U8) : (unsigned char*)P_U, (u64*)(F.ctl + CW_RS) + l * SEQ};
          pg8::gemm_phase<pg8::EpiRes<XBM, l == 0>, pg8::SchedDense, false>(F.lds, DM, DM, DM, S, E); }
        GRID_BAR(); PE(8); }
        const int j = l >> 1;
        if (l & 1) {
            { PB(2); PH(); norm_phase<false, false, 2, false, 1>(F, P_XRES, nullptr, F.ka->in[I_NORM_FFN] + l * DM, P_U, nullptr, F.ka->in[I_ROUTER] + (size_t)j * DM * 8, 8, j);
            GRID_BAR(); PE(2); }
            { PB(11); PH();
              if (F.tid < 8) F.lc[LC_CNT + F.tid] = xb_ld(F.ctl + CW_MOE + (j * 8 + F.tid) * 64);
              __syncthreads();
              if (F.tid == 0) { unsigned t = 0;
                  for (int e = 0; e < 8; ++e) { F.lc[LC_TB + e] = t; t += (F.lc[LC_CNT + e] + 255u) >> 8; }
                  F.lc[LC_TB + 8] = t; }
              __syncthreads();
              pg8::SchedMoe<true> S{(const char*)(ws + WS_U8S), (const char*)(ws + WS_MGU + (size_t)j * 8 * SZ_MGU_E), SZ_MGU_E, F.lc, 2 * DFE / 256, G, cid, DM / 2, DM / 2};
              pg8::EpiSwiglu<true> E{(unsigned char*)P_PROJ, DFE, (const float*)(ws + WS_GATEE), F.lc, 1.0f / (S_U8 * S_W8I), nullptr};
              pg8::gemm_phase<pg8::EpiSwiglu<true>, pg8::SchedMoe<true>, true, 2>(F.lds, DM / 2, DM / 2, DM / 2, S, E);
              if (l == 1) { PH(); const int nun = __builtin_amdgcn_readfirstlane((int)F.lc[LC_TB + 8]) * (2 * DFE / 256), rem = nun % G; if (cid >= rem) convert_moe_expert(F, 11, cid - rem, G - rem); }
            GRID_BAR(); PE(11); }
            { PB(12); PH(); pg8::SchedMoe<false> S{(const char*)P_PROJ, (const char*)(ws + WS_MD + (size_t)j * 8 * SZ_MD_E), SZ_MD_E, F.lc, 4, G, cid, DFE / 2, DFE / 2};
              pg8::EpiMoeDown E{(bf16*)(ws + WS_YS), (const int*)(ws + WS_TOKE), F.lc, 1.0f / W8_DN};
              pg8::gemm_phase<pg8::EpiMoeDown, pg8::SchedMoe<false>, true, 1>(F.lds, DFE / 2, DFE / 2, DFE / 2, S, E);
              if (l == 1) { PH(); const int nun = __builtin_amdgcn_readfirstlane((int)F.lc[LC_TB + 8]) * 4, rem = nun % G; if (cid >= rem) convert_moe_expert(F, 13, cid - rem, G - rem, 3); }
            GRID_BAR(); PE(12); }
        } else {
            { PB(9); PH();
              if constexpr ((D8_MASK >> (l >> 1)) & 1) {
              pg8::SchedDense S{(const char*)(ws + WS_U8), (const char*)(ws + WS_FGU + (size_t)j * SZ_FGU), SEQ / 256, 2 * DFF / 256, G, cid, DM / 2, DM / 2};
              constexpr bool HD8 = (DD8_MASK >> (l >> 1)) & 1;
              pg8::EpiSwiglu<false, HD8> E{(unsigned char*)P_PROJ, DFF, nullptr, F.lc, 1.0f / (S_XB8 * S_W8I), (const u64*)(F.ctl + CW_RS) + l * SEQ};
              pg8::gemm_phase<pg8::EpiSwiglu<false, HD8>, pg8::SchedDense, true, 2>(F.lds, DM / 2, DM / 2, DM / 2, S, E);
              } else {
              pg8::SchedDense S{(const char*)P_U, (const char*)(ws + WS_FGU + (size_t)j * SZ_FGU), SEQ / 256, 2 * DFF / 256, G, cid, DM, DM};
              pg8::EpiSwiglu<false> E{(unsigned char*)P_PROJ, DFF, nullptr, F.lc, 1.0f, (const u64*)(F.ctl + CW_RS) + l * SEQ};
              pg8::gemm_phase<pg8::EpiSwiglu<false>, pg8::SchedDense, true>(F.lds, DM, DM, DM, S, E); }
              { PH(); const int nun = (SEQ / 256) * (2 * DFF / 256), rem = nun % G; if (cid >= rem) convert_moe_expert(F, l == 0 ? 6 : 12, cid - rem, G - rem, l == 0 ? 2 : 1); }
            GRID_BAR(); PE(9); }
            { PB(10); PH(); constexpr bool DD8 = (DD8_MASK >> (l >> 1)) & 1; constexpr int KP = DD8 ? DFF / 2 : DFF;
              pg8::SchedDense S{(const char*)P_PROJ, (const char*)(ws + WS_FD + (size_t)j * SZ_FD), SEQ / 256, 4, G, cid, KP, KP};
              constexpr int XBM = (l + 1 < NBF) ? 1 : 2;
              pg8::EpiRes<XBM, false> E{(const void*)P_XRES, P_XRES, DD8 ? 1.0f / W8_DN : 1.0f, F.ka->in[I_NORM_MIX] + (l + 1) * DM, XBM == 1 ? (unsigned char*)P_U : (unsigned char*)(ws + WS_U8), (u64*)(F.ctl + CW_RS) + (l + 1) * SEQ};
              pg8::gemm_phase<pg8::EpiRes<XBM, false>, pg8::SchedDense, false, DD8 ? 1 : 0>(F.lds, KP, KP, KP, S, E);
            GRID_BAR(); PE(10); }
        }
}
__global__ void __launch_bounds__(512, 2) fwd_kernel(Args args_unused) {
    extern __shared__ __attribute__((aligned(16))) unsigned char lds_raw[];
    Frame F;
    F.lds = (ldsp)lds_raw; F.lc = (volatile LAS unsigned*)(F.lds + LDSCTL_OFF);
    F.G = gridDim.x; { const int bx = blockIdx.x; F.vcu = (F.G % 8 == 0) ? (bx % 8) * (F.G / 8) + bx / 8 : bx; }
    refresh(F); F.pacc = 0ull;
    for (int u = F.tid; u < (LDS_BYTES - LDSCTL_OFF) / 4; u += 512) F.lc[u] = 0u;
    __syncthreads();
    (void)xcd_barrier_post(F.ctl + CW_BAR, F.lc + LC_BAR);
    const int G = F.G, cid = (int)blockIdx.x;

    { PB(1); PH(); prologue_convert(F); PE(1); }
    { PB(2); PH(); norm_phase<false, false, 0, false, (NBF > 0 ? 0 : 1), false>(F, F.ka->in[I_X], nullptr, F.ka->in[I_NORM_MIX], NBF > 0 ? P_U : (bf16*)(ws + WS_U8), nullptr, nullptr, 0, 0);
    GRID_BAR(); PE(2); }

    layer_body<0>(F); layer_body<1>(F); layer_body<2>(F); layer_body<3>(F);
    { PB(2); PH(); norm_phase<true, false, 0, true>(F, P_XRES, nullptr, F.ka->in[I_NORM_FINAL], nullptr, F.ka->out, nullptr, 0, 0); PE(2); }
    if (PROBE_GROUP) { const unsigned long long t0 = __builtin_amdgcn_s_memrealtime(), wait = F.pacc * PROBE_AMP; while (__builtin_amdgcn_s_memrealtime() - t0 < wait) __builtin_amdgcn_s_sleep(20); }
}

extern "C" void kernel_launch(void* const* d_in, const int* in_sizes, int n_in, void* d_out, int out_size, void* d_ws, size_t ws_size, hipStream_t stream) {
    static int grid = 0;
    if (grid == 0) {
        if (n_in != 22 || out_size != SEQ * DM || ws_size < WS_END) { fprintf(stderr, "kernel_launch: unexpected problem (n_in %d, out %d, ws %zu < %zu)\n", n_in, out_size, ws_size, (size_t)WS_END); grid = -1; return; }
        int dev = 0, cus = 0;
        if (hipGetDevice(&dev) != hipSuccess || hipDeviceGetAttribute(&cus, hipDeviceAttributeMultiprocessorCount, dev) != hipSuccess) { grid = -1; return; }
        if (hipFuncSetAttribute((const void*)fwd_kernel, hipFuncAttributeMaxDynamicSharedMemorySize, LDS_BYTES) != hipSuccess) { fprintf(stderr, "kernel_launch: hipFuncSetAttribute failed\n"); grid = -1; return; }
        int per_cu = 0;
        if (hipOccupancyMaxActiveBlocksPerMultiprocessor(&per_cu, (const void*)fwd_kernel, 512, LDS_BYTES) != hipSuccess || per_cu < 1) { fprintf(stderr, "kernel_launch: occupancy query says %d\n", per_cu); }
        (void)hipGetLastError();
        grid = cus;
    }
    if (grid < 0) return;
    (void)hipMemsetAsync((char*)d_ws + WS_CTL, 0, CTL_ZERO_BYTES, stream);
    Args a{};
    for (int i = 0; i < 22; ++i) a.in[i] = (const float*)d_in[i];
    a.out = (float*)d_out; a.ws = (unsigned char*)d_ws;
    hipLaunchKernelGGL(fwd_kernel, dim3(grid), dim3(512), LDS_BYTES, stream, a);
}
```

```cpp
#include <hip/hip_runtime.h>
#include <cstdio>
#include <cstdint>

#define LAS __attribute__((address_space(3)))
#define GAS __attribute__((address_space(1)))
#define DI __device__ __forceinline__
typedef unsigned short bf16;
typedef short bf16x8 __attribute__((ext_vector_type(8)));
typedef short bf16x4 __attribute__((ext_vector_type(4)));
typedef float f32x4 __attribute__((ext_vector_type(4)));
typedef float f32x2 __attribute__((ext_vector_type(2)));
typedef unsigned u32x4 __attribute__((ext_vector_type(4)));
typedef unsigned u32x2 __attribute__((ext_vector_type(2)));
typedef LAS unsigned char* ldsp;

constexpr int SEQ = 16384, DM = 1024, DEPTH = 4, NMEM = 256;
constexpr int IN_COLS = 7944, PC = 7936;
constexpr int C_QM = 0, C_KM = 512, C_VM = 1024, C_OM = 1536, C_QD = 2048, C_KD = 2816, C_VD = 3584, C_QX = 4352, C_GT = 4864;
constexpr int DFF = 2816, DFE = 3584, NEXP = 8;
constexpr float EPS = 1e-6f;
constexpr float RS128 = 0.08838834764831845f;
constexpr float LOG2E = 1.4426950408889634f;

constexpr size_t MiB = 1u << 20;
constexpr size_t WS_CTL = 0, CTL_ZERO_BYTES = 1 * MiB;
constexpr size_t WS_IFG = 1 * MiB;
constexpr size_t WS_LSE = 2 * MiB;
constexpr size_t WS_SUMM = 3 * MiB;
constexpr size_t WS_MST = 3 * MiB + 65536;
constexpr size_t WS_ND = 3 * MiB + 262144;
constexpr size_t WS_NST = 3 * MiB + 524288;
constexpr size_t WS_TOKE = 4 * MiB;
constexpr size_t WS_GATEE = 4 * MiB + 524288;
constexpr size_t WS_MEMN = 6 * MiB;
constexpr size_t WS_KM = 8 * MiB;
constexpr size_t WS_VMT = 9 * MiB;
constexpr size_t WS_WIN = 16 * MiB;
constexpr size_t SZ_WIN = (size_t)8192 * DM;
constexpr size_t WS_WKV = 80 * MiB;
constexpr size_t WS_WBRM = 88 * MiB;
constexpr size_t WS_WBRD = 92 * MiB;
constexpr size_t WS_WBRX = 94 * MiB;
constexpr size_t WS_WOUT = 98 * MiB;
constexpr size_t WS_FGU = 106 * MiB;
constexpr size_t SZ_FGU = (size_t)2 * DFF * DM * 2;
constexpr size_t WS_FD = 128 * MiB;
constexpr size_t SZ_FD = (size_t)DM * DFF * 2;
constexpr size_t WS_MGU = 139 * MiB;
constexpr size_t SZ_MGU_E = (size_t)2 * DFE * DM;
constexpr size_t WS_MD = 363 * MiB;
constexpr size_t SZ_MD_E = (size_t)DM * DFE;
constexpr size_t WS_XRES = 475 * MiB;
constexpr size_t WS_U = 539 * MiB;
constexpr size_t WS_PROJ = 571 * MiB;
constexpr size_t WS_MQ = WS_PROJ;
constexpr size_t WS_DQ = WS_PROJ + 64 * MiB;
constexpr size_t WS_XQ = WS_PROJ + 136 * MiB;
constexpr size_t WS_GT = WS_PROJ + 152 * MiB;
constexpr size_t WS_WINB = WS_MGU + 112 * MiB;
constexpr size_t WS_U8 = WS_MD + 56 * MiB;
constexpr size_t WS_U8S = WS_PROJ + 120 * MiB;
constexpr size_t WS_QKC = 819 * MiB;
constexpr size_t WS_DELTA = 851 * MiB;
constexpr size_t WS_YS = 819 * MiB;
constexpr size_t WS_CST = 883 * MiB;
constexpr size_t WS_OD = 899 * MiB;
constexpr size_t WS_MERGED = 883 * MiB;
constexpr size_t WS_HCAT = 923 * MiB;
constexpr int HCW = 1280;
constexpr size_t WS_HM = 923 * MiB;
constexpr size_t WS_HD = 939 * MiB;
constexpr size_t WS_HX = 947 * MiB;
constexpr size_t WS_END = 963 * MiB;
static_assert(WS_WIN + 4 * SZ_WIN <= WS_WKV && WS_FGU + 2 * SZ_FGU <= WS_FD && WS_FD + 2 * SZ_FD <= WS_MGU && WS_MGU + 16 * SZ_MGU_E <= WS_MD && WS_MD + 16 * SZ_MD_E <= WS_XRES, "weights map");
static_assert(WS_PROJ + (size_t)SEQ * PC * 2 <= WS_QKC && (size_t)34816 * DFE * 2 <= (size_t)SEQ * PC * 2, "proj map");
constexpr int CW_BAR = 4096;
constexpr int CW_RS = 65536;
constexpr float RS_FIX = 16777216.0f, RS_UNFIX = 1.0f / 16777216.0f;
typedef unsigned long long u64;
constexpr int CW_MOE = 16384;

constexpr int SCR_BYTES = 139264;
constexpr int LDSCTL_OFF = SCR_BYTES;
constexpr int LDS_BYTES = 147456;
constexpr int LC_BAR = 8, LC_TB = 16, LC_CNT = 32, LC_LC = 48, LC_BASE = 64;

DI float bf2f(unsigned v) { return __uint_as_float(v << 16); }
DI float bflo(unsigned w) { return __uint_as_float(w << 16); }
DI float bfhi(unsigned w) { return __uint_as_float(w & 0xffff0000u); }
DI unsigned cvt_pk_bf16(float lo, float hi) { unsigned r; asm volatile("v_cvt_pk_bf16_f32 %0, %1, %2" : "=v"(r) : "v"(lo), "v"(hi)); return r; }
DI float fexp2(float x) { return __builtin_amdgcn_exp2f(x); }
DI float fexp(float x) { return __builtin_amdgcn_exp2f(x * LOG2E); }
DI float frcp(float x) { return __builtin_amdgcn_rcpf(x); }
DI float sigmoidf_(float x) { return frcp(1.0f + fexp(-x)); }
DI float siluf_(float x) { return x * sigmoidf_(x); }
DI float shx(float v, int o, int lane) { return __int_as_float(__builtin_amdgcn_ds_bpermute((lane ^ o) << 2, __float_as_int(v))); }
DI float shidx(float v, int src, int lane) { (void)lane; return __int_as_float(__builtin_amdgcn_ds_bpermute(src << 2, __float_as_int(v))); }
DI float shup(float v, int d, int lane) { return __int_as_float(__builtin_amdgcn_ds_bpermute((lane >= d ? lane - d : lane) << 2, __float_as_int(v))); }
DI float wave_sum(float v, int lane) {
#pragma unroll
    for (int o = 1; o < 64; o <<= 1) v += shx(v, o, lane);
    return v;
}
DI float wave_max(float v, int lane) {
#pragma unroll
    for (int o = 1; o < 64; o <<= 1) v = fmaxf(v, shx(v, o, lane));
    return v;
}
typedef int v8i __attribute__((ext_vector_type(8)));
typedef int v4i __attribute__((ext_vector_type(4)));
DI float clamp448(float x) { return __builtin_amdgcn_fmed3f(x, -448.0f, 448.0f); }
DI unsigned pk4_fp8(float a, float b, float c, float d) {
    int p = 0; p = __builtin_amdgcn_cvt_pk_fp8_f32(clamp448(a), clamp448(b), p, false); p = __builtin_amdgcn_cvt_pk_fp8_f32(clamp448(c), clamp448(d), p, true); return (unsigned)p;
}
DI unsigned pk4_u8(const f32x4& g) {
    const unsigned a = (unsigned)(g[0] * 255.0f + 0.5f), b = (unsigned)(g[1] * 255.0f + 0.5f), c = (unsigned)(g[2] * 255.0f + 0.5f), d = (unsigned)(g[3] * 255.0f + 0.5f);
    return a | (b << 8) | (c << 16) | (d << 24);
}
DI float gate_u8(unsigned w, int k) { return fmaxf((float)((w >> (8 * k)) & 0xffu), 0.5f); }
constexpr float S_U8 = 127.0f / 6.0f;
constexpr float S_XB8 = 12.7f;
constexpr float S_W8I = 32.0f * (127.0f / 5.5f);
DI unsigned pk4_i8(float a, float b, float c, float d) {
    const int qa = (int)__builtin_rintf(__builtin_amdgcn_fmed3f(a, -127.0f, 127.0f)), qb = (int)__builtin_rintf(__builtin_amdgcn_fmed3f(b, -127.0f, 127.0f));
    const int qc = (int)__builtin_rintf(__builtin_amdgcn_fmed3f(c, -127.0f, 127.0f)), qd = (int)__builtin_rintf(__builtin_amdgcn_fmed3f(d, -127.0f, 127.0f));
    return (unsigned)(qa & 255) | ((unsigned)(qb & 255) << 8) | ((unsigned)(qc & 255) << 16) | ((unsigned)qd << 24);
}
constexpr float W8_UP = 32.0f, W8_DN = 64.0f;
DI void st16_wt(void* p, u32x4 v) { asm volatile("global_store_dwordx4 %0, %1, off sc1\n\ts_nop 2" :: "v"(p), "v"(v) : "memory"); }
DI void st16_wt(void* p, f32x4 v) { asm volatile("global_store_dwordx4 %0, %1, off sc1\n\ts_nop 2" :: "v"(p), "v"(v) : "memory"); }
#define LDS_WAIT() asm volatile("s_waitcnt lgkmcnt(0)" ::: "memory")
#define VM_WAIT() asm volatile("s_waitcnt vmcnt(0)" ::: "memory")
#define MFMA16(a, b, c) __builtin_amdgcn_mfma_f32_16x16x32_bf16((a), (b), (c), 0, 0, 0)

#define XB_TMO      128
#define XB_XCNT(j)  (256  + 64 * (j))
#define XB_XSUB(j)  (1280 + 64 * (j))
#define XB_XGEN(j)  (2304 + 64 * (j))
#define XB_TOP      3328
#define XB_TOPGEN   3392
#define XCD_BAR_WORDS 3456
#define XB_SPIN_CAP (1u << 18)
DI unsigned xb_ld(unsigned* p)              { return __hip_atomic_load(p, __ATOMIC_RELAXED, __HIP_MEMORY_SCOPE_AGENT); }
DI unsigned xb_add(unsigned* p, unsigned v) { return __hip_atomic_fetch_add(p, v, __ATOMIC_RELAXED, __HIP_MEMORY_SCOPE_AGENT); }
DI unsigned xb_xcc_id() { return (unsigned)__builtin_amdgcn_s_getreg((3 << 11) | 20) & 0xFu; }
#define XB_SPIN(cond, bar) do { unsigned _sp = 0; while (cond) { __builtin_amdgcn_s_sleep(1); \
    if ((++_sp & 255u) == 0u) { if (xb_ld(&(bar)[XB_TMO])) break; if (_sp > XB_SPIN_CAP) { atomicAdd(&(bar)[XB_TMO], 1u); break; } } } } while (0)
struct XcdBarrier { unsigned* bar; unsigned x; volatile LAS unsigned* st; };
DI XcdBarrier xcd_barrier_post(unsigned* bar, volatile LAS unsigned* st) {
    XcdBarrier b; b.bar = bar; b.x = xb_xcc_id(); b.st = st;
    if (threadIdx.x == 0) (void)xb_add(&bar[XB_XCNT(b.x)], 1u);
    return b;
}
DI void xcd_barrier_complete(unsigned* bar, unsigned x, unsigned& nloc, unsigned& nx) {
    const unsigned G = gridDim.x * gridDim.y * gridDim.z;
    unsigned sum, cnt, mine, sp = 0u;
    for (;;) {
        sum = 0u; cnt = 0u; mine = 0u;
#pragma unroll 1
        for (unsigned j = 0; j < 16; ++j) { const unsigned c = xb_ld(&bar[XB_XCNT(j)]); sum += c; cnt += (c > 0u) ? 1u : 0u; mine = (j == x) ? c : mine; }
        if (sum == G) break;
        __builtin_amdgcn_s_sleep(1);
        if ((++sp & 255u) == 0u) { if (xb_ld(&bar[XB_TMO])) break; if (sp > XB_SPIN_CAP) { atomicAdd(&bar[XB_TMO], 1u); break; } }
    }
    nloc = mine > 0u ? mine : 1u; nx = cnt > 0u ? cnt : 1u;
}
DI void xcd_barrier(const XcdBarrier& b) {
    asm volatile("s_waitcnt vmcnt(0)" ::: "memory");
    __syncthreads();
    if (threadIdx.x == 0) {
        unsigned* bar = b.bar;
        __builtin_amdgcn_s_waitcnt(0);
        unsigned nloc = b.st[0], nx = b.st[1];
        if (nloc == 0u) { xcd_barrier_complete(bar, b.x, nloc, nx); b.st[0] = nloc; b.st[1] = nx; }
        const unsigned old = xb_add(&bar[XB_XSUB(b.x)], 1u);
        const unsigned gen = old / nloc;
        if (old + 1u == (gen + 1u) * nloc) {
            __builtin_amdgcn_fence(__ATOMIC_RELEASE, "agent");
            asm volatile("s_waitcnt vmcnt(0)" ::: "memory");
            const unsigned og = xb_add(&bar[XB_TOP], 1u);
            const unsigned tg = og / nx;
            if (og + 1u == (tg + 1u) * nx) xb_add(&bar[XB_TOPGEN], 1u);
            else XB_SPIN(xb_ld(&bar[XB_TOPGEN]) == tg, bar);
            __builtin_amdgcn_fence(__ATOMIC_ACQUIRE, "agent");
            xb_add(&bar[XB_XGEN(b.x)], 1u);
            asm volatile("s_waitcnt vmcnt(0)" ::: "memory");
        } else {
            XB_SPIN(xb_ld(&bar[XB_XGEN(b.x)]) == gen, bar);
            __builtin_amdgcn_fence(__ATOMIC_ACQUIRE, "agent");
            asm volatile("s_waitcnt vmcnt(0)" ::: "memory");
        }
    }
    __syncthreads();
}

namespace pg8 {
constexpr int BM = 256, BK = 64, HALF = 128, HTB = HALF * BK * 2, STAGE_BYTES = 8 * HTB, NXCD = 8, WGM = 8;
DI int lds_byte(int r, int c) { const int st = (r >> 4) * 2 + (c >> 5), rr = r & 15, cc = c & 31, ob = rr * 64 + cc * 2; return st * 1024 + (ob ^ (((ob >> 9) & 1) << 5)); }
DI void stage_rc(int b, int& R, int& C) { const int st = b / 1024, sb = b % 1024, swz = sb ^ (((sb >> 9) & 1) << 5); R = (st >> 1) * 16 + swz / 64; C = (st & 1) * 32 + (swz % 64) / 2; }
DI int perm32(int rho) { const int n = rho >> 4, i = rho & 15; return 8 * (i >> 2) + 4 * n + (i & 3); }
struct Unit { int pm, pn, e, x; };

DI bool static_unit(int i, int G, int c, int nM, int nN, int& pm, int& pn) {
    const int nwg = nM * nN; const long L = (long)i * G + c; if (L >= nwg) return false;
    int wgid = (int)L; { const int q = nwg / NXCD, r = nwg % NXCD, xcd = wgid % NXCD, off = wgid / NXCD; wgid = (xcd < r ? xcd * (q + 1) : r * (q + 1) + (xcd - r) * q) + off; }
    const int nig = WGM * nN, gid = wgid / nig, fm = gid * WGM, gsz = (nM - fm) < WGM ? (nM - fm) : WGM;
    pm = fm + ((wgid % nig) % gsz); pn = (wgid % nig) / gsz; return true;
}

template <class Epi, class Sched, bool ALIGN_EPI, int QM = 0  >
DI void gemm_phase(ldsp lds, const int K, const int lda, const int ldb, const Sched& S, const Epi& E) {
    int tid_ = threadIdx.x; asm volatile("" : "+v"(tid_));
    const int tid = tid_, wid = __builtin_amdgcn_readfirstlane(tid >> 6), lane = tid & 63, wr = wid >> 2, wc = wid & 3, fr = lane & 15, fq = lane >> 4;
    const int nt = K / BK; constexpr bool F8 = (QM == 1);
    unsigned voffB[2];
#pragma unroll
    for (int i = 0; i < 2; ++i) { int R, C; stage_rc(tid * 16 + i * 8192, R, C); const int Rb = Epi::PERM ? ((R & ~31) + perm32(R & 31)) : R; voffB[i] = (unsigned)(Rb * ldb + C) * 2u; }
    unsigned vA[2][2], vAn[2][2];
    const size_t kstep = (size_t)(BK * 2);
    const size_t hstepB = (size_t)HALF * ldb * 2;
    const unsigned ldsw = (unsigned)wid * 1024u;
    const int aoff = lds_byte(wr * 64 + fr, fq * 8), boff = lds_byte(wc * 32 + fr, fq * 8);
#define PG8_SA(b, h) (((b) * 2 + (h)) * HTB)
#define PG8_SB(b, h) ((4 + (b) * 2 + (h)) * HTB)
#define PG8_STG(bufoff, p0, p1) do { \
        __builtin_amdgcn_global_load_lds((const unsigned*)(p0), (LAS unsigned*)(lds + (bufoff) + ldsw), 16, 0, 0); \
        __builtin_amdgcn_global_load_lds((const unsigned*)(p1), (LAS unsigned*)(lds + (bufoff) + ldsw + 8192), 16, 0, 0); } while (0)
#define PG8_STGB(bufoff, gbase) PG8_STG(bufoff, (gbase) + voffB[0], (gbase) + voffB[1])
#define PG8_STGA(bufoff, gbase, v, h) PG8_STG(bufoff, (gbase) + v[h][0], (gbase) + v[h][1])
#define PG8_LD16(off_) (*(const LAS v4i*)(lds + (off_)))
#define PG8_LDA(dst, b, h) do { if constexpr (F8) { _Pragma("unroll") for (int m = 0; m < 4; ++m) dst##8[m] = __builtin_shufflevector(PG8_LD16(PG8_SA(b, h) + aoff + m * 2048), PG8_LD16(PG8_SA(b, h) + aoff + m * 2048 + 1024), 0, 1, 2, 3, 4, 5, 6, 7); } \
        else { _Pragma("unroll") for (int m = 0; m < 4; ++m) _Pragma("unroll") for (int k = 0; k < 2; ++k) dst[m][k] = *(const LAS bf16x8*)(lds + PG8_SA(b, h) + aoff + m * 2048 + k * 1024); } } while (0)
#define PG8_LDB(dst, b, h) do { if constexpr (F8) { _Pragma("unroll") for (int n = 0; n < 2; ++n) dst##8[n] = __builtin_shufflevector(PG8_LD16(PG8_SB(b, h) + boff + n * 2048), PG8_LD16(PG8_SB(b, h) + boff + n * 2048 + 1024), 0, 1, 2, 3, 4, 5, 6, 7); } \
        else { _Pragma("unroll") for (int n = 0; n < 2; ++n) _Pragma("unroll") for (int k = 0; k < 2; ++k) dst[n][k] = *(const LAS bf16x8*)(lds + PG8_SB(b, h) + boff + n * 2048 + k * 1024); } } while (0)
#define PG8_MMA(ai, bj, At, Bt) do { __builtin_amdgcn_s_setprio(1); _Pragma("unroll") for (int m = 0; m < 4; ++m) _Pragma("unroll") for (int n = 0; n < 2; ++n) { \
        if constexpr (F8)   \
            asm volatile("v_mfma_scale_f32_16x16x128_f8f6f4 %0, %1, %2, %0, %3, %3 op_sel_hi:[0,0,0]" : "+v"(acc[ai][bj][m][n]) : "v"(Bt##8[n]), "v"(At##8[m]), "v"(sc127));   \
        else if constexpr (QM == 2) { _Pragma("unroll") for (int k = 0; k < 2; ++k) acc[ai][bj][m][n] = __builtin_bit_cast(f32x4, __builtin_amdgcn_mfma_i32_16x16x64_i8(__builtin_bit_cast(v4i, Bt[n][k]), __builtin_bit_cast(v4i, At[m][k]), __builtin_bit_cast(v4i, acc[ai][bj][m][n]), 0, 0, 0)); } \
        else { _Pragma("unroll") for (int k = 0; k < 2; ++k) acc[ai][bj][m][n] = __builtin_amdgcn_mfma_f32_16x16x32_bf16(Bt[n][k], At[m][k], acc[ai][bj][m][n], 0, 0, 0); } } \
        __builtin_amdgcn_s_setprio(0); } while (0)
#define PG8_WAIT_V(n) asm volatile("s_waitcnt vmcnt(" #n ")" ::: "memory")
#define PG8_WAIT_L(n) asm volatile("s_waitcnt lgkmcnt(" #n ")" ::: "memory")
#define PG8_BAR __builtin_amdgcn_s_barrier()
#define PG8_SCHED __builtin_amdgcn_sched_barrier(0)
    Unit cur, nxt; int ui = 0;
    if (!S.next(0, cur)) return;
    f32x4 acc[2][2][4][2];
#pragma unroll
    for (int a = 0; a < 2; ++a)
#pragma unroll
        for (int b = 0; b < 2; ++b)
#pragma unroll
            for (int m = 0; m < 4; ++m)
#pragma unroll
                for (int n = 0; n < 2; ++n) acc[a][b][m][n] = (f32x4){0.f, 0.f, 0.f, 0.f};
    int sc127 = 0x7f7f7f7f; asm volatile("" : "+v"(sc127));
    bf16x8 At[4][2], B0[2][2], B1[2][2];
    v8i At8[4], B08[2], B18[2];
    const char* cA = S.a_base(cur); const char* cB = S.b_base(cur);
    S.a_off(cur, tid, lda, vA);
#pragma unroll
    for (int h = 0; h < 2; ++h)
#pragma unroll
        for (int i = 0; i < 2; ++i) vAn[h][i] = vA[h][i];
    PG8_STGB(PG8_SB(0, 0), cB); PG8_STGB(PG8_SB(0, 1), cB + hstepB); PG8_STGA(PG8_SA(0, 0), cA, vA, 0); PG8_STGA(PG8_SA(0, 1), cA, vA, 1);
    if (wr == 1) PG8_BAR;
    PG8_WAIT_V(2); PG8_BAR;
    PG8_STGB(PG8_SB(1, 0), cB + kstep); PG8_STGA(PG8_SA(1, 0), cA + kstep, vA, 0); PG8_STGB(PG8_SB(1, 1), cB + hstepB + kstep);
    PG8_WAIT_V(6); PG8_BAR;
    for (;;) {
        const bool has_next = S.next(ui + 1, nxt);
        const char* nA = has_next ? S.a_base(nxt) : cA; const char* nB = has_next ? S.b_base(nxt) : cB;
        if (Sched::GATHER) { if (has_next) S.a_off(nxt, tid, lda, vAn); }
        for (int t = 0; t < nt; t += 2) {
            if constexpr (Epi::HOOK) E.hook(acc, cur, t, wr, wc, fr, fq);
            const bool last = (t == nt - 2);
            const char* a1 = cA + (size_t)(t + 1) * kstep;
            const char* a2 = last ? nA : cA + (size_t)(t + 2) * kstep; const char* b2 = last ? nB : cB + (size_t)(t + 2) * kstep;
            const char* a3 = a2 + kstep; const char* b3 = b2 + kstep;
            PG8_LDB(B0, 0, 0); PG8_LDB(B1, 0, 1); PG8_SCHED; PG8_LDA(At, 0, 0); PG8_STGA(PG8_SA(1, 1), a1, vA, 1);
            if (Sched::GATHER && last) {
#pragma unroll
                for (int h = 0; h < 2; ++h)
#pragma unroll
                    for (int i = 0; i < 2; ++i) vA[h][i] = vAn[h][i]; }
            PG8_WAIT_V(8); PG8_WAIT_L(0); PG8_BAR; PG8_MMA(0, 0, At, B0); PG8_MMA(0, 1, At, B1); PG8_BAR; PG8_SCHED;
            PG8_LDA(At, 0, 1); PG8_STGB(PG8_SB(0, 0), b2); PG8_STGB(PG8_SB(0, 1), b2 + hstepB); PG8_STGA(PG8_SA(0, 0), a2, vA, 0);
            PG8_WAIT_V(8); PG8_WAIT_L(0); PG8_BAR; PG8_MMA(1, 0, At, B0); PG8_MMA(1, 1, At, B1); PG8_BAR; PG8_SCHED;
            PG8_LDB(B0, 1, 0); PG8_LDB(B1, 1, 1); PG8_SCHED; PG8_LDA(At, 1, 0); PG8_STGA(PG8_SA(0, 1), a2, vA, 1);
            PG8_WAIT_V(8); PG8_WAIT_L(0); PG8_BAR; PG8_MMA(0, 0, At, B0); PG8_MMA(0, 1, At, B1); PG8_BAR; PG8_SCHED;
            PG8_LDA(At, 1, 1); PG8_STGB(PG8_SB(1, 0), b3); PG8_STGB(PG8_SB(1, 1), b3 + hstepB); PG8_STGA(PG8_SA(1, 0), a3, vA, 0);
            PG8_WAIT_V(8); PG8_WAIT_L(0); PG8_BAR; PG8_MMA(1, 0, At, B0); PG8_MMA(1, 1, At, B1); PG8_BAR; PG8_SCHED;
        }
        if constexpr (ALIGN_EPI) { if (wr == 0) PG8_BAR; }
        if constexpr (F8) asm volatile("s_nop 15\n\ts_nop 15" ::: "memory");
        if constexpr (QM == 2) {
#pragma unroll
            for (int a = 0; a < 2; ++a)
#pragma unroll
                for (int b = 0; b < 2; ++b)
#pragma unroll
                    for (int m = 0; m < 4; ++m)
#pragma unroll
                        for (int n = 0; n < 2; ++n) { const v4i iv = __builtin_bit_cast(v4i, acc[a][b][m][n]); acc[a][b][m][n] = (f32x4){(float)iv[0], (float)iv[1], (float)iv[2], (float)iv[3]}; } }
        E(acc, cur, wr, wc, fr, fq);
        if (!has_next) break;
#pragma unroll
        for (int a = 0; a < 2; ++a)
#pragma unroll
            for (int b = 0; b < 2; ++b)
#pragma unroll
                for (int m = 0; m < 4; ++m)
#pragma unroll
                    for (int n = 0; n < 2; ++n) acc[a][b][m][n] = (f32x4){0.f, 0.f, 0.f, 0.f};
        cur = nxt; cA = nA; cB = nB; ++ui;
#pragma unroll
        for (int h = 0; h < 2; ++h)
#pragma unroll
            for (int i = 0; i < 2; ++i) vA[h][i] = vAn[h][i];
        if constexpr (ALIGN_EPI) { if (wr == 1) PG8_BAR; }
    }
    PG8_WAIT_V(0);
    if constexpr (!ALIGN_EPI) { if (wr == 0) PG8_BAR; }
    PG8_BAR;
#undef PG8_SA
#undef PG8_SB
#undef PG8_STG
#undef PG8_STGB
#undef PG8_STGA
#undef PG8_LD16
#undef PG8_LDA
#undef PG8_LDB
#undef PG8_MMA
#undef PG8_WAIT_V
#undef PG8_WAIT_L
#undef PG8_BAR
#undef PG8_SCHED
}

struct SchedDense {
    static constexpr bool GATHER = false;
    const char* A; const char* B; int nM, nN, G, c, lda, ldb;
    DI bool next(int i, Unit& u) const { u.e = 0; u.x = 0; return static_unit(i, G, c, nM, nN, u.pm, u.pn); }
    DI const char* a_base(const Unit& u) const { return A + (size_t)u.pm * 256 * lda * 2; }
    DI const char* b_base(const Unit& u) const { return B + (size_t)u.pn * 256 * ldb * 2; }
    DI void a_off(const Unit&, int tid, int lda_, unsigned (&v)[2][2]) const {
#pragma unroll
        for (int i = 0; i < 2; ++i) { int R, C; stage_rc(tid * 16 + i * 8192, R, C);
#pragma unroll
            for (int h = 0; h < 2; ++h) v[h][i] = (unsigned)((h * 128 + R) * lda_ + C) * 2u; }
    }
};
template <int MODE> struct SchedProj {
    static constexpr bool GATHER = false;
    const char* A; const char* B; int G, c, lda, ldb;
    DI bool next(int i, Unit& u) const { u.x = 0; if (!static_unit(i, G, c, SEQ / 256, MODE == 2 ? 32 : (MODE == 1 ? 20 : 12), u.pm, u.pn)) return false;
        const int p = u.pn; u.e = MODE == 2 ? p : (MODE == 1 ? (p < 4 ? p + 4 : (p < 7 ? p + 10 : (p == 7 ? 18 : p + 11))) : (p < 4 ? p : (p < 10 ? p + 4 : (p == 10 ? 17 : 31)))); return true; }
    DI const char* a_base(const Unit& u) const { return A + (size_t)u.pm * 256 * lda * 2; }
    DI const char* b_base(const Unit& u) const { return B + (size_t)u.e * 256 * ldb * 2; }
    DI void a_off(const Unit&, int tid, int lda_, unsigned (&v)[2][2]) const {
#pragma unroll
        for (int i = 0; i < 2; ++i) { int R, C; stage_rc(tid * 16 + i * 8192, R, C);
#pragma unroll
            for (int h = 0; h < 2; ++h) v[h][i] = (unsigned)((h * 128 + R) * lda_ + C) * 2u; }
    }
};
struct SchedKV {
    static constexpr bool GATHER = false;
    const char* memn; const char* wkv; int G, c, first;
    DI bool next(int i, Unit& u) const {
        int cc = c - first; if (cc < 0) cc += G; const int L = i * G + cc; if (L >= 16) return false;
        u.e = L >> 2; u.x = (L >> 1) & 1; const int j = L & 1; u.pm = u.x ? j : 0; u.pn = u.x ? 0 : j; return true;
    }
    DI const char* a_base(const Unit& u) const { return u.x ? wkv + (size_t)u.e * 1024 * 1024 * 2 + (size_t)(512 + u.pm * 256) * 1024 * 2 : memn + (size_t)u.e * 256 * 1024 * 2; }
    DI const char* b_base(const Unit& u) const { return u.x ? memn + (size_t)u.e * 256 * 1024 * 2 : wkv + (size_t)u.e * 1024 * 1024 * 2 + (size_t)(u.pn * 256) * 1024 * 2; }
    DI void a_off(const Unit&, int tid, int lda_, unsigned (&v)[2][2]) const {
#pragma unroll
        for (int i = 0; i < 2; ++i) { int R, C; stage_rc(tid * 16 + i * 8192, R, C);
#pragma unroll
            for (int h = 0; h < 2; ++h) v[h][i] = (unsigned)((h * 128 + R) * lda_ + C) * 2u; }
    }
};
template <bool UP> struct SchedMoe {
    static constexpr bool GATHER = false;
    const char* A; const char* B; size_t bstride; volatile LAS unsigned* lc; int nN, G, c, lda, ldb; int i0 = 0, imax = 1 << 28;
    DI bool next(int i, Unit& u) const {
        const int T = __builtin_amdgcn_readfirstlane((int)lc[LC_TB + 8]);
        if (i + i0 >= imax) return false;
        if (!static_unit(i + i0, G, c, T, nN, u.pm, u.pn)) return false;
        int e = 0, tbe = 0;
#pragma unroll
        for (int j = 1; j < 8; ++j) { const int tbj = __builtin_amdgcn_readfirstlane((int)lc[LC_TB + j]); if (u.pm >= tbj) { e = j; tbe = tbj; } }
        u.e = e; u.x = (u.pm - tbe) * 256; return true;
    }
    DI const char* a_base(const Unit& u) const { return UP ? A + ((size_t)u.e * SEQ + u.x) * lda * 2 : A + (size_t)u.pm * 256 * lda * 2; }
    DI const char* b_base(const Unit& u) const { return B + (size_t)u.e * bstride + (size_t)u.pn * 256 * ldb * 2; }
    DI void a_off(const Unit&, int tid, int lda_, unsigned (&v)[2][2]) const {
#pragma unroll
        for (int i = 0; i < 2; ++i) { int R, C; stage_rc(tid * 16 + i * 8192, R, C);
#pragma unroll
            for (int h = 0; h < 2; ++h) v[h][i] = (unsigned)((h * 128 + R) * lda_ + C) * 2u; }
    }
};

struct EpiProj {
    static constexpr bool PERM = true, HOOK = false;
    bf16* mq; bf16* dq; bf16* xq; bf16* gt; float* ifg; const float* bias8; float sc; const u64* rs; float qd;
    DI void operator()(const f32x4 (&acc)[2][2][4][2], const Unit& u, int wr, int wc, int fr, int fq) const {
        const int row0 = u.pm * BM + wr * 64 + fr; const int pn = u.e;
        float rsc[2][4];
#pragma unroll
        for (int ai = 0; ai < 2; ++ai)
#pragma unroll
            for (int m = 0; m < 4; ++m) rsc[ai][m] = rs ? (float)rs[row0 + ai * HALF + m * 16] * RS_UNFIX : 0.f;
#pragma unroll
        for (int ai = 0; ai < 2; ++ai)
#pragma unroll
            for (int m = 0; m < 4; ++m) rsc[ai][m] = rs ? sc / sqrtf(rsc[ai][m] * (1.f / DM) + EPS) : sc;
        if (pn == 31) {
            if (wc == 0 && fq == 0) { const f32x4 bi = *(const f32x4*)bias8, bf = *(const f32x4*)(bias8 + 4);
#pragma unroll
                for (int ai = 0; ai < 2; ++ai)
#pragma unroll
                    for (int m = 0; m < 4; ++m) { float* p = ifg + (size_t)(row0 + ai * HALF + m * 16) * 8; f32x4 vi = acc[ai][0][m][0] * rsc[ai][m] + bi, vf = acc[ai][0][m][1] * rsc[ai][m] + bf;
#pragma unroll
                        for (int q = 0; q < 4; ++q) vf[q] = fminf(vf[q], 0.f) - __logf(1.0f + __expf(-fabsf(vf[q])));
                        *(f32x4*)p = vi; *(f32x4*)(p + 4) = vf; } }
            return; }
        const bool sg = pn >= 19; const float scl = (pn == 17 || pn == 18) ? RS128 : ((pn >= 8 && pn < 11) ? qd : 1.0f);
#pragma unroll
        for (int bj = 0; bj < 2; ++bj) {
            bf16* base; int rstride; int sh = 0;
            if (pn < 8) { const int sel = pn >> 1, h = (pn & 1) * 2 + bj; base = mq + (size_t)(sel * 4 + h) * SEQ * 128 + wc * 32 + 8 * fq; rstride = 128; }
            else if (pn < 17) { const int t = pn - 8, sel = t / 3, gh = (t % 3) * 4 + bj * 2 + (wc >> 1); sh = 2 * (gh >> 2); base = dq + (size_t)(sel * 12 + gh) * SEQ * 64 + (wc & 1) * 32 + 8 * fq; rstride = 64; }
            else if (pn < 19) { const int hx = (pn - 17) * 2 + bj; base = xq + (size_t)hx * SEQ * 128 + wc * 32 + 8 * fq; rstride = 128; }
            else {
                unsigned char* gb = (unsigned char*)gt + (pn - 19) * 256 + bj * 128 + wc * 32 + 8 * fq;
#pragma unroll
                for (int ai = 0; ai < 2; ++ai)
#pragma unroll
                    for (int m = 0; m < 4; ++m) { const int row = row0 + ai * HALF + m * 16;
                        f32x4 v0 = acc[ai][bj][m][0] * rsc[ai][m], v1 = acc[ai][bj][m][1] * rsc[ai][m];
#pragma unroll
                        for (int q = 0; q < 4; ++q) { v0[q] = sigmoidf_(v0[q]); v1[q] = sigmoidf_(v1[q]); }
                        u32x2 w; w.x = pk4_u8(v0); w.y = pk4_u8(v1); *(u32x2*)(gb + (size_t)row * 3072) = w; }
                continue; }
#pragma unroll
            for (int ai = 0; ai < 2; ++ai)
#pragma unroll
                for (int m = 0; m < 4; ++m) { const int row = row0 + ai * HALF + m * 16; const int pos = ((row & ((1 << sh) - 1)) << (14 - sh)) + (row >> sh);
                    f32x4 v0 = acc[ai][bj][m][0] * (scl * rsc[ai][m]), v1 = acc[ai][bj][m][1] * (scl * rsc[ai][m]);
                    if (sg) {
#pragma unroll
                        for (int q = 0; q < 4; ++q) { v0[q] = sigmoidf_(v0[q]); v1[q] = sigmoidf_(v1[q]); } }
                    u32x4 w; w.x = cvt_pk_bf16(v0[0], v0[1]); w.y = cvt_pk_bf16(v0[2], v0[3]); w.z = cvt_pk_bf16(v1[0], v1[1]); w.w = cvt_pk_bf16(v1[2], v1[3]);
                    st16_wt(base + (size_t)pos * rstride, w); } }
    }
};
struct EpiKV {
    static constexpr bool PERM = true, HOOK = false;
    bf16* km; bf16* vmt;
    DI void operator()(const f32x4 (&acc)[2][2][4][2], const Unit& u, int wr, int wc, int fr, int fq) const {
        bf16* O = u.x ? vmt + (size_t)u.e * 512 * 256 : km + (size_t)u.e * 256 * 512; const int ldc = u.x ? 256 : 512;
        const int row0 = u.pm * BM + wr * 64 + fr, col0 = u.pn * BM + wc * 32 + 8 * fq;
#pragma unroll
        for (int ai = 0; ai < 2; ++ai)
#pragma unroll
            for (int m = 0; m < 4; ++m) { bf16* rowp = O + (size_t)(row0 + ai * HALF + m * 16) * ldc + col0;
#pragma unroll
                for (int bj = 0; bj < 2; ++bj) { const f32x4 v0 = acc[ai][bj][m][0], v1 = acc[ai][bj][m][1];
                    u32x4 w; w.x = cvt_pk_bf16(v0[0], v0[1]); w.y = cvt_pk_bf16(v0[2], v0[3]); w.z = cvt_pk_bf16(v1[0], v1[1]); w.w = cvt_pk_bf16(v1[2], v1[3]);
                    *(u32x4*)(rowp + bj * HALF) = w; } }
    }
};
struct EpiBranchFused {
    static constexpr bool PERM = true, HOOK = true;
    bf16* Mg; const unsigned char* gates;
    DI void hook(f32x4 (&acc)[2][2][4][2], const Unit& u, int t, int wr, int wc, int fr, int fq) const {
        if (t != 8 && t != 12) return;
        const int gnum = (t == 8) ? 0 : 1024;
        const unsigned char* gp0 = gates + (size_t)(u.pm * BM + wr * 64 + fr) * 3072 + u.pn * BM + wc * 32 + 8 * fq + gnum;
#pragma unroll
        for (int ai = 0; ai < 2; ++ai)
#pragma unroll
            for (int mp = 0; mp < 2; ++mp) {
                u32x2 gn[2][2], gd[2][2];
#pragma unroll
                for (int mm = 0; mm < 2; ++mm)
#pragma unroll
                    for (int bj = 0; bj < 2; ++bj) { const unsigned char* gp = gp0 + (size_t)(ai * HALF + (2 * mp + mm) * 16) * 3072 + bj * HALF; gn[mm][bj] = *(const u32x2*)gp; gd[mm][bj] = *(const u32x2*)(gp + 1024); }
#pragma unroll
                for (int mm = 0; mm < 2; ++mm)
#pragma unroll
                    for (int bj = 0; bj < 2; ++bj) { const int m = 2 * mp + mm; const u32x2 n2 = gn[mm][bj], d2 = gd[mm][bj];
                        f32x4 v0 = acc[ai][bj][m][0], v1 = acc[ai][bj][m][1];
#pragma unroll
                        for (int q = 0; q < 4; ++q) { v0[q] *= gate_u8(n2.x, q) * frcp(gate_u8(d2.x, q)); v1[q] *= gate_u8(n2.y, q) * frcp(gate_u8(d2.y, q)); }
                        acc[ai][bj][m][0] = v0; acc[ai][bj][m][1] = v1; }
                asm volatile("" : "+v"(acc[ai][0][2 * mp][0]), "+v"(acc[ai][1][2 * mp + 1][1]) :: "memory"); }
    }
    DI void operator()(const f32x4 (&acc)[2][2][4][2], const Unit& u, int wr, int wc, int fr, int fq) const {
        const int row0 = u.pm * BM + wr * 64 + fr, col0 = u.pn * BM + wc * 32 + 8 * fq;
#pragma unroll
        for (int ai = 0; ai < 2; ++ai) { u32x2 g[4][2];
#pragma unroll
            for (int m = 0; m < 4; ++m)
#pragma unroll
                for (int bj = 0; bj < 2; ++bj) g[m][bj] = *(const u32x2*)(gates + (size_t)(row0 + ai * HALF + m * 16) * 3072 + 2048 + col0 + bj * HALF);
#pragma unroll
            for (int m = 0; m < 4; ++m) { const size_t row = (size_t)(row0 + ai * HALF + m * 16);
#pragma unroll
                for (int bj = 0; bj < 2; ++bj) { f32x4 v0 = acc[ai][bj][m][0], v1 = acc[ai][bj][m][1];
#pragma unroll
                    for (int q = 0; q < 4; ++q) { v0[q] *= gate_u8(g[m][bj].x, q) * (1.0f / 255.0f); v1[q] *= gate_u8(g[m][bj].y, q) * (1.0f / 255.0f); }
                    u32x4 w; w.x = cvt_pk_bf16(v0[0], v0[1]); w.y = cvt_pk_bf16(v0[2], v0[3]); w.z = cvt_pk_bf16(v1[0], v1[1]); w.w = cvt_pk_bf16(v1[2], v1[3]);
                    st16_wt(Mg + row * DM + col0 + bj * HALF, w); } } }
    }
};
template <int XB, bool IN_F32> struct EpiRes {
    static constexpr bool PERM = true, HOOK = false;
    const void* in; bf16* out; float sc; const float* gain; unsigned char* xb; u64* rs;
    DI void operator()(const f32x4 (&acc)[2][2][4][2], const Unit& u, int wr, int wc, int fr, int fq) const {
        const int row0 = u.pm * BM + wr * 64 + fr, col0 = u.pn * BM + wc * 32 + 8 * fq;
        f32x4 gv[2][2];
        if (XB) {
#pragma unroll
            for (int bj = 0; bj < 2; ++bj)
#pragma unroll
                for (int n = 0; n < 2; ++n) gv[bj][n] = *(const f32x4*)(gain + col0 + bj * HALF + 4 * n); }
        constexpr int MB = 2;
#pragma unroll
        for (int ai = 0; ai < 2; ++ai)
#pragma unroll
          for (int m0 = 0; m0 < 4; m0 += MB) { f32x4 b[MB][2][2];
#pragma unroll
            for (int mm = 0; mm < MB; ++mm) { const size_t off = (size_t)(row0 + ai * HALF + (m0 + mm) * 16) * DM + col0;
#pragma unroll
                for (int bj = 0; bj < 2; ++bj) {
                    if (IN_F32) { b[mm][bj][0] = *(const f32x4*)((const float*)in + off + bj * HALF); b[mm][bj][1] = *(const f32x4*)((const float*)in + off + bj * HALF + 4); }
                    else { const u32x4 r = *(const u32x4*)((const bf16*)in + off + bj * HALF); b[mm][bj][0] = (f32x4){bflo(r.x), bfhi(r.x), bflo(r.y), bfhi(r.y)}; b[mm][bj][1] = (f32x4){bflo(r.z), bfhi(r.z), bflo(r.w), bfhi(r.w)}; } } }
#pragma unroll
            for (int mm = 0; mm < MB; ++mm) { const int m = m0 + mm; const int row = row0 + ai * HALF + m * 16; const size_t off = (size_t)row * DM + col0; float ss = 0.f;
#pragma unroll
                for (int bj = 0; bj < 2; ++bj) { const f32x4 s0 = b[mm][bj][0] + acc[ai][bj][m][0] * sc, s1 = b[mm][bj][1] + acc[ai][bj][m][1] * sc;
                    u32x4 w; w.x = cvt_pk_bf16(s0[0], s0[1]); w.y = cvt_pk_bf16(s0[2], s0[3]); w.z = cvt_pk_bf16(s1[0], s1[1]); w.w = cvt_pk_bf16(s1[2], s1[3]);
                    st16_wt(out + off + bj * HALF, w);
                    if (XB) { const f32x4 v0 = (f32x4){bflo(w.x), bfhi(w.x), bflo(w.y), bfhi(w.y)}, v1 = (f32x4){bflo(w.z), bfhi(w.z), bflo(w.w), bfhi(w.w)};
                        ss += ((v0[0] * v0[0] + v0[1] * v0[1]) + (v0[2] * v0[2] + v0[3] * v0[3])) + ((v1[0] * v1[0] + v1[1] * v1[1]) + (v1[2] * v1[2] + v1[3] * v1[3]));
                        const f32x4 g0 = v0 * gv[bj][0], g1 = v1 * gv[bj][1];
                        if (XB == 1) { u32x4 x; x.x = cvt_pk_bf16(g0[0], g0[1]); x.y = cvt_pk_bf16(g0[2], g0[3]); x.z = cvt_pk_bf16(g1[0], g1[1]); x.w = cvt_pk_bf16(g1[2], g1[3]); *(u32x4*)(xb + (off + bj * HALF) * 2) = x; }
                        else { u32x2 x; x.x = pk4_i8(g0[0] * S_XB8, g0[1] * S_XB8, g0[2] * S_XB8, g0[3] * S_XB8); x.y = pk4_i8(g1[0] * S_XB8, g1[1] * S_XB8, g1[2] * S_XB8, g1[3] * S_XB8); *(u32x2*)(xb + off + bj * HALF) = x; } } }
                if (XB) { const int lane = (fq << 4) | fr; ss += shx(ss, 16, lane); ss += shx(ss, 32, lane);
                    if (fq == 0) (void)__hip_atomic_fetch_add(rs + row, (u64)(ss * RS_FIX), __ATOMIC_RELAXED, __HIP_MEMORY_SCOPE_AGENT); } } }
    }
};
template <bool MOE, bool H8 = MOE> struct EpiSwiglu {
    static constexpr bool PERM = true, HOOK = false;
    unsigned char* H; int ldh; const float* gatee; volatile LAS unsigned* lc; float sc; const u64* rs;
    DI void operator()(const f32x4 (&acc)[2][2][4][2], const Unit& u, int wr, int wc, int fr, int fq) const {
        const int r0 = wr * 64 + fr, col0 = u.pn * HALF + wc * 32 + 8 * fq;
        int cnt = 0; if (MOE) cnt = __builtin_amdgcn_readfirstlane((int)lc[LC_CNT + u.e]);
        float rgs[2][4];
#pragma unroll
        for (int ai = 0; ai < 2; ++ai)
#pragma unroll
            for (int m = 0; m < 4; ++m) { rgs[ai][m] = 1.f; if (MOE) { const int pos = u.x + r0 + ai * HALF + m * 16; rgs[ai][m] = pos < cnt ? gatee[u.e * SEQ + pos] : 0.f; }
                else if (rs) rgs[ai][m] = (float)rs[u.pm * BM + r0 + ai * HALF + m * 16] * RS_UNFIX; }
#pragma unroll
        for (int ai = 0; ai < 2; ++ai)
#pragma unroll
            for (int m = 0; m < 4; ++m) { const int r = r0 + ai * HALF + m * 16;
                const float rg = rgs[ai][m];
                const f32x4 g0 = acc[ai][0][m][0], g1 = acc[ai][0][m][1], u0 = acc[ai][1][m][0], u1 = acc[ai][1][m][1];
                float o[8];
                const float rsd = (!MOE && rs) ? sc / sqrtf(rg * (1.f / DM) + EPS) : sc, rgm = MOE ? rg : 1.f;
#pragma unroll
                for (int q = 0; q < 4; ++q) { o[q] = siluf_(g0[q] * rsd) * (u0[q] * rsd) * rgm; o[4 + q] = siluf_(g1[q] * rsd) * (u1[q] * rsd) * rgm; }
                if (H8) { u32x2 w; w.x = pk4_fp8(o[0], o[1], o[2], o[3]); w.y = pk4_fp8(o[4], o[5], o[6], o[7]); *(u32x2*)(H + (size_t)(u.pm * BM + r) * ldh + col0) = w; }
                else { u32x4 w; w.x = cvt_pk_bf16(o[0], o[1]); w.y = cvt_pk_bf16(o[2], o[3]); w.z = cvt_pk_bf16(o[4], o[5]); w.w = cvt_pk_bf16(o[6], o[7]); st16_wt(H + ((size_t)(u.pm * BM + r) * ldh + col0) * 2, w); } }
    }
};
struct EpiMoeDown {
    static constexpr bool PERM = true, HOOK = false;
    bf16* ys; const int* toke; volatile LAS unsigned* lc; float sc;
    DI void operator()(const f32x4 (&acc)[2][2][4][2], const Unit& u, int wr, int wc, int fr, int fq) const {
        const int r0 = wr * 64 + fr, col0 = u.pn * BM + wc * 32 + 8 * fq; const int cnt = __builtin_amdgcn_readfirstlane((int)lc[LC_CNT + u.e]);
        int tks[2][4];
#pragma unroll
        for (int ai = 0; ai < 2; ++ai)
#pragma unroll
            for (int m = 0; m < 4; ++m) { const int pos = u.x + r0 + ai * HALF + m * 16; tks[ai][m] = pos < cnt ? toke[u.e * SEQ + pos] : 0; }
#pragma unroll
        for (int ai = 0; ai < 2; ++ai)
#pragma unroll
            for (int m = 0; m < 4; ++m) { const int pos = u.x + r0 + ai * HALF + m * 16;
                if (pos < cnt) { const int tk = tks[ai][m]; bf16* rowp = ys + ((size_t)(tk >> 20) * SEQ + (size_t)(tk & 0xFFFFF)) * DM + col0;
#pragma unroll
                    for (int bj = 0; bj < 2; ++bj) { const f32x4 v0 = acc[ai][bj][m][0] * sc, v1 = acc[ai][bj][m][1] * sc;
                        u32x4 w; w.x = cvt_pk_bf16(v0[0], v0[1]); w.y = cvt_pk_bf16(v0[2], v0[3]); w.z = cvt_pk_bf16(v1[0], v1[1]); w.w = cvt_pk_bf16(v1[2], v1[3]);
                        st16_wt(rowp + bj * HALF, w); } } }
    }
};
}

struct Args { const float* in[22]; float* out; unsigned char* ws; };
struct Frame {
    ldsp lds; volatile LAS unsigned* lc; unsigned* ctl;
    int tid, lane, wave, vcu, G;
    unsigned char* ws;
    unsigned long long pacc;
    const __attribute__((address_space(4))) Args* ka;
};
DI void refresh(Frame& F) {
    int t = threadIdx.x; asm volatile("" : "+v"(t)); F.tid = t; F.lane = t & 63; F.wave = __builtin_amdgcn_readfirstlane(t >> 6);
    const __attribute__((address_space(4))) Args* ka = (const __attribute__((address_space(4))) Args*)__builtin_amdgcn_kernarg_segment_ptr(); asm volatile("" : "+s"(ka)); F.ka = ka;
    unsigned char* w = ka->ws; F.ws = w; F.ctl = (unsigned*)(w + WS_CTL);
    int vc = F.vcu, gg = F.G; asm volatile("" : "+s"(vc), "+s"(gg)); F.vcu = vc; F.G = gg;
}
enum { I_X = 0, I_MEM, I_NORM_MIX, I_W_IN, I_CONV, I_BIF, I_MLSTM_NORM, I_NORM_MEM, I_W_MEM_KV, I_W_BR_M, I_W_BR_D, I_W_BR_X, I_W_OUT, I_NORM_FFN,
       I_FFN_G, I_FFN_U, I_FFN_D, I_ROUTER, I_MOE_G, I_MOE_U, I_MOE_D, I_NORM_FINAL };

DI void cvt_item(const float* src, int sld, int scol0, bf16* dst, int dld, int drow0, int k0, float scale, LAS float* scr, int lane) {
    f32x4 v[16];
    const float* s0 = src + (size_t)(k0 + (lane >> 4)) * sld + scol0 + 4 * (lane & 15);
#pragma unroll
    for (int i = 0; i < 16; ++i) v[i] = __builtin_nontemporal_load((const f32x4*)(s0 + (size_t)(4 * i) * sld));
#pragma unroll
    for (int i = 0; i < 16; ++i) { LAS float* p = scr + (4 * i + (lane >> 4)) * 65 + 4 * (lane & 15); p[0] = v[i].x * scale; p[1] = v[i].y * scale; p[2] = v[i].z * scale; p[3] = v[i].w * scale; }
    LDS_WAIT(); asm volatile("" ::: "memory");
    const int c = lane & 7;
#pragma unroll
    for (int j = 0; j < 8; ++j) { const int n = (lane >> 3) + 8 * j; const LAS float* s = scr + (8 * c) * 65 + n;
        u32x4 o; o.x = cvt_pk_bf16(s[0], s[65]); o.y = cvt_pk_bf16(s[2 * 65], s[3 * 65]); o.z = cvt_pk_bf16(s[4 * 65], s[5 * 65]); o.w = cvt_pk_bf16(s[6 * 65], s[7 * 65]);
        *(u32x4*)(dst + (size_t)(drow0 + n) * dld + k0 + 8 * c) = o; }
    LDS_WAIT(); asm volatile("" ::: "memory");
}
DI bool proj_tile_bf16(int t) { return t < 4 || (t >= 8 && t < 14) || t == 17 || t == 31; }
constexpr int NBF = 0;
constexpr int D8_MASK = 2;
constexpr int DD8_MASK = 2;
constexpr int N_DEFER = 9;
template <bool I8 = false> DI void cvt_item8(const float* src, int sld, int scol0, unsigned char* dst, int dld, int drow0, int k0, float scale, LAS float* scr, int lane) {
    f32x4 v[16];
    const float* s0 = src + (size_t)(k0 + (lane >> 4)) * sld + scol0 + 4 * (lane & 15);
#pragma unroll
    for (int i = 0; i < 16; ++i) v[i] = __builtin_nontemporal_load((const f32x4*)(s0 + (size_t)(4 * i) * sld));
#pragma unroll
    for (int i = 0; i < 16; ++i) { LAS float* p = scr + (4 * i + (lane >> 4)) * 65 + 4 * (lane & 15); p[0] = v[i].x * scale; p[1] = v[i].y * scale; p[2] = v[i].z * scale; p[3] = v[i].w * scale; }
    LDS_WAIT(); asm volatile("" ::: "memory");
    const int c = lane & 3;
#pragma unroll
    for (int j = 0; j < 4; ++j) { const int n = (lane >> 2) + 16 * j; const LAS float* s = scr + (16 * c) * 65 + n;
        u32x4 o;
        if (I8) { o.x = pk4_i8(s[0], s[65], s[2 * 65], s[3 * 65]); o.y = pk4_i8(s[4 * 65], s[5 * 65], s[6 * 65], s[7 * 65]); o.z = pk4_i8(s[8 * 65], s[9 * 65], s[10 * 65], s[11 * 65]); o.w = pk4_i8(s[12 * 65], s[13 * 65], s[14 * 65], s[15 * 65]); }
        else { o.x = pk4_fp8(s[0], s[65], s[2 * 65], s[3 * 65]); o.y = pk4_fp8(s[4 * 65], s[5 * 65], s[6 * 65], s[7 * 65]); o.z = pk4_fp8(s[8 * 65], s[9 * 65], s[10 * 65], s[11 * 65]); o.w = pk4_fp8(s[12 * 65], s[13 * 65], s[14 * 65], s[15 * 65]); }
        *(u32x4*)(dst + (size_t)(drow0 + n) * dld + k0 + 16 * c) = o; }
    LDS_WAIT(); asm volatile("" ::: "memory");
}
DI void prologue_convert(Frame& F) {
    LAS float* scr = (LAS float*)(F.lds + F.wave * 16640);
    const int gw = F.vcu * 8 + F.wave, NGW = F.G * 8, lane = F.lane;
    unsigned char* ws = F.ws;
    constexpr int PER_L = 2000 + 256 + 128 + 64 + 128 + 256, N_L = 4 * PER_L, PER_D = 3 * 704, N_D = 2 * PER_D, PER_E = 3 * 896, N_E = (16 - N_DEFER) * PER_E;
    for (int it = gw; it < N_L + N_D + N_E; it += NGW) {
        int r = it;
        if (r < N_L) { const int l = r / PER_L; r -= l * PER_L;
            if (r < 2000) { const int kb = r / 125, nb = r % 125, n0 = nb * 64; const int scol = n0 < 2048 ? n0 : (n0 < PC ? n0 + 8 : 2048);
                const float sc = (n0 >= C_QD && n0 < C_KD) ? 0.125f : 1.0f;
                if (l < NBF) cvt_item(F.ka->in[I_W_IN] + (size_t)l * DM * IN_COLS, IN_COLS, scol, (bf16*)(ws + WS_WINB + (size_t)l * 16 * MiB), DM, n0, kb * 64, sc, scr, lane);
                else cvt_item8<true>(F.ka->in[I_W_IN] + (size_t)l * DM * IN_COLS, IN_COLS, scol, ws + WS_WIN + (size_t)l * SZ_WIN, DM, n0, kb * 64, S_W8I, scr, lane);
                continue; }
            r -= 2000;
            if (r < 256) { const int kb = r >> 4, nb = r & 15; cvt_item(F.ka->in[I_W_MEM_KV] + (size_t)l * DM * DM, DM, nb * 64, (bf16*)(ws + WS_WKV) + (size_t)l * DM * DM, DM, nb * 64, kb * 64, 1.f, scr, lane); continue; }
            r -= 256;
            if (r < 128) { const int kb = r >> 4, nb = r & 15; cvt_item(F.ka->in[I_W_BR_M] + (size_t)l * 512 * DM, DM, nb * 64, (bf16*)(ws + WS_WBRM) + (size_t)l * DM * HCW, HCW, nb * 64, kb * 64, 1.f, scr, lane); continue; }
            r -= 128;
            if (r < 64) { const int kb = r >> 4, nb = r & 15; cvt_item(F.ka->in[I_W_BR_D] + (size_t)l * 256 * DM, DM, nb * 64, (bf16*)(ws + WS_WBRM) + (size_t)l * DM * HCW + 512, HCW, nb * 64, kb * 64, 1.f, scr, lane); continue; }
            r -= 64;
            if (r < 128) { const int kb = r >> 4, nb = r & 15; cvt_item(F.ka->in[I_W_BR_X] + (size_t)l * 512 * DM, DM, nb * 64, (bf16*)(ws + WS_WBRM) + (size_t)l * DM * HCW + 768, HCW, nb * 64, kb * 64, 1.f, scr, lane); continue; }
            r -= 128;
            { const int kb = r >> 4, nb = r & 15; cvt_item(F.ka->in[I_W_OUT] + (size_t)l * DM * DM, DM, nb * 64, (bf16*)(ws + WS_WOUT) + (size_t)l * DM * DM, DM, nb * 64, kb * 64, 1.f, scr, lane); continue; }
        }
        r -= N_L;
        if (r < N_D) { const int j = r / PER_D; r -= j * PER_D;
            if (r < 1408) { const int up = r >= 704; if (up) r -= 704; const int kb = r / 44, nb = r % 44, n0 = nb * 64; const int drow = 256 * (n0 >> 7) + (n0 & 127) + (up ? 128 : 0);
                if ((D8_MASK >> j) & 1) cvt_item8<true>(F.ka->in[up ? I_FFN_U : I_FFN_G] + (size_t)j * DM * DFF, DFF, n0, ws + WS_FGU + (size_t)j * SZ_FGU, DM, drow, kb * 64, S_W8I, scr, lane);
                else cvt_item(F.ka->in[up ? I_FFN_U : I_FFN_G] + (size_t)j * DM * DFF, DFF, n0, (bf16*)(ws + WS_FGU + (size_t)j * SZ_FGU), DM, drow, kb * 64, 1.f, scr, lane);
                continue; }
            r -= 1408;
            { const int kb = r >> 4, nb = r & 15;
              if ((DD8_MASK >> j) & 1) cvt_item8<false>(F.ka->in[I_FFN_D] + (size_t)j * DFF * DM, DM, nb * 64, ws + WS_FD + (size_t)j * SZ_FD, DFF, nb * 64, kb * 64, W8_DN, scr, lane);
              else cvt_item(F.ka->in[I_FFN_D] + (size_t)j * DFF * DM, DM, nb * 64, (bf16*)(ws + WS_FD + (size_t)j * SZ_FD), DFF, nb * 64, kb * 64, 1.f, scr, lane);
              continue; }
        }
        r -= N_D;
        { const int jx = r / PER_E; r -= jx * PER_E; const int je = jx < 4 ? jx : jx + 4;
            if (r < 1792) { const int up = r >= 896; if (up) r -= 896; const int kb = r / 56, nb = r % 56, n0 = nb * 64; const int drow = 256 * (n0 >> 7) + (n0 & 127) + (up ? 128 : 0);
                cvt_item8<true>(F.ka->in[up ? I_MOE_U : I_MOE_G] + (size_t)je * DM * DFE, DFE, n0, ws + WS_MGU + (size_t)je * SZ_MGU_E, DM, drow, kb * 64, S_W8I, scr, lane); continue; }
            r -= 1792;
            { const int kb = r >> 4, nb = r & 15; cvt_item8<false>(F.ka->in[I_MOE_D] + (size_t)je * DFE * DM, DM, nb * 64, ws + WS_MD + (size_t)je * SZ_MD_E, DFE, nb * 64, kb * 64, W8_DN, scr, lane); continue; }
        }
    }
    for (int rw = gw; rw < 4 * NMEM; rw += NGW) { const int l = rw >> 8, m = rw & 255;
        const f32x4* xr = (const f32x4*)(F.ka->in[I_MEM] + (size_t)m * DM) + lane; const f32x4* gr = (const f32x4*)(F.ka->in[I_NORM_MEM] + (size_t)l * DM) + lane;
        f32x4 v[4]; float s = 0.f;
#pragma unroll
        for (int j = 0; j < 4; ++j) { v[j] = xr[64 * j]; s += (v[j].x * v[j].x + v[j].y * v[j].y) + (v[j].z * v[j].z + v[j].w * v[j].w); }
        const float rstd = 1.0f / sqrtf(wave_sum(s, lane) * (1.f / DM) + EPS);
        u32x2* o8 = (u32x2*)((bf16*)(ws + WS_MEMN) + (size_t)rw * DM) + lane;
#pragma unroll
        for (int j = 0; j < 4; ++j) { const f32x4 g = gr[64 * j]; u32x2 w; w.x = cvt_pk_bf16(v[j].x * rstd * g.x, v[j].y * rstd * g.y); w.y = cvt_pk_bf16(v[j].z * rstd * g.z, v[j].w * rstd * g.w); o8[64 * j] = w; }
    }
}

DI void convert_moe_expert(Frame& F, int je0, int rank, int nranks, int nexp = 1) {
    LAS float* scr = (LAS float*)(F.lds + F.wave * 16640);
    const int lane = F.lane; unsigned char* ws = F.ws;
    for (int it = rank * 8 + F.wave; it < nexp * 3 * 896; it += nranks * 8) {
        const int je = je0 + it / (3 * 896); int r = it % (3 * 896);
        if (r < 1792) { const int up = r >= 896; if (up) r -= 896; const int kb = r / 56, nb = r % 56, n0 = nb * 64; const int drow = 256 * (n0 >> 7) + (n0 & 127) + (up ? 128 : 0);
            cvt_item8<true>(F.ka->in[up ? I_MOE_U : I_MOE_G] + (size_t)je * DM * DFE, DFE, n0, ws + WS_MGU + (size_t)je * SZ_MGU_E, DM, drow, kb * 64, S_W8I, scr, lane); continue; }
        r -= 1792;
        { const int kb = r >> 4, nb = r & 15; cvt_item8<false>(F.ka->in[I_MOE_D] + (size_t)je * DFE * DM, DM, nb * 64, ws + WS_MD + (size_t)je * SZ_MD_E, DFE, nb * 64, kb * 64, W8_DN, scr, lane); }
    }
}

DI void reduce8(float (&d)[8], int lane) {
    float r4[4], r2[2], p;
    { const bool hi = lane & 32;
#pragma unroll
      for (int i = 0; i < 4; ++i) { const float send = hi ? d[i] : d[i + 4], keep = hi ? d[i + 4] : d[i]; r4[i] = keep + shx(send, 32, lane); } }
    { const bool hi = lane & 16;
#pragma unroll
      for (int i = 0; i < 2; ++i) { const float send = hi ? r4[i] : r4[i + 2], keep = hi ? r4[i + 2] : r4[i]; r2[i] = keep + shx(send, 16, lane); } }
    { const bool hi = lane & 8; const float send = hi ? r2[0] : r2[1], keep = hi ? r2[1] : r2[0]; p = keep + shx(send, 8, lane); }
    p += shx(p, 4, lane); p += shx(p, 2, lane); p += shx(p, 1, lane);
#pragma unroll
    for (int i = 0; i < 8; ++i) d[i] = shidx(p, ((i >> 2) & 1) * 32 + ((i >> 1) & 1) * 16 + (i & 1) * 8, lane);
}
template <bool ADD_YS, bool WRITE_X, int DOTS, bool FINAL, int U8 = 0  , bool XINB = true  >
DI void norm_phase(Frame& F, const void* xin, bf16* xout, const float* gain, bf16* U, float* outF, const float* wsm, int wld, int moe_j) {
    constexpr int RB = DOTS ? (XINB ? 4 : 1) : (ADD_YS ? 2 : 4);
    const int lane = F.lane;
    f32x4 g[4];
#pragma unroll
    for (int j = 0; j < 4; ++j) g[j] = *((const f32x4*)gain + 64 * j + lane);
    float wreg[DOTS ? 16 : 1][8];
    if (DOTS) {
#pragma unroll
        for (int j = 0; j < 4; ++j)
#pragma unroll
            for (int e = 0; e < 4; ++e) { const float* p = wsm + (size_t)(256 * j + 4 * lane + e) * wld; const f32x4 a = *(const f32x4*)p, b = *(const f32x4*)(p + 4);
                wreg[j * 4 + e][0] = a.x; wreg[j * 4 + e][1] = a.y; wreg[j * 4 + e][2] = a.z; wreg[j * 4 + e][3] = a.w; wreg[j * 4 + e][4] = b.x; wreg[j * 4 + e][5] = b.y; wreg[j * 4 + e][6] = b.z; wreg[j * 4 + e][7] = b.w; }
    }
    const bf16* ys = (const bf16*)(F.ws + WS_YS);
    LAS int* sel_e = (LAS int*)(F.lds); LAS int* sel_lp = sel_e + 128; LAS float* sel_g = (LAS float*)(sel_lp + 128);
    for (int rb = F.vcu; rb < SEQ / 64; rb += F.G) {
        LAS unsigned* rowl = (LAS unsigned*)(F.lds + 4096) + F.wave * 2048;
        if (DOTS == 2) { if (F.tid < 8) F.lc[LC_LC + F.tid] = 0u; __syncthreads(); }
        for (int i0 = 0; i0 < 8; i0 += RB) {
            f32x4 v[RB][4]; u32x2 xraw[XINB ? RB : 1][4]; u32x2 y0[ADD_YS ? RB : 1][4], y1[ADD_YS ? RB : 1][4];
#pragma unroll
            for (int r = 0; r < RB; ++r) { const int row = rb * 64 + F.wave * 8 + i0 + r;
#pragma unroll
                for (int j = 0; j < 4; ++j) {
                    if (XINB) xraw[r][j] = *((const u32x2*)((const bf16*)xin + (size_t)row * DM) + 64 * j + lane);
                    else v[r][j] = *((const f32x4*)((const float*)xin + (size_t)row * DM) + 64 * j + lane);
                    if (ADD_YS) { y0[r][j] = *((const u32x2*)(ys + (size_t)row * DM) + 64 * j + lane); y1[r][j] = *((const u32x2*)(ys + (size_t)(SEQ + row) * DM) + 64 * j + lane); } } }
#pragma unroll
            for (int r = 0; r < RB; ++r) {
                const int rl = F.wave * 8 + i0 + r, row = rb * 64 + rl;
                float ss = 0.f;
#pragma unroll
                for (int j = 0; j < 4; ++j) {
                    if (XINB) { const u32x2 xr = xraw[r][j]; v[r][j] = (f32x4){bflo(xr.x), bfhi(xr.x), bflo(xr.y), bfhi(xr.y)}; }
                    if (ADD_YS) { v[r][j].x += bflo(y0[r][j].x) + bflo(y1[r][j].x); v[r][j].y += bfhi(y0[r][j].x) + bfhi(y1[r][j].x); v[r][j].z += bflo(y0[r][j].y) + bflo(y1[r][j].y); v[r][j].w += bfhi(y0[r][j].y) + bfhi(y1[r][j].y); }
                    if (WRITE_X) { u32x2 xw; xw.x = cvt_pk_bf16(v[r][j].x, v[r][j].y); xw.y = cvt_pk_bf16(v[r][j].z, v[r][j].w); *((u32x2*)(xout + (size_t)row * DM) + 64 * j + lane) = xw;
                        v[r][j] = (f32x4){bflo(xw.x), bfhi(xw.x), bflo(xw.y), bfhi(xw.y)}; }
                    ss += (v[r][j].x * v[r][j].x + v[r][j].y * v[r][j].y) + (v[r][j].z * v[r][j].z + v[r][j].w * v[r][j].w); }
                const float rstd = 1.0f / sqrtf(wave_sum(ss, lane) * (1.f / DM) + EPS);
#pragma unroll
                for (int j = 0; j < 4; ++j) { v[r][j] = v[r][j] * g[j];
                    if (FINAL) *((f32x4*)(outF + (size_t)row * DM) + 64 * j + lane) = v[r][j] * rstd;
                    else if (DOTS == 2) rowl[(i0 + r) * 256 + 64 * j + lane] = pk4_i8(v[r][j].x * (rstd * S_U8), v[r][j].y * (rstd * S_U8), v[r][j].z * (rstd * S_U8), v[r][j].w * (rstd * S_U8));
                    else if (U8 == 1) *((unsigned*)((unsigned char*)U + (size_t)row * DM) + 64 * j + lane) = pk4_i8(v[r][j].x * (rstd * S_U8), v[r][j].y * (rstd * S_U8), v[r][j].z * (rstd * S_U8), v[r][j].w * (rstd * S_U8));
                    else { if (U8 == 2) *((unsigned*)(F.ws + WS_U8 + (size_t)row * DM) + 64 * j + lane) = pk4_i8(v[r][j].x * (rstd * S_U8), v[r][j].y * (rstd * S_U8), v[r][j].z * (rstd * S_U8), v[r][j].w * (rstd * S_U8)); u32x2 w; w.x = cvt_pk_bf16(v[r][j].x * rstd, v[r][j].y * rstd); w.y = cvt_pk_bf16(v[r][j].z * rstd, v[r][j].w * rstd); *((u32x2*)(U + (size_t)row * DM) + 64 * j + lane) = w; } }
                if (DOTS == 2) {
                    float d[8];
#pragma unroll
                    for (int c = 0; c < 8; ++c) d[c] = 0.f;
#pragma unroll
                    for (int j = 0; j < 4; ++j)
#pragma unroll
                        for (int c = 0; c < 8; ++c) d[c] += v[r][j].x * wreg[j * 4 + 0][c] + v[r][j].y * wreg[j * 4 + 1][c] + v[r][j].z * wreg[j * 4 + 2][c] + v[r][j].w * wreg[j * 4 + 3][c];
                    reduce8(d, lane);
                    int e0 = 0; float l0 = d[0];
#pragma unroll
                    for (int c = 1; c < 8; ++c) if (d[c] > l0) { l0 = d[c]; e0 = c; }
                    int e1 = -1; float l1 = -3.0e38f;
#pragma unroll
                    for (int c = 0; c < 8; ++c) if (c != e0 && d[c] > l1) { l1 = d[c]; e1 = c; }
                    const float g0 = 1.0f / (1.0f + __expf((l1 - l0) * rstd)), g1 = 1.0f - g0;
                    if (lane < 2) { const int e = lane ? e1 : e0;
                        const unsigned lp = __hip_atomic_fetch_add((LAS unsigned*)&F.lc[LC_LC + e], 1u, __ATOMIC_RELAXED, __HIP_MEMORY_SCOPE_WORKGROUP);
                        sel_e[rl * 2 + lane] = e; sel_lp[rl * 2 + lane] = (int)lp; sel_g[rl * 2 + lane] = lane ? g1 : g0; }
                }
            }
        }
        if (DOTS == 2) {
            __syncthreads();
            if (F.tid < 8) { const unsigned n = F.lc[LC_LC + F.tid]; F.lc[LC_BASE + F.tid] = xb_add(F.ctl + CW_MOE + (moe_j * 8 + F.tid) * 64, n); }
            __syncthreads();
            if (F.tid < 128) { const int e = sel_e[F.tid], pos = (int)F.lc[LC_BASE + e] + sel_lp[F.tid];
                ((int*)(F.ws + WS_TOKE))[e * SEQ + pos] = (rb * 64 + (F.tid >> 1)) | ((F.tid & 1) << 20);
                ((float*)(F.ws + WS_GATEE))[e * SEQ + pos] = sel_g[F.tid]; }
            unsigned char* u8s = F.ws + WS_U8S;
#pragma unroll
            for (int i = 0; i < 8; ++i)
#pragma unroll
                for (int sl = 0; sl < 2; ++sl) { const int si = (F.wave * 8 + i) * 2 + sl; const int e = sel_e[si], pos = (int)F.lc[LC_BASE + e] + sel_lp[si];
                    unsigned* dst = (unsigned*)(u8s + ((size_t)e * SEQ + pos) * DM) + lane;
#pragma unroll
                    for (int j = 0; j < 4; ++j) dst[64 * j] = rowl[i * 256 + 64 * j + lane]; }
            __syncthreads();
        }
    }
}

DI bf16x8 ld_bf16x8(const bf16* p) { return __builtin_bit_cast(bf16x8, *(const u32x4*)p); }
DI bf16x8 pack_p(const f32x4& a, const f32x4& b) { u32x4 w; w.x = cvt_pk_bf16(a[0], a[1]); w.y = cvt_pk_bf16(a[2], a[3]); w.z = cvt_pk_bf16(b[0], b[1]); w.w = cvt_pk_bf16(b[2], b[3]); return __builtin_bit_cast(bf16x8, w); }
DI bf16x8 lds_frag_perm(ldsp rowp, int koff_bytes) {
    const u32x2 lo = *(const LAS u32x2*)(rowp + koff_bytes), hi = *(const LAS u32x2*)(rowp + koff_bytes + 32);
    u32x4 w; w.x = lo.x; w.y = lo.y; w.z = hi.x; w.w = hi.y; return __builtin_bit_cast(bf16x8, w);
}

typedef short s16x4 __attribute__((ext_vector_type(4)));
DI bf16x8 lds_frag_tr(ldsp lo, ldsp hi) {
    const s16x4 a = __builtin_amdgcn_ds_read_tr16_b64_v4i16((LAS s16x4*)lo), b = __builtin_amdgcn_ds_read_tr16_b64_v4i16((LAS s16x4*)hi);
    return __builtin_shufflevector(a, b, 0, 1, 2, 3, 4, 5, 6, 7);
}
DI void memattn_phase(Frame& F, int l) {
    ldsp Ks = F.lds, Vt = F.lds + 69632;
    const bf16* xq = (const bf16*)(F.ws + WS_XQ); bf16* hx_out = (bf16*)(F.ws + WS_HCAT) + 768;
    const int tid = F.tid, lane = F.lane, fr = lane & 15, fq = lane >> 4;
    for (int unit = F.vcu; unit < 256; unit += F.G) {
        const int hx = unit >> 6, rb = unit & 63;
        const bf16* km = (const bf16*)(F.ws + WS_KM) + (size_t)l * 256 * 512 + hx * 128;
        const bf16* vt = (const bf16*)(F.ws + WS_VMT) + (size_t)l * 512 * 256 + (size_t)hx * 128 * 256;
#pragma unroll
        for (int it = 0; it < 8; ++it) { const int i = tid + it * 512, r = i >> 4, c8 = i & 15; *(LAS u32x4*)(Ks + r * 272 + c8 * 16) = *(const u32x4*)(km + (size_t)r * 512 + c8 * 8); }
#pragma unroll
        for (int it = 0; it < 8; ++it) { const int i = tid + it * 512, r = i >> 5, c8 = i & 31; *(LAS u32x4*)(Vt + r * 528 + c8 * 16) = *(const u32x4*)(vt + (size_t)r * 256 + c8 * 8); }
        __syncthreads();
        for (int pass = 0; pass < 2; ++pass) {
            const int row = rb * 256 + F.wave * 32 + pass * 16 + fr;
            bf16x8 q[4];
#pragma unroll
            for (int ks = 0; ks < 4; ++ks) q[ks] = ld_bf16x8(xq + ((size_t)hx * SEQ + row) * 128 + ks * 32 + fq * 8);
            f32x4 s[16];
#pragma unroll
            for (int t = 0; t < 16; ++t) { s[t] = (f32x4){0.f, 0.f, 0.f, 0.f};
#pragma unroll
                for (int ks = 0; ks < 4; ++ks) s[t] = MFMA16(*(const LAS bf16x8*)(Ks + (16 * t + fr) * 272 + (ks * 32 + fq * 8) * 2), q[ks], s[t]); }
            float mx = -3.0e38f;
#pragma unroll
            for (int t = 0; t < 16; ++t) mx = fmaxf(mx, fmaxf(fmaxf(s[t][0], s[t][1]), fmaxf(s[t][2], s[t][3])));
            mx = fmaxf(mx, shx(mx, 16, lane)); mx = fmaxf(mx, shx(mx, 32, lane));
            float sum = 0.f;
#pragma unroll
            for (int t = 0; t < 16; ++t)
#pragma unroll
                for (int r = 0; r < 4; ++r) { s[t][r] = fexp(s[t][r] - mx); sum += s[t][r]; }
            sum += shx(sum, 16, lane); sum += shx(sum, 32, lane);
            f32x4 o[8];
#pragma unroll
            for (int tv = 0; tv < 8; ++tv) o[tv] = (f32x4){0.f, 0.f, 0.f, 0.f};
#pragma unroll
            for (int k2 = 0; k2 < 8; ++k2) { const bf16x8 pf = pack_p(s[2 * k2], s[2 * k2 + 1]);
#pragma unroll
                for (int tv = 0; tv < 8; ++tv) o[tv] = MFMA16(lds_frag_perm(Vt + (16 * tv + fr) * 528, (32 * k2 + 4 * fq) * 2), pf, o[tv]); }
            const float inv = 1.0f / sum;
#pragma unroll
            for (int tv = 0; tv < 8; ++tv) { u32x2 w; w.x = cvt_pk_bf16(o[tv][0] * inv, o[tv][1] * inv); w.y = cvt_pk_bf16(o[tv][2] * inv, o[tv][3] * inv);
                *(u32x2*)(hx_out + (size_t)row * HCW + hx * 128 + 16 * tv + 4 * fq) = w; }
        }
        __syncthreads();
    }
}

#define DIL_DECODE(ud_, g_, r_, s0_, gh_, sh_) const int g_ = (ud_) >> 9, rem_##g_ = (ud_) & 511, sh_ = 2 * g_, nbs_##g_ = 7 - sh_, blk_##g_ = rem_##g_ & 127, \
        r_ = blk_##g_ >> nbs_##g_, s0_ = (blk_##g_ & ((1 << nbs_##g_) - 1)) * 128, gh_ = g_ * 4 + (rem_##g_ >> 7)
#define DIL_ISSUE(ud_) do { DIL_DECODE(ud_, gN, rN, s0N, ghN, shN); const size_t pb = (size_t)rN << (14 - shN); \
        _Pragma("unroll") for (int it = 0; it < 4; ++it) { const int i = tid + it * 512, jl = i >> 3, c8 = i & 7, sp = s0N - 128 + jl; kreg[it] = (u32x4){0u, 0u, 0u, 0u}; vreg[it] = (u32x4){0u, 0u, 0u, 0u}; \
            if (sp >= 0) { kreg[it] = *(const u32x4*)(dq + ((size_t)(12 + ghN) * SEQ + pb + sp) * 64 + c8 * 8); vreg[it] = *(const u32x4*)(dq + ((size_t)(24 + ghN) * SEQ + pb + sp) * 64 + c8 * 8); } } \
        { const bf16* qp = dq + ((size_t)ghN * SEQ + pb + s0N + 16 * w + fr) * 64 + fq * 8; qreg[0] = *(const u32x4*)qp; qreg[1] = *(const u32x4*)(qp + 32); } } while (0)
DI void dilated_phase(Frame& F) {
    ldsp Kd = F.lds, Vd = F.lds + 36864;
    const bf16* dq = (const bf16*)(F.ws + WS_DQ); bf16* od = (bf16*)(F.ws + WS_OD); float* lse = (float*)(F.ws + WS_LSE);
    const int tid = F.tid, lane = F.lane, fr = lane & 15, fq = lane >> 4, w = F.wave;
    for (int i = tid; i < 24 * 36; i += 512) *(LAS unsigned*)(Vd + 256 * 144 + i * 4) = 0u;
    u32x4 kreg[4], vreg[4], qreg[2];
    int ud = F.vcu;
    if (ud < 1536) DIL_ISSUE(ud);
    for (; ud < 1536; ud += F.G) {
        DIL_DECODE(ud, g, r, s0, gh, sh);
#pragma unroll
        for (int it = 0; it < 4; ++it) { const int i = tid + it * 512, jl = i >> 3, c8 = i & 7; *(LAS u32x4*)(Kd + jl * 144 + c8 * 16) = kreg[it]; *(LAS u32x4*)(Vd + jl * 144 + c8 * 16) = vreg[it]; }
        bf16x8 q[2]; q[0] = __builtin_bit_cast(bf16x8, qreg[0]); q[1] = __builtin_bit_cast(bf16x8, qreg[1]);
        __syncthreads();
        { const int un = ud + F.G; if (un < 1536) DIL_ISSUE(un); }
        {
            const int qs = s0 + 16 * w + fr; const size_t qtok = (size_t)((qs << sh) + r);
            f32x4 s[10];
#pragma unroll
            for (int t = 0; t < 9; ++t) { s[t] = (f32x4){0.f, 0.f, 0.f, 0.f};
#pragma unroll
                for (int ks = 0; ks < 2; ++ks) s[t] = MFMA16(*(const LAS bf16x8*)(Kd + (16 * w + 16 * t + fr) * 144 + (ks * 32 + fq * 8) * 2), q[ks], s[t]); }
            s[9] = (f32x4){0.f, 0.f, 0.f, 0.f};
            float mx = -3.0e38f;
#pragma unroll
            for (int t = 0; t < 9; ++t)
#pragma unroll
                for (int rg = 0; rg < 4; ++rg) { const int jj = 16 * t + 4 * fq + rg; const bool ok = (jj >= fr) && (jj <= 128 + fr) && (s0 - 128 + 16 * w + jj >= 0);
                    s[t][rg] = ok ? s[t][rg] : -1.0e30f; mx = fmaxf(mx, s[t][rg]); }
            mx = fmaxf(mx, shx(mx, 16, lane)); mx = fmaxf(mx, shx(mx, 32, lane));
            float sum = 0.f;
#pragma unroll
            for (int t = 0; t < 9; ++t)
#pragma unroll
                for (int rg = 0; rg < 4; ++rg) { s[t][rg] = fexp(s[t][rg] - mx); sum += s[t][rg]; }
            sum += shx(sum, 16, lane); sum += shx(sum, 32, lane);
            f32x4 o[4];
#pragma unroll
            for (int tv = 0; tv < 4; ++tv) o[tv] = (f32x4){0.f, 0.f, 0.f, 0.f};
#pragma unroll
            for (int k2 = 0; k2 < 5; ++k2) { const bf16x8 pf = pack_p(s[2 * k2], s[2 * k2 + 1]);
#pragma unroll
                for (int tv = 0; tv < 4; ++tv) { ldsp lo = Vd + (16 * w + 32 * k2 + 4 * fq + (fr >> 2)) * 144 + (16 * tv + 4 * (fr & 3)) * 2; o[tv] = MFMA16(lds_frag_tr(lo, lo + 16 * 144), pf, o[tv]); } }
            const float inv = 1.0f / sum;
#pragma unroll
            for (int tv = 0; tv < 4; ++tv) { u32x2 ww; ww.x = cvt_pk_bf16(o[tv][0] * inv, o[tv][1] * inv); ww.y = cvt_pk_bf16(o[tv][2] * inv, o[tv][3] * inv);
                *(u32x2*)(od + qtok * 768 + gh * 64 + 16 * tv + 4 * fq) = ww; }
            if (fq == 0) lse[qtok * 12 + gh] = mx + __logf(sum);
        }
        __syncthreads();
    }
}

DI void gate_scan(const float* ifg, int t0, int h, int lane, float& a0, float& a1, float& cum0, float& cum1, float& total, float& maxa) {
    const float* p0 = ifg + (size_t)(t0 + 2 * lane) * 8; const float i0 = p0[h], lf0 = p0[4 + h], i1 = p0[8 + h], lf1 = p0[12 + h];
    const float s = lf0 + lf1; float incl = s;
#pragma unroll
    for (int off = 1; off < 64; off <<= 1) { const float t = shup(incl, off, lane); if (lane >= off) incl += t; }
    const float excl = incl - s; cum0 = excl + lf0; cum1 = incl; a0 = i0 - cum0; a1 = i1 - cum1;
    total = shidx(incl, 63, lane); maxa = wave_max(fmaxf(a0, a1), lane);
}
DI void mlstm_delta_phase(Frame& F, int l) {
    ldsp Kimg = F.lds, Vimg = F.lds + 34816; LAS float* w_s = (LAS float*)(F.lds + 69632);
    const bf16* mq = (const bf16*)(F.ws + WS_MQ); bf16* qkc = (bf16*)(F.ws + WS_QKC); const float* ifg = (const float*)(F.ws + WS_IFG);
    const float* convw = F.ka->in[I_CONV] + (size_t)l * 4 * 1024;
    const int tid = F.tid, lane = F.lane, fr = lane & 15, fq = lane >> 4, w = F.wave;
    for (int unit = F.vcu; unit < 512; unit += F.G) {
        const int c = unit >> 2, h = unit & 3, t0 = c * 128;
        const int cs = tid & 15, rg = tid >> 4, l0 = rg * 4;
        u32x4 xrr[2][7], vv[4];
#pragma unroll
        for (int which = 0; which < 2; ++which)
#pragma unroll
            for (int i = 0; i < 7; ++i) { const int row = t0 + l0 - 3 + i; xrr[which][i] = (u32x4){0u, 0u, 0u, 0u}; if (row >= 0) xrr[which][i] = *(const u32x4*)(mq + ((size_t)(which * 4 + h) * SEQ + row) * 128 + cs * 8); }
#pragma unroll
        for (int it = 0; it < 4; ++it) { const int i = tid + it * 512, lr = i >> 4, c8 = i & 15; vv[it] = *(const u32x4*)(mq + ((size_t)(8 + h) * SEQ + t0 + lr) * 128 + c8 * 8); }
        f32x4 cwv[2][4][2];
#pragma unroll
        for (int which = 0; which < 2; ++which)
#pragma unroll
            for (int j = 0; j < 4; ++j) { const float* p = convw + j * 1024 + which * 512 + h * 128 + cs * 8; cwv[which][j][0] = *(const f32x4*)p; cwv[which][j][1] = *(const f32x4*)(p + 4); }
        if (w == 0) { float a0, a1, c0, c1, total, maxa; gate_scan(ifg, t0, h, lane, a0, a1, c0, c1, total, maxa);
            w_s[2 * lane] = fexp(a0 - maxa); w_s[2 * lane + 1] = fexp(a1 - maxa);
            if (lane == 0) { float* sm = (float*)(F.ws + WS_SUMM) + (c * 4 + h) * 2; sm[0] = total; sm[1] = maxa; } }
#pragma unroll
        for (int which = 0; which < 2; ++which) {
            float cw[4][8];
#pragma unroll
            for (int j = 0; j < 4; ++j) { const f32x4 a = cwv[which][j][0], b = cwv[which][j][1];
                cw[j][0] = a.x; cw[j][1] = a.y; cw[j][2] = a.z; cw[j][3] = a.w; cw[j][4] = b.x; cw[j][5] = b.y; cw[j][6] = b.z; cw[j][7] = b.w; }
            const u32x4 (&xr)[7] = xrr[which];
#pragma unroll
            for (int o = 0; o < 4; ++o) { float acc[8];
#pragma unroll
                for (int e = 0; e < 8; ++e) acc[e] = 0.f;
#pragma unroll
                for (int j = 0; j < 4; ++j) { const u32x4 x = xr[o + j];
                    acc[0] += cw[j][0] * bflo(x.x); acc[1] += cw[j][1] * bfhi(x.x); acc[2] += cw[j][2] * bflo(x.y); acc[3] += cw[j][3] * bfhi(x.y);
                    acc[4] += cw[j][4] * bflo(x.z); acc[5] += cw[j][5] * bfhi(x.z); acc[6] += cw[j][6] * bflo(x.w); acc[7] += cw[j][7] * bfhi(x.w); }
#pragma unroll
                for (int e = 0; e < 8; ++e) { acc[e] = siluf_(acc[e]); if (which) acc[e] *= RS128; }
                u32x4 ww; ww.x = cvt_pk_bf16(acc[0], acc[1]); ww.y = cvt_pk_bf16(acc[2], acc[3]); ww.z = cvt_pk_bf16(acc[4], acc[5]); ww.w = cvt_pk_bf16(acc[6], acc[7]);
                *(u32x4*)(qkc + ((size_t)(which * 4 + h) * SEQ + t0 + l0 + o) * 128 + cs * 8) = ww;
                if (which) *(LAS u32x4*)(Kimg + (l0 + o) * 272 + cs * 16) = ww; } }
        __syncthreads();
#pragma unroll
        for (int it = 0; it < 4; ++it) { const int i = tid + it * 512, lr = i >> 4, c8 = i & 15; const u32x4 v = vv[it]; const float ww = w_s[lr];
            u32x4 p; p.x = cvt_pk_bf16(bflo(v.x) * ww, bfhi(v.x) * ww); p.y = cvt_pk_bf16(bflo(v.y) * ww, bfhi(v.y) * ww); p.z = cvt_pk_bf16(bflo(v.z) * ww, bfhi(v.z) * ww); p.w = cvt_pk_bf16(bflo(v.w) * ww, bfhi(v.w) * ww);
            *(LAS u32x4*)(Vimg + lr * 272 + c8 * 16) = p; }
        __syncthreads();
        { f32x4 acc[8];
#pragma unroll
          for (int t = 0; t < 8; ++t) acc[t] = (f32x4){0.f, 0.f, 0.f, 0.f};
#pragma unroll
          for (int ks = 0; ks < 4; ++ks) { const int rowb = (32 * ks + 8 * fq + (fr >> 2)) * 272 + 8 * (fr & 3);
            ldsp vb = Vimg + rowb + 32 * w; const bf16x8 bfrag = lds_frag_tr(vb, vb + 4 * 272);
#pragma unroll
            for (int t = 0; t < 8; ++t) { ldsp ka = Kimg + rowb + 32 * t; acc[t] = MFMA16(lds_frag_tr(ka, ka + 4 * 272), bfrag, acc[t]); } }
          bf16* dl = (bf16*)(F.ws + WS_DELTA) + ((size_t)(c * 4 + h) * 128 + 16 * w + fr) * 128 + 4 * fq;
#pragma unroll
          for (int t = 0; t < 8; ++t) { u32x2 dw; dw.x = cvt_pk_bf16(acc[t][0], acc[t][1]); dw.y = cvt_pk_bf16(acc[t][2], acc[t][3]); *(u32x2*)(dl + 16 * t) = dw; }
        }
        if (tid < 128) { float sacc = 0.f;
#pragma unroll 8
            for (int j = 0; j < 128; ++j) sacc += w_s[j] * bf2f(*(const LAS bf16*)(Kimg + j * 272 + tid * 2));
            ((float*)(F.ws + WS_ND))[(c * 4 + h) * 128 + tid] = sacc; }
        __syncthreads();
    }
}
DI void scan_phase(Frame& F) {
    LAS float* dec = (LAS float*)F.lds; LAS float* scl = dec + 512;
    const int tid = F.tid, lane = F.lane, w = F.wave;
    if (w < 4) { const int h = w; const float* sm = (const float*)(F.ws + WS_SUMM);
        const float tot0 = sm[((2 * lane) * 4 + h) * 2], mxa0 = sm[((2 * lane) * 4 + h) * 2 + 1], tot1 = sm[((2 * lane + 1) * 4 + h) * 2], mxa1 = sm[((2 * lane + 1) * 4 + h) * 2 + 1];
        const float s = tot0 + tot1; float incl = s;
#pragma unroll
        for (int off = 1; off < 64; off <<= 1) { const float t = shup(incl, off, lane); if (lane >= off) incl += t; }
        const float excl = incl - s, T0 = excl + tot0, T1 = incl;
        const float b0 = mxa0 - excl, b1 = mxa1 - T0; float inclm = fmaxf(b0, b1);
#pragma unroll
        for (int off = 1; off < 64; off <<= 1) { const float t = shup(inclm, off, lane); if (lane >= off) inclm = fmaxf(inclm, t); }
        float exclm = shup(inclm, 1, lane); if (lane == 0) exclm = -1.0e30f;
        const float m0 = T0 + fmaxf(exclm, b0), m1 = T1 + inclm;
        float mprev = shup(m1, 1, lane); if (lane == 0) mprev = -1.0e30f;
        const float A0 = fmaxf(mprev, mxa0), A1 = fmaxf(m0, mxa1);
        dec[h * 128 + 2 * lane] = fexp(mprev - A0); scl[h * 128 + 2 * lane] = fexp(mxa0 - A0);
        dec[h * 128 + 2 * lane + 1] = fexp(m0 - A1); scl[h * 128 + 2 * lane + 1] = fexp(mxa1 - A1);
        if (F.vcu == 0) { float* mst = (float*)(F.ws + WS_MST); mst[(2 * lane) * 4 + h] = mprev; mst[(2 * lane + 1) * 4 + h] = m0; }
    }
    __syncthreads();
    if (w < 4) {
        const bf16* delta = (const bf16*)(F.ws + WS_DELTA); bf16* cst = (bf16*)(F.ws + WS_CST);
        const float* nd = (const float*)(F.ws + WS_ND); float* nst = (float*)(F.ws + WS_NST);
        for (int e = F.vcu * 256 + tid; e < 65536 + 512; e += F.G * 256) {
            if (e < 65536) { const int h = e >> 14, vd = e & 16383; float C = 0.f;
                for (int c0 = 0; c0 < 128; c0 += 32) { float dv[32];
#pragma unroll
                    for (int j = 0; j < 32; ++j) dv[j] = bf2f(delta[(size_t)((c0 + j) * 4 + h) * 16384 + vd]);
#pragma unroll
                    for (int j = 0; j < 32; ++j) { const float Cin = C; C = dec[h * 128 + c0 + j] * C + scl[h * 128 + c0 + j] * dv[j]; dv[j] = Cin; }
#pragma unroll
                    for (int j = 0; j < 32; ++j) cst[(size_t)((c0 + j) * 4 + h) * 16384 + vd] = (bf16)(cvt_pk_bf16(dv[j], 0.f) & 0xffff); }
            } else { const int idx = e - 65536, h = idx >> 7, d = idx & 127; float n = 0.f;
                for (int c0 = 0; c0 < 128; c0 += 32) { float dv[32];
#pragma unroll
                    for (int j = 0; j < 32; ++j) dv[j] = nd[((c0 + j) * 4 + h) * 128 + d];
#pragma unroll
                    for (int j = 0; j < 32; ++j) { const float nin = n; n = dec[h * 128 + c0 + j] * n + scl[h * 128 + c0 + j] * dv[j]; dv[j] = nin; }
#pragma unroll
                    for (int j = 0; j < 32; ++j) nst[((c0 + j) * 4 + h) * 128 + d] = dv[j]; } }
        }
    } else {
        const bf16* od = (const bf16*)(F.ws + WS_OD); const float* lse = (const float*)(F.ws + WS_LSE); bf16* hd = (bf16*)(F.ws + WS_HCAT) + 512;
        const int hh = lane >> 4, dv4 = (lane & 15) * 4;
        for (int tok = F.vcu * 4 + (w - 4); tok < SEQ; tok += F.G * 4) {
            const float l0 = lse[(size_t)tok * 12 + hh], l1 = lse[(size_t)tok * 12 + 4 + hh], l2 = lse[(size_t)tok * 12 + 8 + hh];
            const float mx = fmaxf(l0, fmaxf(l1, l2)); float w0 = fexp(l0 - mx), w1 = fexp(l1 - mx), w2 = fexp(l2 - mx); const float inv = 1.0f / (w0 + w1 + w2); w0 *= inv; w1 *= inv; w2 *= inv;
            const u32x2 o0 = *(const u32x2*)(od + (size_t)tok * 768 + hh * 64 + dv4), o1 = *(const u32x2*)(od + (size_t)tok * 768 + 256 + hh * 64 + dv4), o2 = *(const u32x2*)(od + (size_t)tok * 768 + 512 + hh * 64 + dv4);
            u32x2 r; r.x = cvt_pk_bf16(w0 * bflo(o0.x) + w1 * bflo(o1.x) + w2 * bflo(o2.x), w0 * bfhi(o0.x) + w1 * bfhi(o1.x) + w2 * bfhi(o2.x));
            r.y = cvt_pk_bf16(w0 * bflo(o0.y) + w1 * bflo(o1.y) + w2 * bflo(o2.y), w0 * bfhi(o0.y) + w1 * bfhi(o1.y) + w2 * bfhi(o2.y));
            *(u32x2*)(hd + (size_t)tok * HCW + hh * 64 + dv4) = r;
        }
    }
    __syncthreads();
}
DI void mlstm_out_phase(Frame& F, int l) {
    ldsp Ks = F.lds, Vimg = F.lds + 34816, Cs = F.lds + 73728;
    LAS float* a_s = (LAS float*)(F.lds + 113152); LAS float* A_s = a_s + 128; LAS float* wi_s = A_s + 128; LAS float* emr_s = wi_s + 128;
    const bf16* mq = (const bf16*)(F.ws + WS_MQ); const bf16* qkc = (const bf16*)(F.ws + WS_QKC); const float* ifg = (const float*)(F.ws + WS_IFG);
    const bf16* cst = (const bf16*)(F.ws + WS_CST); const float* nst = (const float*)(F.ws + WS_NST); bf16* hm = (bf16*)(F.ws + WS_HCAT);
    const float* gain = F.ka->in[I_MLSTM_NORM] + (size_t)l * 512;
    const int tid = F.tid, lane = F.lane, fr = lane & 15, fq = lane >> 4, w = F.wave;
    for (int unit = F.vcu; unit < 512; unit += F.G) {
        const int c = unit >> 2, h = unit & 3, t0 = c * 128;
        u32x4 kst[4], vst[4], cstr[4]; float nval = 0.f;
#pragma unroll
        for (int it = 0; it < 4; ++it) { const int i = tid + it * 512, j = i >> 4, c8 = i & 15;
            kst[it] = *(const u32x4*)(qkc + ((size_t)(4 + h) * SEQ + t0 + j) * 128 + c8 * 8);
            vst[it] = *(const u32x4*)(mq + ((size_t)(8 + h) * SEQ + t0 + j) * 128 + c8 * 8);
            cstr[it] = *(const u32x4*)(cst + ((size_t)(c * 4 + h) * 128 + j) * 128 + c8 * 8); }
        if (tid < 128) nval = nst[(c * 4 + h) * 128 + tid];
        const int lrow = 16 * w + fr; const size_t trow = (size_t)(t0 + lrow);
        bf16x8 q[4];
#pragma unroll
        for (int ks = 0; ks < 4; ++ks) q[ks] = ld_bf16x8(qkc + ((size_t)h * SEQ + trow) * 128 + ks * 32 + fq * 8);
        u32x2 ogv[8]; f32x4 gnv[8];
#pragma unroll
        for (int tv = 0; tv < 8; ++tv) { ogv[tv] = *(const u32x2*)(mq + ((size_t)(12 + h) * SEQ + trow) * 128 + 16 * tv + 4 * fq); gnv[tv] = *(const f32x4*)(gain + h * 128 + 16 * tv + 4 * fq); }
        if (w == 0) { float a0, a1, c0, c1, total, maxa; gate_scan(ifg, t0, h, lane, a0, a1, c0, c1, total, maxa);
            const float m_in = ((const float*)(F.ws + WS_MST))[c * 4 + h];
            float inclm = fmaxf(a0, a1);
#pragma unroll
            for (int off = 1; off < 64; off <<= 1) { const float t = shup(inclm, off, lane); if (lane >= off) inclm = fmaxf(inclm, t); }
            float exclm = shup(inclm, 1, lane); if (lane == 0) exclm = -3.0e38f;
            const float A0 = fmaxf(fmaxf(exclm, a0), m_in), A1 = fmaxf(inclm, m_in);
            a_s[2 * lane] = a0; a_s[2 * lane + 1] = a1; A_s[2 * lane] = A0; A_s[2 * lane + 1] = A1;
            wi_s[2 * lane] = fexp(m_in - A0); wi_s[2 * lane + 1] = fexp(m_in - A1);
            emr_s[2 * lane] = fexp(-(c0 + A0)); emr_s[2 * lane + 1] = fexp(-(c1 + A1)); }
#pragma unroll
        for (int it = 0; it < 4; ++it) { const int i = tid + it * 512, j = i >> 4, c8 = i & 15;
            *(LAS u32x4*)(Ks + j * 272 + c8 * 16) = kst[it]; *(LAS u32x4*)(Vimg + j * 304 + c8 * 16) = vst[it]; *(LAS u32x4*)(Cs + j * 272 + c8 * 16) = cstr[it]; }
        if (tid < 128) { unsigned z_ = 0u; asm volatile("" : "+v"(z_)); *(LAS u32x4*)(Vimg + tid * 304 + 256) = (u32x4){0x00003F80u + z_, z_, z_, z_}; *(LAS u32x4*)(Vimg + tid * 304 + 272) = (u32x4){z_, z_, z_, z_};
            *(LAS bf16*)(Cs + 128 * 272 + tid * 2) = (bf16)(cvt_pk_bf16(nval, 0.f) & 0xffff); }
        for (int i = tid; i < 15 * 64; i += 512) { const int rr = 129 + i / 64, ww = i % 64; *(LAS unsigned*)(Cs + rr * 272 + ww * 4) = 0u; }
        __syncthreads();
        {
            f32x4 s[8];
#pragma unroll
            for (int t = 0; t < 8; ++t) { s[t] = (f32x4){0.f, 0.f, 0.f, 0.f};
                if (t <= w) {
#pragma unroll
                    for (int ks = 0; ks < 4; ++ks) s[t] = MFMA16(*(const LAS bf16x8*)(Ks + (16 * t + fr) * 272 + (ks * 32 + fq * 8) * 2), q[ks], s[t]);
                    const f32x4 a4 = *(const LAS f32x4*)(a_s + 16 * t + 4 * fq); const float Al = A_s[lrow];
#pragma unroll
                    for (int rg = 0; rg < 4; ++rg) { const int j = 16 * t + 4 * fq + rg; s[t][rg] = (j <= lrow) ? s[t][rg] * fexp(a4[rg] - Al) : 0.f; } } }
            const float wi = wi_s[lrow];
            bf16x8 qs[4];
#pragma unroll
            for (int ks = 0; ks < 4; ++ks) { const u32x4 x = __builtin_bit_cast(u32x4, q[ks]); u32x4 y;
                y.x = cvt_pk_bf16(bflo(x.x) * wi, bfhi(x.x) * wi); y.y = cvt_pk_bf16(bflo(x.y) * wi, bfhi(x.y) * wi); y.z = cvt_pk_bf16(bflo(x.z) * wi, bfhi(x.z) * wi); y.w = cvt_pk_bf16(bflo(x.w) * wi, bfhi(x.w) * wi);
                qs[ks] = __builtin_bit_cast(bf16x8, y); }
            f32x4 o[9];
#pragma unroll
            for (int tv = 0; tv < 9; ++tv) { o[tv] = (f32x4){0.f, 0.f, 0.f, 0.f};
#pragma unroll
                for (int ks = 0; ks < 4; ++ks) o[tv] = MFMA16(*(const LAS bf16x8*)(Cs + (16 * tv + fr) * 272 + (ks * 32 + fq * 8) * 2), qs[ks], o[tv]); }
#pragma unroll
            for (int k2 = 0; k2 < 4; ++k2) if (2 * k2 <= w) { const bf16x8 pf = pack_p(s[2 * k2], s[2 * k2 + 1]);
#pragma unroll
                for (int tv = 0; tv < 9; ++tv) { ldsp lo = Vimg + (32 * k2 + 4 * fq + (fr >> 2)) * 304 + (16 * tv + 4 * (fr & 3)) * 2; o[tv] = MFMA16(lds_frag_tr(lo, lo + 16 * 304), pf, o[tv]); } }
            const float den = shidx(o[8][0], fr, lane);
            const float inv = 1.0f / fmaxf(fabsf(den), emr_s[lrow]);
            float sm = 0.f;
#pragma unroll
            for (int tv = 0; tv < 8; ++tv) { o[tv] = o[tv] * inv; sm += (o[tv][0] + o[tv][1]) + (o[tv][2] + o[tv][3]); }
            sm += shx(sm, 16, lane); sm += shx(sm, 32, lane);
            const float mu = sm * (1.f / 128.f); float vs = 0.f;
#pragma unroll
            for (int tv = 0; tv < 8; ++tv) { o[tv] = o[tv] - mu; vs += (o[tv][0] * o[tv][0] + o[tv][1] * o[tv][1]) + (o[tv][2] * o[tv][2] + o[tv][3] * o[tv][3]); }
            vs += shx(vs, 16, lane); vs += shx(vs, 32, lane);
            const float rstd = 1.0f / sqrtf(vs * (1.f / 128.f) + EPS);
#pragma unroll
            for (int tv = 0; tv < 8; ++tv) { const int col = h * 128 + 16 * tv + 4 * fq; const f32x4 gn = gnv[tv]; const u32x2 og = ogv[tv];
                const float r0 = o[tv][0] * rstd * gn.x * sigmoidf_(bflo(og.x)), r1 = o[tv][1] * rstd * gn.y * sigmoidf_(bfhi(og.x)), r2 = o[tv][2] * rstd * gn.z * sigmoidf_(bflo(og.y)), r3 = o[tv][3] * rstd * gn.w * sigmoidf_(bfhi(og.y));
                u32x2 ww; ww.x = cvt_pk_bf16(r0, r1); ww.y = cvt_pk_bf16(r2, r3); *(u32x2*)(hm + trow * HCW + col) = ww; }
        }
        __syncthreads();
    }
}

#define PH() refresh(F); unsigned char* const ws = F.ws; (void)ws
#define P_XRES ((bf16*)(ws + WS_XRES))
#define P_U ((bf16*)(ws + WS_U))
#define P_PROJ ((bf16*)(ws + WS_PROJ))
#define P_MERGED ((bf16*)(ws + WS_MERGED))
#ifndef PROBE_GROUP
#define PROBE_GROUP 0
#endif
#define PROBE_AMP 8
#define PB(g) unsigned long long pt0_ = 0; if (PROBE_GROUP == (g)) pt0_ = __builtin_amdgcn_s_memrealtime()
#define PE(g) do { if (PROBE_GROUP == (g)) F.pacc += __builtin_amdgcn_s_memrealtime() - pt0_; } while (0)
#define GRID_BAR() do { refresh(F); XcdBarrier bar_; bar_.bar = F.ctl + CW_BAR; bar_.x = xb_xcc_id(); bar_.st = F.lc + LC_BAR; xcd_barrier(bar_); } while (0)
template <int l> DI void layer_body(Frame& F) {
    const int G = F.G, cid = (int)blockIdx.x;
        if constexpr (l == 2) {
            PB(2); PH();
            norm_phase<true, true, 0, false, 1>(F, P_XRES, P_XRES, F.ka->in[I_NORM_MIX] + l * DM, (bf16*)(ws + WS_U8), nullptr, nullptr, 0, 0);
            GRID_BAR(); PE(2);
        }
        { PB(3);
        if constexpr (l < NBF) { PH(); pg8::SchedProj<2> S{(const char*)P_U, (const char*)(ws + WS_WINB + (size_t)l * 16 * MiB), G, cid, DM, DM};
          pg8::EpiProj E{(bf16*)(ws + WS_MQ), (bf16*)(ws + WS_DQ), (bf16*)(ws + WS_XQ), (bf16*)(ws + WS_GT), (float*)(ws + WS_IFG), F.ka->in[I_BIF] + l * 8, 1.0f, l == 1 ? (const u64*)(F.ctl + CW_RS) + 1 * SEQ : nullptr, 1.0f};
          pg8::gemm_phase<pg8::EpiProj, pg8::SchedProj<2>, true>(F.lds, DM, DM, DM, S, E); }
        else { PH(); pg8::SchedProj<2> S{(const char*)(ws + WS_U8), (const char*)(ws + WS_WIN + (size_t)l * SZ_WIN), G, cid, DM / 2, DM / 2};
          pg8::EpiProj E{(bf16*)(ws + WS_MQ), (bf16*)(ws + WS_DQ), (bf16*)(ws + WS_XQ), (bf16*)(ws + WS_GT), (float*)(ws + WS_IFG), F.ka->in[I_BIF] + l * 8, 1.0f / (((l == 1 || l == 3) ? S_XB8 : S_U8) * S_W8I), (l == 1 || l == 3) ? (const u64*)(F.ctl + CW_RS) + l * SEQ : nullptr, 0.125f};
          pg8::gemm_phase<pg8::EpiProj, pg8::SchedProj<2>, true, 2>(F.lds, DM / 2, DM / 2, DM / 2, S, E); }
        if (l == 0) { PH(); pg8::SchedKV S{(const char*)(ws + WS_MEMN), (const char*)(ws + WS_WKV), G, cid, 192 % G};
          pg8::EpiKV E{(bf16*)(ws + WS_KM), (bf16*)(ws + WS_VMT)};
          pg8::gemm_phase<pg8::EpiKV, pg8::SchedKV, false>(F.lds, DM, DM, DM, S, E); }
        if (l == 0) { PH(); int cc = cid - 192 % G; if (cc < 0) cc += G; if (cc >= 16 || G <= 16) convert_moe_expert(F, 4, G > 16 ? cc - 16 : cid, G > 16 ? G - 16 : G, 2); }
        GRID_BAR(); PE(3); }
        { PB(4);
        { PB(13); PH(); memattn_phase(F, l); PE(13); }
        { PB(14); PH(); dilated_phase(F); PE(14); }
        { PB(15); PH(); mlstm_delta_phase(F, l); PE(15); }
        GRID_BAR(); PE(4); }
        { PB(5); PH(); scan_phase(F);
        GRID_BAR(); PE(5); }
        { PB(6); PH(); mlstm_out_phase(F, l);
        GRID_BAR(); PE(6); }
        { PB(7);
        { PH(); pg8::SchedDense S{(const char*)(ws + WS_HCAT), (const char*)(ws + WS_WBRM + (size_t)l * DM * HCW * 2), SEQ / 256, 4, G, cid, HCW, HCW};
          pg8::EpiBranchFused E{P_MERGED, (const unsigned char*)(ws + WS_GT)};
          pg8::gemm_phase<pg8::EpiBranchFused, pg8::SchedDense, false>(F.lds, HCW, HCW, HCW, S, E); }
        GRID_BAR(); PE(7); }
        { PB(8);
        { PH(); pg8::SchedDense S{(const char*)P_MERGED, (const char*)(ws + WS_WOUT + (size_t)l * DM * DM * 2), SEQ / 256, 4, G, cid, DM, DM};
          constexpr int XBM = (l & 1) ? 0 : (((D8_MASK >> (l >> 1)) & 1) ? 2 : 1);
          pg8::EpiRes<XBM, l == 0> E{(l == 0) ? (const void*)F.ka->in[I_X] : (const void*)P_XRES, P_XRES, 1.0f, F.ka->in[I_NORM_FFN] + l * DM, XBM == 2 ? (unsigned char*)(ws + WS_U8) : (unsigned char*)P_U, (u64*)(F.ctl + CW_RS) + l * SEQ};
          pg8::gemm_phase<pg8::EpiRes<XBM, l == 0>, pg8::SchedDense, false>(F.lds, DM, DM, DM, S, E); }
        GRID_BAR(); PE(8); }
        const int j = l >> 1;
        if (l & 1) {
            { PB(2); PH(); norm_phase<false, false, 2, false, 1>(F, P_XRES, nullptr, F.ka->in[I_NORM_FFN] + l * DM, P_U, nullptr, F.ka->in[I_ROUTER] + (size_t)j * DM * 8, 8, j);
            GRID_BAR(); PE(2); }
            { PB(11); PH();
              if (F.tid < 8) F.lc[LC_CNT + F.tid] = xb_ld(F.ctl + CW_MOE + (j * 8 + F.tid) * 64);
              __syncthreads();
              if (F.tid == 0) { unsigned t = 0;
                  for (int e = 0; e < 8; ++e) { F.lc[LC_TB + e] = t; t += (F.lc[LC_CNT + e] + 255u) >> 8; }
                  F.lc[LC_TB + 8] = t; }
              __syncthreads();
              pg8::SchedMoe<true> S{(const char*)(ws + WS_U8S), (const char*)(ws + WS_MGU + (size_t)j * 8 * SZ_MGU_E), SZ_MGU_E, F.lc, 2 * DFE / 256, G, cid, DM / 2, DM / 2};
              pg8::EpiSwiglu<true> E{(unsigned char*)P_PROJ, DFE, (const float*)(ws + WS_GATEE), F.lc, 1.0f / (S_U8 * S_W8I), nullptr};
              pg8::gemm_phase<pg8::EpiSwiglu<true>, pg8::SchedMoe<true>, true, 2>(F.lds, DM / 2, DM / 2, DM / 2, S, E);
              if (l == 1) { PH(); const int nun = __builtin_amdgcn_readfirstlane((int)F.lc[LC_TB + 8]) * (2 * DFE / 256), rem = nun % G; if (cid >= rem) convert_moe_expert(F, 11, cid - rem, G - rem); }
            GRID_BAR(); PE(11); }
            { PB(12); PH(); pg8::SchedMoe<false> S{(const char*)P_PROJ, (const char*)(ws + WS_MD + (size_t)j * 8 * SZ_MD_E), SZ_MD_E, F.lc, 4, G, cid, DFE / 2, DFE / 2};
              pg8::EpiMoeDown E{(bf16*)(ws + WS_YS), (const int*)(ws + WS_TOKE), F.lc, 1.0f / W8_DN};
              pg8::gemm_phase<pg8::EpiMoeDown, pg8::SchedMoe<false>, true, 1>(F.lds, DFE / 2, DFE / 2, DFE / 2, S, E);
              if (l == 1) { PH(); const int nun = __builtin_amdgcn_readfirstlane((int)F.lc[LC_TB + 8]) * 4, rem = nun % G; if (cid >= rem) convert_moe_expert(F, 13, cid - rem, G - rem, 3); }
            GRID_BAR(); PE(12); }
        } else {
            { PB(9); PH();
              if constexpr ((D8_MASK >> (l >> 1)) & 1) {
              pg8::SchedDense S{(const char*)(ws + WS_U8), (const char*)(ws + WS_FGU + (size_t)j * SZ_FGU), SEQ / 256, 2 * DFF / 256, G, cid, DM / 2, DM / 2};
              constexpr bool HD8 = (DD8_MASK >> (l >> 1)) & 1;
              pg8::EpiSwiglu<false, HD8> E{(unsigned char*)P_PROJ, DFF, nullptr, F.lc, 1.0f / (S_XB8 * S_W8I), (const u64*)(F.ctl + CW_RS) + l * SEQ};
              pg8::gemm_phase<pg8::EpiSwiglu<false, HD8>, pg8::SchedDense, true, 2>(F.lds, DM / 2, DM / 2, DM / 2, S, E);
              } else {
              pg8::SchedDense S{(const char*)P_U, (const char*)(ws + WS_FGU + (size_t)j * SZ_FGU), SEQ / 256, 2 * DFF / 256, G, cid, DM, DM};
              pg8::EpiSwiglu<false> E{(unsigned char*)P_PROJ, DFF, nullptr, F.lc, 1.0f, (const u64*)(F.ctl + CW_RS) + l * SEQ};
              pg8::gemm_phase<pg8::EpiSwiglu<false>, pg8::SchedDense, true>(F.lds, DM, DM, DM, S, E); }
              { PH(); const int nun = (SEQ / 256) * (2 * DFF / 256), rem = nun % G; if (cid >= rem) convert_moe_expert(F, l == 0 ? 6 : 12, cid - rem, G - rem, l == 0 ? 2 : 1); }
            GRID_BAR(); PE(9); }
            { PB(10); PH(); constexpr bool DD8 = (DD8_MASK >> (l >> 1)) & 1; constexpr int KP = DD8 ? DFF / 2 : DFF;
              pg8::SchedDense S{(const char*)P_PROJ, (const char*)(ws + WS_FD + (size_t)j * SZ_FD), SEQ / 256, 4, G, cid, KP, KP};
              constexpr int XBM = (l + 1 < NBF) ? 1 : 2;
              pg8::EpiRes<XBM, false> E{(const void*)P_XRES, P_XRES, DD8 ? 1.0f / W8_DN : 1.0f, F.ka->in[I_NORM_MIX] + (l + 1) * DM, XBM == 1 ? (unsigned char*)P_U : (unsigned char*)(ws + WS_U8), (u64*)(F.ctl + CW_RS) + (l + 1) * SEQ};
              pg8::gemm_phase<pg8::EpiRes<XBM, false>, pg8::SchedDense, false, DD8 ? 1 : 0>(F.lds, KP, KP, KP, S, E);
            GRID_BAR(); PE(10); }
        }
}
__global__ void __launch_bounds__(512, 2) fwd_kernel(Args args_unused) {
    extern __shared__ __attribute__((aligned(16))) unsigned char lds_raw[];
    Frame F;
    F.lds = (ldsp)lds_raw; F.lc = (volatile LAS unsigned*)(F.lds + LDSCTL_OFF);
    F.G = gridDim.x; { const int bx = blockIdx.x; F.vcu = (F.G % 8 == 0) ? (bx % 8) * (F.G / 8) + bx / 8 : bx; }
    refresh(F); F.pacc = 0ull;
    for (int u = F.tid; u < (LDS_BYTES - LDSCTL_OFF) / 4; u += 512) F.lc[u] = 0u;
    __syncthreads();
    (void)xcd_barrier_post(F.ctl + CW_BAR, F.lc + LC_BAR);
    const int G = F.G, cid = (int)blockIdx.x;

    { PB(1); PH(); prologue_convert(F); PE(1); }
    { PB(2); PH(); norm_phase<false, false, 0, false, (NBF > 0 ? 0 : 1), false>(F, F.ka->in[I_X], nullptr, F.ka->in[I_NORM_MIX], NBF > 0 ? P_U : (bf16*)(ws + WS_U8), nullptr, nullptr, 0, 0);
    GRID_BAR(); PE(2); }

    layer_body<0>(F); layer_body<1>(F); layer_body<2>(F); layer_body<3>(F);
    { PB(2); PH(); norm_phase<true, false, 0, true>(F, P_XRES, nullptr, F.ka->in[I_NORM_FINAL], nullptr, F.ka->out, nullptr, 0, 0); PE(2); }
    if (PROBE_GROUP) { const unsigned long long t0 = __builtin_amdgcn_s_memrealtime(), wait = F.pacc * PROBE_AMP; while (__builtin_amdgcn_s_memrealtime() - t0 < wait) __builtin_amdgcn_s_sleep(20); }
}

extern "C" void kernel_launch(void* const* d_in, const int* in_sizes, int n_in, void* d_out, int out_size, void* d_ws, size_t ws_size, hipStream_t stream) {
    static int grid = 0;
    if (grid == 0) {
        if (n_in != 22 || out_size != SEQ * DM || ws_size < WS_END) { fprintf(stderr, "kernel_launch: unexpected problem (n_in %d, out %d, ws %zu < %zu)\n", n_in, out_size, ws_size, (size_t)WS_END); grid = -1; return; }
        int dev = 0, cus = 0;
        if (hipGetDevice(&dev) != hipSuccess || hipDeviceGetAttribute(&cus, hipDeviceAttributeMultiprocessorCount, dev) != hipSuccess) { grid = -1; return; }
        if (hipFuncSetAttribute((const void*)fwd_kernel, hipFuncAttributeMaxDynamicSharedMemorySize, LDS_BYTES) != hipSuccess) { fprintf(stderr, "kernel_launch: hipFuncSetAttribute failed\n"); grid = -1; return; }
        int per_cu = 0;
        if (hipOccupancyMaxActiveBlocksPerMultiprocessor(&per_cu, (const void*)fwd_kernel, 512, LDS_BYTES) != hipSuccess || per_cu < 1) { fprintf(stderr, "kernel_launch: occupancy query says %d\n", per_cu); }
        (void)hipGetLastError();
        grid = cus;
    }
    if (grid < 0) return;
    (void)hipMemsetAsync((char*)d_ws + WS_CTL, 0, CTL_ZERO_BYTES, stream);
    Args a{};
    for (int i = 0; i < 22; ++i) a.in[i] = (const float*)d_in[i];
    a.out = (float*)d_out; a.ws = (unsigned char*)d_ws;
    hipLaunchKernelGGL(fwd_kernel, dim3(grid), dim3(512), LDS_BYTES, stream, a);
}
```

```cpp
#include <hip/hip_runtime.h>
#include <cstdio>
#include <cstdint>

#define LAS __attribute__((address_space(3)))
#define GAS __attribute__((address_space(1)))
#define DI __device__ __forceinline__
typedef unsigned short bf16;
typedef short bf16x8 __attribute__((ext_vector_type(8)));
typedef short bf16x4 __attribute__((ext_vector_type(4)));
typedef float f32x4 __attribute__((ext_vector_type(4)));
typedef float f32x2 __attribute__((ext_vector_type(2)));
typedef unsigned u32x4 __attribute__((ext_vector_type(4)));
typedef unsigned u32x2 __attribute__((ext_vector_type(2)));
typedef LAS unsigned char* ldsp;

constexpr int SEQ = 16384, DM = 1024, DEPTH = 4, NMEM = 256;
constexpr int IN_COLS = 7944, PC = 7936;
constexpr int C_QM = 0, C_KM = 512, C_VM = 1024, C_OM = 1536, C_QD = 2048, C_KD = 2816, C_VD = 3584, C_QX = 4352, C_GT = 4864;
constexpr int DFF = 2816, DFE = 3584, NEXP = 8;
constexpr float EPS = 1e-6f;
constexpr float RS128 = 0.08838834764831845f;
constexpr float LOG2E = 1.4426950408889634f;

constexpr size_t MiB = 1u << 20;
constexpr size_t WS_CTL = 0, CTL_ZERO_BYTES = 1 * MiB;
constexpr size_t WS_IFG = 1 * MiB;
constexpr size_t WS_LSE = 2 * MiB;
constexpr size_t WS_SUMM = 3 * MiB;
constexpr size_t WS_MST = 3 * MiB + 65536;
constexpr size_t WS_ND = 3 * MiB + 262144;
constexpr size_t WS_NST = 3 * MiB + 524288;
constexpr size_t WS_TOKE = 4 * MiB;
constexpr size_t WS_GATEE = 4 * MiB + 524288;
constexpr size_t WS_MEMN = 6 * MiB;
constexpr size_t WS_KM = 8 * MiB;
constexpr size_t WS_VMT = 9 * MiB;
constexpr size_t WS_WIN = 16 * MiB;
constexpr size_t SZ_WIN = (size_t)8192 * DM;
constexpr size_t WS_WKV = 80 * MiB;
constexpr size_t WS_WBRM = 88 * MiB;
constexpr size_t WS_WBRD = 92 * MiB;
constexpr size_t WS_WBRX = 94 * MiB;
constexpr size_t WS_WOUT = 98 * MiB;
constexpr size_t WS_FGU = 106 * MiB;
constexpr size_t SZ_FGU = (size_t)2 * DFF * DM * 2;
constexpr size_t WS_FD = 128 * MiB;
constexpr size_t SZ_FD = (size_t)DM * DFF * 2;
constexpr size_t WS_MGU = 139 * MiB;
constexpr size_t SZ_MGU_E = (size_t)2 * DFE * DM;
constexpr size_t WS_MD = 363 * MiB;
constexpr size_t SZ_MD_E = (size_t)DM * DFE;
constexpr size_t WS_XRES = 475 * MiB;
constexpr size_t WS_U = 539 * MiB;
constexpr size_t WS_PROJ = 571 * MiB;
constexpr size_t WS_MQ = WS_PROJ;
constexpr size_t WS_DQ = WS_PROJ + 64 * MiB;
constexpr size_t WS_XQ = WS_PROJ + 136 * MiB;
constexpr size_t WS_GT = WS_PROJ + 152 * MiB;
constexpr size_t WS_WINB = WS_MGU + 112 * MiB;
constexpr size_t WS_U8 = WS_MD + 56 * MiB;
constexpr size_t WS_U8S = WS_PROJ + 120 * MiB;
constexpr size_t WS_QKC = 819 * MiB;
constexpr size_t WS_DELTA = 851 * MiB;
constexpr size_t WS_YS = 819 * MiB;
constexpr size_t WS_CST = 883 * MiB;
constexpr size_t WS_OD = 899 * MiB;
constexpr size_t WS_MERGED = 883 * MiB;
constexpr size_t WS_HCAT = 923 * MiB;
constexpr int HCW = 1280;
constexpr size_t WS_HM = 923 * MiB;
constexpr size_t WS_HD = 939 * MiB;
constexpr size_t WS_HX = 947 * MiB;
constexpr size_t WS_END = 963 * MiB;
static_assert(WS_WIN + 4 * SZ_WIN <= WS_WKV && WS_FGU + 2 * SZ_FGU <= WS_FD && WS_FD + 2 * SZ_FD <= WS_MGU && WS_MGU + 16 * SZ_MGU_E <= WS_MD && WS_MD + 16 * SZ_MD_E <= WS_XRES, "weights map");
static_assert(WS_PROJ + (size_t)SEQ * PC * 2 <= WS_QKC && (size_t)34816 * DFE * 2 <= (size_t)SEQ * PC * 2, "proj map");
constexpr int CW_BAR = 4096;
constexpr int CW_RS = 65536;
constexpr float RS_FIX = 16777216.0f, RS_UNFIX = 1.0f / 16777216.0f;
typedef unsigned long long u64;
constexpr int CW_MOE = 16384;

constexpr int SCR_BYTES = 139264;
constexpr int LDSCTL_OFF = SCR_BYTES;
constexpr int LDS_BYTES = 147456;
constexpr int LC_BAR = 8, LC_TB = 16, LC_CNT = 32, LC_LC = 48, LC_BASE = 64;

DI float bf2f(unsigned v) { return __uint_as_float(v << 16); }
DI float bflo(unsigned w) { return __uint_as_float(w << 16); }
DI float bfhi(unsigned w) { return __uint_as_float(w & 0xffff0000u); }
DI unsigned cvt_pk_bf16(float lo, float hi) { unsigned r; asm volatile("v_cvt_pk_bf16_f32 %0, %1, %2" : "=v"(r) : "v"(lo), "v"(hi)); return r; }
DI float fexp2(float x) { return __builtin_amdgcn_exp2f(x); }
DI float fexp(float x) { return __builtin_amdgcn_exp2f(x * LOG2E); }
DI float frcp(float x) { return __builtin_amdgcn_rcpf(x); }
DI float sigmoidf_(float x) { return frcp(1.0f + fexp(-x)); }
DI float siluf_(float x) { return x * sigmoidf_(x); }
DI float shx(float v, int o, int lane) { return __int_as_float(__builtin_amdgcn_ds_bpermute((lane ^ o) << 2, __float_as_int(v))); }
DI float shidx(float v, int src, int lane) { (void)lane; return __int_as_float(__builtin_amdgcn_ds_bpermute(src << 2, __float_as_int(v))); }
DI float shup(float v, int d, int lane) { return __int_as_float(__builtin_amdgcn_ds_bpermute((lane >= d ? lane - d : lane) << 2, __float_as_int(v))); }
DI float wave_sum(float v, int lane) {
#pragma unroll
    for (int o = 1; o < 64; o <<= 1) v += shx(v, o, lane);
    return v;
}
DI float wave_max(float v, int lane) {
#pragma unroll
    for (int o = 1; o < 64; o <<= 1) v = fmaxf(v, shx(v, o, lane));
    return v;
}
typedef int v8i __attribute__((ext_vector_type(8)));
typedef int v4i __attribute__((ext_vector_type(4)));
DI float clamp448(float x) { return __builtin_amdgcn_fmed3f(x, -448.0f, 448.0f); }
DI unsigned pk4_fp8(float a, float b, float c, float d) {
    int p = 0; p = __builtin_amdgcn_cvt_pk_fp8_f32(clamp448(a), clamp448(b), p, false); p = __builtin_amdgcn_cvt_pk_fp8_f32(clamp448(c), clamp448(d), p, true); return (unsigned)p;
}
DI unsigned pk4_u8(const f32x4& g) {
    const unsigned a = (unsigned)(g[0] * 255.0f + 0.5f), b = (unsigned)(g[1] * 255.0f + 0.5f), c = (unsigned)(g[2] * 255.0f + 0.5f), d = (unsigned)(g[3] * 255.0f + 0.5f);
    return a | (b << 8) | (c << 16) | (d << 24);
}
DI float gate_u8(unsigned w, int k) { return fmaxf((float)((w >> (8 * k)) & 0xffu), 0.5f); }
constexpr float S_U8 = 127.0f / 6.0f;
constexpr float S_XB8 = 12.7f;
constexpr float S_W8I = 32.0f * (127.0f / 5.5f);
DI unsigned pk4_i8(float a, float b, float c, float d) {
    const int qa = (int)__builtin_rintf(__builtin_amdgcn_fmed3f(a, -127.0f, 127.0f)), qb = (int)__builtin_rintf(__builtin_amdgcn_fmed3f(b, -127.0f, 127.0f));
    const int qc = (int)__builtin_rintf(__builtin_amdgcn_fmed3f(c, -127.0f, 127.0f)), qd = (int)__builtin_rintf(__builtin_amdgcn_fmed3f(d, -127.0f, 127.0f));
    return (unsigned)(qa & 255) | ((unsigned)(qb & 255) << 8) | ((unsigned)(qc & 255) << 16) | ((unsigned)qd << 24);
}
constexpr float W8_UP = 32.0f, W8_DN = 64.0f;
DI void st16_wt(void* p, u32x4 v) { asm volatile("global_store_dwordx4 %0, %1, off sc1\n\ts_nop 2" :: "v"(p), "v"(v) : "memory"); }
DI void st16_wt(void* p, f32x4 v) { asm volatile("global_store_dwordx4 %0, %1, off sc1\n\ts_nop 2" :: "v"(p), "v"(v) : "memory"); }
#define LDS_WAIT() asm volatile("s_waitcnt lgkmcnt(0)" ::: "memory")
#define VM_WAIT() asm volatile("s_waitcnt vmcnt(0)" ::: "memory")
#define MFMA16(a, b, c) __builtin_amdgcn_mfma_f32_16x16x32_bf16((a), (b), (c), 0, 0, 0)

#define XB_TMO      128
#define XB_XCNT(j)  (256  + 64 * (j))
#define XB_XSUB(j)  (1280 + 64 * (j))
#define XB_XGEN(j)  (2304 + 64 * (j))
#define XB_TOP      3328
#define XB_TOPGEN   3392
#define XCD_BAR_WORDS 3456
#define XB_SPIN_CAP (1u << 18)
DI unsigned xb_ld(unsigned* p)              { return __hip_atomic_load(p, __ATOMIC_RELAXED, __HIP_MEMORY_SCOPE_AGENT); }
DI unsigned xb_add(unsigned* p, unsigned v) { return __hip_atomic_fetch_add(p, v, __ATOMIC_RELAXED, __HIP_MEMORY_SCOPE_AGENT); }
DI unsigned xb_xcc_id() { return (unsigned)__builtin_amdgcn_s_getreg((3 << 11) | 20) & 0xFu; }
#define XB_SPIN(cond, bar) do { unsigned _sp = 0; while (cond) { __builtin_amdgcn_s_sleep(1); \
    if ((++_sp & 255u) == 0u) { if (xb_ld(&(bar)[XB_TMO])) break; if (_sp > XB_SPIN_CAP) { atomicAdd(&(bar)[XB_TMO], 1u); break; } } } } while (0)
struct XcdBarrier { unsigned* bar; unsigned x; volatile LAS unsigned* st; };
DI XcdBarrier xcd_barrier_post(unsigned* bar, volatile LAS unsigned* st) {
    XcdBarrier b; b.bar = bar; b.x = xb_xcc_id(); b.st = st;
    if (threadIdx.x == 0) (void)xb_add(&bar[XB_XCNT(b.x)], 1u);
    return b;
}
DI void xcd_barrier_complete(unsigned* bar, unsigned x, unsigned& nloc, unsigned& nx) {
    const unsigned G = gridDim.x * gridDim.y * gridDim.z;
    unsigned sum, cnt, mine, sp = 0u;
    for (;;) {
        sum = 0u; cnt = 0u; mine = 0u;
#pragma unroll 1
        for (unsigned j = 0; j < 16; ++j) { const unsigned c = xb_ld(&bar[XB_XCNT(j)]); sum += c; cnt += (c > 0u) ? 1u : 0u; mine = (j == x) ? c : mine; }
        if (sum == G) break;
        __builtin_amdgcn_s_sleep(1);
        if ((++sp & 255u) == 0u) { if (xb_ld(&bar[XB_TMO])) break; if (sp > XB_SPIN_CAP) { atomicAdd(&bar[XB_TMO], 1u); break; } }
    }
    nloc = mine > 0u ? mine : 1u; nx = cnt > 0u ? cnt : 1u;
}
DI void xcd_barrier(const XcdBarrier& b) {
    asm volatile("s_waitcnt vmcnt(0)" ::: "memory");
    __syncthreads();
    if (threadIdx.x == 0) {
        unsigned* bar = b.bar;
        __builtin_amdgcn_s_waitcnt(0);
        unsigned nloc = b.st[0], nx = b.st[1];
        if (nloc == 0u) { xcd_barrier_complete(bar, b.x, nloc, nx); b.st[0] = nloc; b.st[1] = nx; }
        const unsigned old = xb_add(&bar[XB_XSUB(b.x)], 1u);
        const unsigned gen = old / nloc;
        if (old + 1u == (gen + 1u) * nloc) {
            __builtin_amdgcn_fence(__ATOMIC_RELEASE, "agent");
            asm volatile("s_waitcnt vmcnt(0)" ::: "memory");
            const unsigned og = xb_add(&bar[XB_TOP], 1u);
            const unsigned tg = og / nx;
            if (og + 1u == (tg + 1u) * nx) xb_add(&bar[XB_TOPGEN], 1u);
            else XB_SPIN(xb_ld(&bar[XB_TOPGEN]) == tg, bar);
            __builtin_amdgcn_fence(__ATOMIC_ACQUIRE, "agent");
            xb_add(&bar[XB_XGEN(b.x)], 1u);
            asm volatile("s_waitcnt vmcnt(0)" ::: "memory");
        } else {
            XB_SPIN(xb_ld(&bar[XB_XGEN(b.x)]) == gen, bar);
            __builtin_amdgcn_fence(__ATOMIC_ACQUIRE, "agent");
            asm volatile("s_waitcnt vmcnt(0)" ::: "memory");
        }
    }
    __syncthreads();
}

namespace pg8 {
constexpr int BM = 256, BK = 64, HALF = 128, HTB = HALF * BK * 2, STAGE_BYTES = 8 * HTB, NXCD = 8, WGM = 8;
DI int lds_byte(int r, int c) { const int st = (r >> 4) * 2 + (c >> 5), rr = r & 15, cc = c & 31, ob = rr * 64 + cc * 2; return st * 1024 + (ob ^ (((ob >> 9) & 1) << 5)); }
DI void stage_rc(int b, int& R, int& C) { const int st = b / 1024, sb = b % 1024, swz = sb ^ (((sb >> 9) & 1) << 5); R = (st >> 1) * 16 + swz / 64; C = (st & 1) * 32 + (swz % 64) / 2; }
DI int perm32(int rho) { const int n = rho >> 4, i = rho & 15; return 8 * (i >> 2) + 4 * n + (i & 3); }
struct Unit { int pm, pn, e, x; };

DI bool static_unit(int i, int G, int c, int nM, int nN, int& pm, int& pn) {
    const int nwg = nM * nN; const long L = (long)i * G + c; if (L >= nwg) return false;
    int wgid = (int)L; { const int q = nwg / NXCD, r = nwg % NXCD, xcd = wgid % NXCD, off = wgid / NXCD; wgid = (xcd < r ? xcd * (q + 1) : r * (q + 1) + (xcd - r) * q) + off; }
    const int nig = WGM * nN, gid = wgid / nig, fm = gid * WGM, gsz = (nM - fm) < WGM ? (nM - fm) : WGM;
    pm = fm + ((wgid % nig) % gsz); pn = (wgid % nig) / gsz; return true;
}

template <class Epi, class Sched, bool ALIGN_EPI, int QM = 0  , bool ADJ = false  >
DI void gemm_phase(ldsp lds, const int K, const int lda, const int ldb, const Sched& S, const Epi& E) {
    int tid_ = threadIdx.x; asm volatile("" : "+v"(tid_));
    const int tid = tid_, wid = __builtin_amdgcn_readfirstlane(tid >> 6), lane = tid & 63, wr = wid >> 2, wc = wid & 3, fr = lane & 15, fq = lane >> 4;
    const int nt = K / BK; constexpr bool F8 = (QM == 1);
    unsigned voffB[2];
#pragma unroll
    for (int i = 0; i < 2; ++i) { int R, C; stage_rc(tid * 16 + i * 8192, R, C); const int Rb = ADJ ? ((R >> 5) * 64 + perm32(R & 31)) : (Epi::PERM ? ((R & ~31) + perm32(R & 31)) : R); voffB[i] = (unsigned)(Rb * ldb + C) * 2u; }
    unsigned vA[2][2], vAn[2][2];
    const size_t kstep = (size_t)(BK * 2);
    const size_t hstepB = (size_t)(ADJ ? 32 : HALF) * ldb * 2;
    const unsigned ldsw = (unsigned)wid * 1024u;
    const int aoff = lds_byte(wr * 64 + fr, fq * 8), boff = lds_byte(wc * 32 + fr, fq * 8);
#define PG8_SA(b, h) (((b) * 2 + (h)) * HTB)
#define PG8_SB(b, h) ((4 + (b) * 2 + (h)) * HTB)
#define PG8_STG(bufoff, p0, p1) do { \
        __builtin_amdgcn_global_load_lds((const unsigned*)(p0), (LAS unsigned*)(lds + (bufoff) + ldsw), 16, 0, 0); \
        __builtin_amdgcn_global_load_lds((const unsigned*)(p1), (LAS unsigned*)(lds + (bufoff) + ldsw + 8192), 16, 0, 0); } while (0)
#define PG8_STGB(bufoff, gbase) PG8_STG(bufoff, (gbase) + voffB[0], (gbase) + voffB[1])
#define PG8_STGA(bufoff, gbase, v, h) PG8_STG(bufoff, (gbase) + v[h][0], (gbase) + v[h][1])
#define PG8_LD16(off_) (*(const LAS v4i*)(lds + (off_)))
#define PG8_LDA(dst, b, h) do { if constexpr (F8) { _Pragma("unroll") for (int m = 0; m < 4; ++m) dst##8[m] = __builtin_shufflevector(PG8_LD16(PG8_SA(b, h) + aoff + m * 2048), PG8_LD16(PG8_SA(b, h) + aoff + m * 2048 + 1024), 0, 1, 2, 3, 4, 5, 6, 7); } \
        else { _Pragma("unroll") for (int m = 0; m < 4; ++m) _Pragma("unroll") for (int k = 0; k < 2; ++k) dst[m][k] = *(const LAS bf16x8*)(lds + PG8_SA(b, h) + aoff + m * 2048 + k * 1024); } } while (0)
#define PG8_LDB(dst, b, h) do { if constexpr (F8) { _Pragma("unroll") for (int n = 0; n < 2; ++n) dst##8[n] = __builtin_shufflevector(PG8_LD16(PG8_SB(b, h) + boff + n * 2048), PG8_LD16(PG8_SB(b, h) + boff + n * 2048 + 1024), 0, 1, 2, 3, 4, 5, 6, 7); } \
        else { _Pragma("unroll") for (int n = 0; n < 2; ++n) _Pragma("unroll") for (int k = 0; k < 2; ++k) dst[n][k] = *(const LAS bf16x8*)(lds + PG8_SB(b, h) + boff + n * 2048 + k * 1024); } } while (0)
#define PG8_MMA(ai, bj, At, Bt) do { __builtin_amdgcn_s_setprio(1); _Pragma("unroll") for (int m = 0; m < 4; ++m) _Pragma("unroll") for (int n = 0; n < 2; ++n) { \
        if constexpr (F8)   \
            asm volatile("v_mfma_scale_f32_16x16x128_f8f6f4 %0, %1, %2, %0, %3, %3 op_sel_hi:[0,0,0]" : "+v"(acc[ai][bj][m][n]) : "v"(Bt##8[n]), "v"(At##8[m]), "v"(sc127));   \
        else if constexpr (QM == 2) { _Pragma("unroll") for (int k = 0; k < 2; ++k) acc[ai][bj][m][n] = __builtin_bit_cast(f32x4, __builtin_amdgcn_mfma_i32_16x16x64_i8(__builtin_bit_cast(v4i, Bt[n][k]), __builtin_bit_cast(v4i, At[m][k]), __builtin_bit_cast(v4i, acc[ai][bj][m][n]), 0, 0, 0)); } \
        else { _Pragma("unroll") for (int k = 0; k < 2; ++k) acc[ai][bj][m][n] = __builtin_amdgcn_mfma_f32_16x16x32_bf16(Bt[n][k], At[m][k], acc[ai][bj][m][n], 0, 0, 0); } } \
        __builtin_amdgcn_s_setprio(0); } while (0)
#define PG8_WAIT_V(n) asm volatile("s_waitcnt vmcnt(" #n ")" ::: "memory")
#define PG8_WAIT_L(n) asm volatile("s_waitcnt lgkmcnt(" #n ")" ::: "memory")
#define PG8_BAR __builtin_amdgcn_s_barrier()
#define PG8_SCHED __builtin_amdgcn_sched_barrier(0)
    Unit cur, nxt; int ui = 0;
    if (!S.next(0, cur)) return;
    f32x4 acc[2][2][4][2];
#pragma unroll
    for (int a = 0; a < 2; ++a)
#pragma unroll
        for (int b = 0; b < 2; ++b)
#pragma unroll
            for (int m = 0; m < 4; ++m)
#pragma unroll
                for (int n = 0; n < 2; ++n) acc[a][b][m][n] = (f32x4){0.f, 0.f, 0.f, 0.f};
    int sc127 = 0x7f7f7f7f; asm volatile("" : "+v"(sc127));
    bf16x8 At[4][2], B0[2][2], B1[2][2];
    v8i At8[4], B08[2], B18[2];
    const char* cA = S.a_base(cur); const char* cB = S.b_base(cur);
    S.a_off(cur, tid, lda, vA);
#pragma unroll
    for (int h = 0; h < 2; ++h)
#pragma unroll
        for (int i = 0; i < 2; ++i) vAn[h][i] = vA[h][i];
    PG8_STGB(PG8_SB(0, 0), cB); PG8_STGB(PG8_SB(0, 1), cB + hstepB); PG8_STGA(PG8_SA(0, 0), cA, vA, 0); PG8_STGA(PG8_SA(0, 1), cA, vA, 1);
    if (wr == 1) PG8_BAR;
    PG8_WAIT_V(2); PG8_BAR;
    PG8_STGB(PG8_SB(1, 0), cB + kstep); PG8_STGA(PG8_SA(1, 0), cA + kstep, vA, 0); PG8_STGB(PG8_SB(1, 1), cB + hstepB + kstep);
    PG8_WAIT_V(6); PG8_BAR;
    for (;;) {
        const bool has_next = S.next(ui + 1, nxt);
        const char* nA = has_next ? S.a_base(nxt) : cA; const char* nB = has_next ? S.b_base(nxt) : cB;
        if (Sched::GATHER) { if (has_next) S.a_off(nxt, tid, lda, vAn); }
        for (int t = 0; t < nt; t += 2) {
            if constexpr (Epi::HOOK) E.hook(acc, cur, t, wr, wc, fr, fq);
            const bool last = (t == nt - 2);
            const char* a1 = cA + (size_t)(t + 1) * kstep;
            const char* a2 = last ? nA : cA + (size_t)(t + 2) * kstep; const char* b2 = last ? nB : cB + (size_t)(t + 2) * kstep;
            const char* a3 = a2 + kstep; const char* b3 = b2 + kstep;
            PG8_LDB(B0, 0, 0); PG8_LDB(B1, 0, 1); PG8_SCHED; PG8_LDA(At, 0, 0); PG8_STGA(PG8_SA(1, 1), a1, vA, 1);
            if (Sched::GATHER && last) {
#pragma unroll
                for (int h = 0; h < 2; ++h)
#pragma unroll
                    for (int i = 0; i < 2; ++i) vA[h][i] = vAn[h][i]; }
            PG8_WAIT_V(8); PG8_WAIT_L(0); PG8_BAR; PG8_MMA(0, 0, At, B0); PG8_MMA(0, 1, At, B1); PG8_BAR; PG8_SCHED;
            PG8_LDA(At, 0, 1); PG8_STGB(PG8_SB(0, 0), b2); PG8_STGB(PG8_SB(0, 1), b2 + hstepB); PG8_STGA(PG8_SA(0, 0), a2, vA, 0);
            PG8_WAIT_V(8); PG8_WAIT_L(0); PG8_BAR; PG8_MMA(1, 0, At, B0); PG8_MMA(1, 1, At, B1); PG8_BAR; PG8_SCHED;
            PG8_LDB(B0, 1, 0); PG8_LDB(B1, 1, 1); PG8_SCHED; PG8_LDA(At, 1, 0); PG8_STGA(PG8_SA(0, 1), a2, vA, 1);
            PG8_WAIT_V(8); PG8_WAIT_L(0); PG8_BAR; PG8_MMA(0, 0, At, B0); PG8_MMA(0, 1, At, B1); PG8_BAR; PG8_SCHED;
            PG8_LDA(At, 1, 1); PG8_STGB(PG8_SB(1, 0), b3); PG8_STGB(PG8_SB(1, 1), b3 + hstepB); PG8_STGA(PG8_SA(1, 0), a3, vA, 0);
            PG8_WAIT_V(8); PG8_WAIT_L(0); PG8_BAR; PG8_MMA(1, 0, At, B0); PG8_MMA(1, 1, At, B1); PG8_BAR; PG8_SCHED;
        }
        if constexpr (ALIGN_EPI) { if (wr == 0) PG8_BAR; }
        if constexpr (F8) asm volatile("s_nop 15\n\ts_nop 15" ::: "memory");
        if constexpr (QM == 2) {
#pragma unroll
            for (int a = 0; a < 2; ++a)
#pragma unroll
                for (int b = 0; b < 2; ++b)
#pragma unroll
                    for (int m = 0; m < 4; ++m)
#pragma unroll
                        for (int n = 0; n < 2; ++n) { const v4i iv = __builtin_bit_cast(v4i, acc[a][b][m][n]); acc[a][b][m][n] = (f32x4){(float)iv[0], (float)iv[1], (float)iv[2], (float)iv[3]}; } }
        E(acc, cur, wr, wc, fr, fq);
        if (!has_next) break;
#pragma unroll
        for (int a = 0; a < 2; ++a)
#pragma unroll
            for (int b = 0; b < 2; ++b)
#pragma unroll
                for (int m = 0; m < 4; ++m)
#pragma unroll
                    for (int n = 0; n < 2; ++n) acc[a][b][m][n] = (f32x4){0.f, 0.f, 0.f, 0.f};
        cur = nxt; cA = nA; cB = nB; ++ui;
#pragma unroll
        for (int h = 0; h < 2; ++h)
#pragma unroll
            for (int i = 0; i < 2; ++i) vA[h][i] = vAn[h][i];
        if constexpr (ALIGN_EPI) { if (wr == 1) PG8_BAR; }
    }
    PG8_WAIT_V(0);
    if constexpr (!ALIGN_EPI) { if (wr == 0) PG8_BAR; }
    PG8_BAR;
#undef PG8_SA
#undef PG8_SB
#undef PG8_STG
#undef PG8_STGB
#undef PG8_STGA
#undef PG8_LD16
#undef PG8_LDA
#undef PG8_LDB
#undef PG8_MMA
#undef PG8_WAIT_V
#undef PG8_WAIT_L
#undef PG8_BAR
#undef PG8_SCHED
}

struct SchedDense {
    static constexpr bool GATHER = false;
    const char* A; const char* B; int nM, nN, G, c, lda, ldb;
    DI bool next(int i, Unit& u) const { u.e = 0; u.x = 0; return static_unit(i, G, c, nM, nN, u.pm, u.pn); }
    DI const char* a_base(const Unit& u) const { return A + (size_t)u.pm * 256 * lda * 2; }
    DI const char* b_base(const Unit& u) const { return B + (size_t)u.pn * 256 * ldb * 2; }
    DI void a_off(const Unit&, int tid, int lda_, unsigned (&v)[2][2]) const {
#pragma unroll
        for (int i = 0; i < 2; ++i) { int R, C; stage_rc(tid * 16 + i * 8192, R, C);
#pragma unroll
            for (int h = 0; h < 2; ++h) v[h][i] = (unsigned)((h * 128 + R) * lda_ + C) * 2u; }
    }
};
template <int MODE> struct SchedProj {
    static constexpr bool GATHER = false;
    const char* A; const char* B; int G, c, lda, ldb;
    DI bool next(int i, Unit& u) const { u.x = 0; if (!static_unit(i, G, c, SEQ / 256, MODE == 2 ? 32 : (MODE == 1 ? 20 : 12), u.pm, u.pn)) return false;
        const int p = u.pn; u.e = MODE == 2 ? p : (MODE == 1 ? (p < 4 ? p + 4 : (p < 7 ? p + 10 : (p == 7 ? 18 : p + 11))) : (p < 4 ? p : (p < 10 ? p + 4 : (p == 10 ? 17 : 31)))); return true; }
    DI const char* a_base(const Unit& u) const { return A + (size_t)u.pm * 256 * lda * 2; }
    DI const char* b_base(const Unit& u) const { return B + (size_t)u.e * 256 * ldb * 2; }
    DI void a_off(const Unit&, int tid, int lda_, unsigned (&v)[2][2]) const {
#pragma unroll
        for (int i = 0; i < 2; ++i) { int R, C; stage_rc(tid * 16 + i * 8192, R, C);
#pragma unroll
            for (int h = 0; h < 2; ++h) v[h][i] = (unsigned)((h * 128 + R) * lda_ + C) * 2u; }
    }
};
struct SchedKV {
    static constexpr bool GATHER = false;
    const char* memn; const char* wkv; int G, c, first;
    DI bool next(int i, Unit& u) const {
        int cc = c - first; if (cc < 0) cc += G; const int L = i * G + cc; if (L >= 16) return false;
        u.e = L >> 2; u.x = (L >> 1) & 1; const int j = L & 1; u.pm = u.x ? j : 0; u.pn = u.x ? 0 : j; return true;
    }
    DI const char* a_base(const Unit& u) const { return u.x ? wkv + (size_t)u.e * 1024 * 1024 * 2 + (size_t)(512 + u.pm * 256) * 1024 * 2 : memn + (size_t)u.e * 256 * 1024 * 2; }
    DI const char* b_base(const Unit& u) const { return u.x ? memn + (size_t)u.e * 256 * 1024 * 2 : wkv + (size_t)u.e * 1024 * 1024 * 2 + (size_t)(u.pn * 256) * 1024 * 2; }
    DI void a_off(const Unit&, int tid, int lda_, unsigned (&v)[2][2]) const {
#pragma unroll
        for (int i = 0; i < 2; ++i) { int R, C; stage_rc(tid * 16 + i * 8192, R, C);
#pragma unroll
            for (int h = 0; h < 2; ++h) v[h][i] = (unsigned)((h * 128 + R) * lda_ + C) * 2u; }
    }
};
template <bool UP> struct SchedMoe {
    static constexpr bool GATHER = false;
    const char* A; const char* B; size_t bstride; volatile LAS unsigned* lc; int nN, G, c, lda, ldb; int i0 = 0, imax = 1 << 28;
    DI bool next(int i, Unit& u) const {
        const int T = __builtin_amdgcn_readfirstlane((int)lc[LC_TB + 8]);
        if (i + i0 >= imax) return false;
        if (!static_unit(i + i0, G, c, T, nN, u.pm, u.pn)) return false;
        int e = 0, tbe = 0;
#pragma unroll
        for (int j = 1; j < 8; ++j) { const int tbj = __builtin_amdgcn_readfirstlane((int)lc[LC_TB + j]); if (u.pm >= tbj) { e = j; tbe = tbj; } }
        u.e = e; u.x = (u.pm - tbe) * 256; return true;
    }
    DI const char* a_base(const Unit& u) const { return UP ? A + ((size_t)u.e * SEQ + u.x) * lda * 2 : A + (size_t)u.pm * 256 * lda * 2; }
    DI const char* b_base(const Unit& u) const { return B + (size_t)u.e * bstride + (size_t)u.pn * 256 * ldb * 2; }
    DI void a_off(const Unit&, int tid, int lda_, unsigned (&v)[2][2]) const {
#pragma unroll
        for (int i = 0; i < 2; ++i) { int R, C; stage_rc(tid * 16 + i * 8192, R, C);
#pragma unroll
            for (int h = 0; h < 2; ++h) v[h][i] = (unsigned)((h * 128 + R) * lda_ + C) * 2u; }
    }
};

struct EpiProj {
    static constexpr bool PERM = true, HOOK = false;
    bf16* mq; bf16* dq; bf16* xq; bf16* gt; float* ifg; const float* bias8; float sc; const u64* rs; float qd;
    DI void operator()(const f32x4 (&acc)[2][2][4][2], const Unit& u, int wr, int wc, int fr, int fq) const {
        const int row0 = u.pm * BM + wr * 64 + fr; const int pn = u.e;
        float rsc[2][4];
#pragma unroll
        for (int ai = 0; ai < 2; ++ai)
#pragma unroll
            for (int m = 0; m < 4; ++m) rsc[ai][m] = rs ? (float)rs[row0 + ai * HALF + m * 16] * RS_UNFIX : 0.f;
#pragma unroll
        for (int ai = 0; ai < 2; ++ai)
#pragma unroll
            for (int m = 0; m < 4; ++m) rsc[ai][m] = rs ? sc / sqrtf(rsc[ai][m] * (1.f / DM) + EPS) : sc;
        if (pn == 31) {
            if (wc == 0 && fq == 0) { const f32x4 bi = *(const f32x4*)bias8, bf = *(const f32x4*)(bias8 + 4);
#pragma unroll
                for (int ai = 0; ai < 2; ++ai)
#pragma unroll
                    for (int m = 0; m < 4; ++m) { float* p = ifg + (size_t)(row0 + ai * HALF + m * 16) * 8; f32x4 vi = acc[ai][0][m][0] * rsc[ai][m] + bi, vf = acc[ai][0][m][1] * rsc[ai][m] + bf;
#pragma unroll
                        for (int q = 0; q < 4; ++q) vf[q] = fminf(vf[q], 0.f) - __logf(1.0f + __expf(-fabsf(vf[q])));
                        *(f32x4*)p = vi; *(f32x4*)(p + 4) = vf; } }
            return; }
        const bool sg = pn >= 19; const float scl = (pn == 17 || pn == 18) ? RS128 : ((pn >= 8 && pn < 11) ? qd : 1.0f);
#pragma unroll
        for (int bj = 0; bj < 2; ++bj) {
            bf16* base; int rstride; int sh = 0;
            if (pn < 8) { const int sel = pn >> 1, h = (pn & 1) * 2 + (wc >> 1); base = mq + (size_t)(sel * 4 + h) * SEQ * 128 + (wc & 1) * 64 + bj * 32 + 8 * fq; rstride = 128; }
            else if (pn < 17) { const int t = pn - 8, sel = t / 3, gh = (t % 3) * 4 + wc; sh = 2 * (gh >> 2); base = dq + (size_t)(sel * 12 + gh) * SEQ * 64 + bj * 32 + 8 * fq; rstride = 64; }
            else if (pn < 19) { const int hx = (pn - 17) * 2 + (wc >> 1); base = xq + (size_t)hx * SEQ * 128 + (wc & 1) * 64 + bj * 32 + 8 * fq; rstride = 128; }
            else {
                unsigned char* gb = (unsigned char*)gt + (pn - 19) * 256 + wc * 64 + bj * 32 + 8 * fq;
#pragma unroll
                for (int ai = 0; ai < 2; ++ai)
#pragma unroll
                    for (int m = 0; m < 4; ++m) { const int row = row0 + ai * HALF + m * 16;
                        f32x4 v0 = acc[ai][bj][m][0] * rsc[ai][m], v1 = acc[ai][bj][m][1] * rsc[ai][m];
#pragma unroll
                        for (int q = 0; q < 4; ++q) { v0[q] = sigmoidf_(v0[q]); v1[q] = sigmoidf_(v1[q]); }
                        u32x2 w; w.x = pk4_u8(v0); w.y = pk4_u8(v1); *(u32x2*)(gb + (size_t)row * 3072) = w; }
                continue; }
#pragma unroll
            for (int ai = 0; ai < 2; ++ai)
#pragma unroll
                for (int m = 0; m < 4; ++m) { const int row = row0 + ai * HALF + m * 16; const int pos = ((row & ((1 << sh) - 1)) << (14 - sh)) + (row >> sh);
                    f32x4 v0 = acc[ai][bj][m][0] * (scl * rsc[ai][m]), v1 = acc[ai][bj][m][1] * (scl * rsc[ai][m]);
                    if (sg) {
#pragma unroll
                        for (int q = 0; q < 4; ++q) { v0[q] = sigmoidf_(v0[q]); v1[q] = sigmoidf_(v1[q]); } }
                    u32x4 w; w.x = cvt_pk_bf16(v0[0], v0[1]); w.y = cvt_pk_bf16(v0[2], v0[3]); w.z = cvt_pk_bf16(v1[0], v1[1]); w.w = cvt_pk_bf16(v1[2], v1[3]);
                    st16_wt(base + (size_t)pos * rstride, w); } }
    }
};
struct EpiKV {
    static constexpr bool PERM = true, HOOK = false;
    bf16* km; bf16* vmt;
    DI void operator()(const f32x4 (&acc)[2][2][4][2], const Unit& u, int wr, int wc, int fr, int fq) const {
        bf16* O = u.x ? vmt + (size_t)u.e * 512 * 256 : km + (size_t)u.e * 256 * 512; const int ldc = u.x ? 256 : 512;
        const int row0 = u.pm * BM + wr * 64 + fr, col0 = u.pn * BM + wc * 32 + 8 * fq;
#pragma unroll
        for (int ai = 0; ai < 2; ++ai)
#pragma unroll
            for (int m = 0; m < 4; ++m) { bf16* rowp = O + (size_t)(row0 + ai * HALF + m * 16) * ldc + col0;
#pragma unroll
                for (int bj = 0; bj < 2; ++bj) { const f32x4 v0 = acc[ai][bj][m][0], v1 = acc[ai][bj][m][1];
                    u32x4 w; w.x = cvt_pk_bf16(v0[0], v0[1]); w.y = cvt_pk_bf16(v0[2], v0[3]); w.z = cvt_pk_bf16(v1[0], v1[1]); w.w = cvt_pk_bf16(v1[2], v1[3]);
                    *(u32x4*)(rowp + bj * HALF) = w; } }
    }
};
struct EpiBranchFused {
    static constexpr bool PERM = true, HOOK = true;
    bf16* Mg; const unsigned char* gates;
    DI void hook(f32x4 (&acc)[2][2][4][2], const Unit& u, int t, int wr, int wc, int fr, int fq) const {
        if (t != 8 && t != 12) return;
        const int gnum = (t == 8) ? 0 : 1024;
        const unsigned char* gp0 = gates + (size_t)(u.pm * BM + wr * 64 + fr) * 3072 + u.pn * BM + wc * 32 + 8 * fq + gnum;
#pragma unroll
        for (int ai = 0; ai < 2; ++ai)
#pragma unroll
            for (int mp = 0; mp < 2; ++mp) {
                u32x2 gn[2][2], gd[2][2];
#pragma unroll
                for (int mm = 0; mm < 2; ++mm)
#pragma unroll
                    for (int bj = 0; bj < 2; ++bj) { const unsigned char* gp = gp0 + (size_t)(ai * HALF + (2 * mp + mm) * 16) * 3072 + bj * HALF; gn[mm][bj] = *(const u32x2*)gp; gd[mm][bj] = *(const u32x2*)(gp + 1024); }
#pragma unroll
                for (int mm = 0; mm < 2; ++mm)
#pragma unroll
                    for (int bj = 0; bj < 2; ++bj) { const int m = 2 * mp + mm; const u32x2 n2 = gn[mm][bj], d2 = gd[mm][bj];
                        f32x4 v0 = acc[ai][bj][m][0], v1 = acc[ai][bj][m][1];
#pragma unroll
                        for (int q = 0; q < 4; ++q) { v0[q] *= gate_u8(n2.x, q) * frcp(gate_u8(d2.x, q)); v1[q] *= gate_u8(n2.y, q) * frcp(gate_u8(d2.y, q)); }
                        acc[ai][bj][m][0] = v0; acc[ai][bj][m][1] = v1; }
                asm volatile("" : "+v"(acc[ai][0][2 * mp][0]), "+v"(acc[ai][1][2 * mp + 1][1]) :: "memory"); }
    }
    DI void operator()(const f32x4 (&acc)[2][2][4][2], const Unit& u, int wr, int wc, int fr, int fq) const {
        const int row0 = u.pm * BM + wr * 64 + fr, col0 = u.pn * BM + wc * 32 + 8 * fq;
#pragma unroll
        for (int ai = 0; ai < 2; ++ai) { u32x2 g[4][2];
#pragma unroll
            for (int m = 0; m < 4; ++m)
#pragma unroll
                for (int bj = 0; bj < 2; ++bj) g[m][bj] = *(const u32x2*)(gates + (size_t)(row0 + ai * HALF + m * 16) * 3072 + 2048 + col0 + bj * HALF);
#pragma unroll
            for (int m = 0; m < 4; ++m) { const size_t row = (size_t)(row0 + ai * HALF + m * 16);
#pragma unroll
                for (int bj = 0; bj < 2; ++bj) { f32x4 v0 = acc[ai][bj][m][0], v1 = acc[ai][bj][m][1];
#pragma unroll
                    for (int q = 0; q < 4; ++q) { v0[q] *= gate_u8(g[m][bj].x, q) * (1.0f / 255.0f); v1[q] *= gate_u8(g[m][bj].y, q) * (1.0f / 255.0f); }
                    u32x4 w; w.x = cvt_pk_bf16(v0[0], v0[1]); w.y = cvt_pk_bf16(v0[2], v0[3]); w.z = cvt_pk_bf16(v1[0], v1[1]); w.w = cvt_pk_bf16(v1[2], v1[3]);
                    st16_wt(Mg + row * DM + col0 + bj * HALF, w); } } }
    }
};
template <int XB, bool IN_F32> struct EpiRes {
    static constexpr bool PERM = true, HOOK = false;
    const void* in; bf16* out; float sc; const float* gain; unsigned char* xb; u64* rs;
    DI void operator()(const f32x4 (&acc)[2][2][4][2], const Unit& u, int wr, int wc, int fr, int fq) const {
        const int row0 = u.pm * BM + wr * 64 + fr, col0 = u.pn * BM + wc * 32 + 8 * fq;
        f32x4 gv[2][2];
        if (XB) {
#pragma unroll
            for (int bj = 0; bj < 2; ++bj)
#pragma unroll
                for (int n = 0; n < 2; ++n) gv[bj][n] = *(const f32x4*)(gain + col0 + bj * HALF + 4 * n); }
        constexpr int MB = 2;
#pragma unroll
        for (int ai = 0; ai < 2; ++ai)
#pragma unroll
          for (int m0 = 0; m0 < 4; m0 += MB) { f32x4 b[MB][2][2];
#pragma unroll
            for (int mm = 0; mm < MB; ++mm) { const size_t off = (size_t)(row0 + ai * HALF + (m0 + mm) * 16) * DM + col0;
#pragma unroll
                for (int bj = 0; bj < 2; ++bj) {
                    if (IN_F32) { b[mm][bj][0] = *(const f32x4*)((const float*)in + off + bj * HALF); b[mm][bj][1] = *(const f32x4*)((const float*)in + off + bj * HALF + 4); }
                    else { const u32x4 r = *(const u32x4*)((const bf16*)in + off + bj * HALF); b[mm][bj][0] = (f32x4){bflo(r.x), bfhi(r.x), bflo(r.y), bfhi(r.y)}; b[mm][bj][1] = (f32x4){bflo(r.z), bfhi(r.z), bflo(r.w), bfhi(r.w)}; } } }
#pragma unroll
            for (int mm = 0; mm < MB; ++mm) { const int m = m0 + mm; const int row = row0 + ai * HALF + m * 16; const size_t off = (size_t)row * DM + col0; float ss = 0.f;
#pragma unroll
                for (int bj = 0; bj < 2; ++bj) { const f32x4 s0 = b[mm][bj][0] + acc[ai][bj][m][0] * sc, s1 = b[mm][bj][1] + acc[ai][bj][m][1] * sc;
                    u32x4 w; w.x = cvt_pk_bf16(s0[0], s0[1]); w.y = cvt_pk_bf16(s0[2], s0[3]); w.z = cvt_pk_bf16(s1[0], s1[1]); w.w = cvt_pk_bf16(s1[2], s1[3]);
                    st16_wt(out + off + bj * HALF, w);
                    if (XB) { const f32x4 v0 = (f32x4){bflo(w.x), bfhi(w.x), bflo(w.y), bfhi(w.y)}, v1 = (f32x4){bflo(w.z), bfhi(w.z), bflo(w.w), bfhi(w.w)};
                        ss += ((v0[0] * v0[0] + v0[1] * v0[1]) + (v0[2] * v0[2] + v0[3] * v0[3])) + ((v1[0] * v1[0] + v1[1] * v1[1]) + (v1[2] * v1[2] + v1[3] * v1[3]));
                        const f32x4 g0 = v0 * gv[bj][0], g1 = v1 * gv[bj][1];
                        if (XB == 1) { u32x4 x; x.x = cvt_pk_bf16(g0[0], g0[1]); x.y = cvt_pk_bf16(g0[2], g0[3]); x.z = cvt_pk_bf16(g1[0], g1[1]); x.w = cvt_pk_bf16(g1[2], g1[3]); *(u32x4*)(xb + (off + bj * HALF) * 2) = x; }
                        else { u32x2 x; x.x = pk4_i8(g0[0] * S_XB8, g0[1] * S_XB8, g0[2] * S_XB8, g0[3] * S_XB8); x.y = pk4_i8(g1[0] * S_XB8, g1[1] * S_XB8, g1[2] * S_XB8, g1[3] * S_XB8); *(u32x2*)(xb + off + bj * HALF) = x; } } }
                if (XB) { const int lane = (fq << 4) | fr; ss += shx(ss, 16, lane); ss += shx(ss, 32, lane);
                    if (fq == 0) (void)__hip_atomic_fetch_add(rs + row, (u64)(ss * RS_FIX), __ATOMIC_RELAXED, __HIP_MEMORY_SCOPE_AGENT); } } }
    }
};
template <bool MOE, bool H8 = MOE> struct EpiSwiglu {
    static constexpr bool PERM = true, HOOK = false;
    unsigned char* H; int ldh; const float* gatee; volatile LAS unsigned* lc; float sc; const u64* rs;
    DI void operator()(const f32x4 (&acc)[2][2][4][2], const Unit& u, int wr, int wc, int fr, int fq) const {
        const int r0 = wr * 64 + fr, col0 = u.pn * HALF + wc * 32 + 8 * fq;
        int cnt = 0; if (MOE) cnt = __builtin_amdgcn_readfirstlane((int)lc[LC_CNT + u.e]);
        float rgs[2][4];
#pragma unroll
        for (int ai = 0; ai < 2; ++ai)
#pragma unroll
            for (int m = 0; m < 4; ++m) { rgs[ai][m] = 1.f; if (MOE) { const int pos = u.x + r0 + ai * HALF + m * 16; rgs[ai][m] = pos < cnt ? gatee[u.e * SEQ + pos] : 0.f; }
                else if (rs) rgs[ai][m] = (float)rs[u.pm * BM + r0 + ai * HALF + m * 16] * RS_UNFIX; }
#pragma unroll
        for (int ai = 0; ai < 2; ++ai)
#pragma unroll
            for (int m = 0; m < 4; ++m) { const int r = r0 + ai * HALF + m * 16;
                const float rg = rgs[ai][m];
                const f32x4 g0 = acc[ai][0][m][0], g1 = acc[ai][0][m][1], u0 = acc[ai][1][m][0], u1 = acc[ai][1][m][1];
                float o[8];
                const float rsd = (!MOE && rs) ? sc / sqrtf(rg * (1.f / DM) + EPS) : sc, rgm = MOE ? rg : 1.f;
#pragma unroll
                for (int q = 0; q < 4; ++q) { o[q] = siluf_(g0[q] * rsd) * (u0[q] * rsd) * rgm; o[4 + q] = siluf_(g1[q] * rsd) * (u1[q] * rsd) * rgm; }
                if (H8) { u32x2 w; w.x = pk4_fp8(o[0], o[1], o[2], o[3]); w.y = pk4_fp8(o[4], o[5], o[6], o[7]); *(u32x2*)(H + (size_t)(u.pm * BM + r) * ldh + col0) = w; }
                else { u32x4 w; w.x = cvt_pk_bf16(o[0], o[1]); w.y = cvt_pk_bf16(o[2], o[3]); w.z = cvt_pk_bf16(o[4], o[5]); w.w = cvt_pk_bf16(o[6], o[7]); st16_wt(H + ((size_t)(u.pm * BM + r) * ldh + col0) * 2, w); } }
    }
};
struct EpiMoeDown {
    static constexpr bool PERM = true, HOOK = false;
    bf16* ys; const int* toke; volatile LAS unsigned* lc; float sc;
    DI void operator()(const f32x4 (&acc)[2][2][4][2], const Unit& u, int wr, int wc, int fr, int fq) const {
        const int r0 = wr * 64 + fr, col0 = u.pn * BM + wc * 32 + 8 * fq; const int cnt = __builtin_amdgcn_readfirstlane((int)lc[LC_CNT + u.e]);
        int tks[2][4];
#pragma unroll
        for (int ai = 0; ai < 2; ++ai)
#pragma unroll
            for (int m = 0; m < 4; ++m) { const int pos = u.x + r0 + ai * HALF + m * 16; tks[ai][m] = pos < cnt ? toke[u.e * SEQ + pos] : 0; }
#pragma unroll
        for (int ai = 0; ai < 2; ++ai)
#pragma unroll
            for (int m = 0; m < 4; ++m) { const int pos = u.x + r0 + ai * HALF + m * 16;
                if (pos < cnt) { const int tk = tks[ai][m]; bf16* rowp = ys + ((size_t)(tk >> 20) * SEQ + (size_t)(tk & 0xFFFFF)) * DM + col0;
#pragma unroll
                    for (int bj = 0; bj < 2; ++bj) { const f32x4 v0 = acc[ai][bj][m][0] * sc, v1 = acc[ai][bj][m][1] * sc;
                        u32x4 w; w.x = cvt_pk_bf16(v0[0], v0[1]); w.y = cvt_pk_bf16(v0[2], v0[3]); w.z = cvt_pk_bf16(v1[0], v1[1]); w.w = cvt_pk_bf16(v1[2], v1[3]);
                        st16_wt(rowp + bj * HALF, w); } } }
    }
};
}

struct Args { const float* in[22]; float* out; unsigned char* ws; };
struct Frame {
    ldsp lds; volatile LAS unsigned* lc; unsigned* ctl;
    int tid, lane, wave, vcu, G;
    unsigned char* ws;
    unsigned long long pacc;
    const __attribute__((address_space(4))) Args* ka;
};
DI void refresh(Frame& F) {
    int t = threadIdx.x; asm volatile("" : "+v"(t)); F.tid = t; F.lane = t & 63; F.wave = __builtin_amdgcn_readfirstlane(t >> 6);
    const __attribute__((address_space(4))) Args* ka = (const __attribute__((address_space(4))) Args*)__builtin_amdgcn_kernarg_segment_ptr(); asm volatile("" : "+s"(ka)); F.ka = ka;
    unsigned char* w = ka->ws; F.ws = w; F.ctl = (unsigned*)(w + WS_CTL);
    int vc = F.vcu, gg = F.G; asm volatile("" : "+s"(vc), "+s"(gg)); F.vcu = vc; F.G = gg;
}
enum { I_X = 0, I_MEM, I_NORM_MIX, I_W_IN, I_CONV, I_BIF, I_MLSTM_NORM, I_NORM_MEM, I_W_MEM_KV, I_W_BR_M, I_W_BR_D, I_W_BR_X, I_W_OUT, I_NORM_FFN,
       I_FFN_G, I_FFN_U, I_FFN_D, I_ROUTER, I_MOE_G, I_MOE_U, I_MOE_D, I_NORM_FINAL };

DI void cvt_item(const float* src, int sld, int scol0, bf16* dst, int dld, int drow0, int k0, float scale, LAS float* scr, int lane) {
    f32x4 v[16];
    const float* s0 = src + (size_t)(k0 + (lane >> 4)) * sld + scol0 + 4 * (lane & 15);
#pragma unroll
    for (int i = 0; i < 16; ++i) v[i] = __builtin_nontemporal_load((const f32x4*)(s0 + (size_t)(4 * i) * sld));
#pragma unroll
    for (int i = 0; i < 16; ++i) { LAS float* p = scr + (4 * i + (lane >> 4)) * 65 + 4 * (lane & 15); p[0] = v[i].x * scale; p[1] = v[i].y * scale; p[2] = v[i].z * scale; p[3] = v[i].w * scale; }
    LDS_WAIT(); asm volatile("" ::: "memory");
    const int c = lane & 7;
#pragma unroll
    for (int j = 0; j < 8; ++j) { const int n = (lane >> 3) + 8 * j; const LAS float* s = scr + (8 * c) * 65 + n;
        u32x4 o; o.x = cvt_pk_bf16(s[0], s[65]); o.y = cvt_pk_bf16(s[2 * 65], s[3 * 65]); o.z = cvt_pk_bf16(s[4 * 65], s[5 * 65]); o.w = cvt_pk_bf16(s[6 * 65], s[7 * 65]);
        *(u32x4*)(dst + (size_t)(drow0 + n) * dld + k0 + 8 * c) = o; }
    LDS_WAIT(); asm volatile("" ::: "memory");
}
DI bool proj_tile_bf16(int t) { return t < 4 || (t >= 8 && t < 14) || t == 17 || t == 31; }
constexpr int NBF = 0;
constexpr int D8_MASK = 2;
constexpr int DD8_MASK = 2;
constexpr int N_DEFER = 9;
template <bool I8 = false> DI void cvt_item8(const float* src, int sld, int scol0, unsigned char* dst, int dld, int drow0, int k0, float scale, LAS float* scr, int lane) {
    f32x4 v[16];
    const float* s0 = src + (size_t)(k0 + (lane >> 4)) * sld + scol0 + 4 * (lane & 15);
#pragma unroll
    for (int i = 0; i < 16; ++i) v[i] = __builtin_nontemporal_load((const f32x4*)(s0 + (size_t)(4 * i) * sld));
#pragma unroll
    for (int i = 0; i < 16; ++i) { LAS float* p = scr + (4 * i + (lane >> 4)) * 65 + 4 * (lane & 15); p[0] = v[i].x * scale; p[1] = v[i].y * scale; p[2] = v[i].z * scale; p[3] = v[i].w * scale; }
    LDS_WAIT(); asm volatile("" ::: "memory");
    const int c = lane & 3;
#pragma unroll
    for (int j = 0; j < 4; ++j) { const int n = (lane >> 2) + 16 * j; const LAS float* s = scr + (16 * c) * 65 + n;
        u32x4 o;
        if (I8) { o.x = pk4_i8(s[0], s[65], s[2 * 65], s[3 * 65]); o.y = pk4_i8(s[4 * 65], s[5 * 65], s[6 * 65], s[7 * 65]); o.z = pk4_i8(s[8 * 65], s[9 * 65], s[10 * 65], s[11 * 65]); o.w = pk4_i8(s[12 * 65], s[13 * 65], s[14 * 65], s[15 * 65]); }
        else { o.x = pk4_fp8(s[0], s[65], s[2 * 65], s[3 * 65]); o.y = pk4_fp8(s[4 * 65], s[5 * 65], s[6 * 65], s[7 * 65]); o.z = pk4_fp8(s[8 * 65], s[9 * 65], s[10 * 65], s[11 * 65]); o.w = pk4_fp8(s[12 * 65], s[13 * 65], s[14 * 65], s[15 * 65]); }
        *(u32x4*)(dst + (size_t)(drow0 + n) * dld + k0 + 16 * c) = o; }
    LDS_WAIT(); asm volatile("" ::: "memory");
}
DI void prologue_convert(Frame& F) {
    LAS float* scr = (LAS float*)(F.lds + F.wave * 16640);
    const int gw = F.vcu * 8 + F.wave, NGW = F.G * 8, lane = F.lane;
    unsigned char* ws = F.ws;
    constexpr int PER_L = 2000 + 256 + 128 + 64 + 128 + 256, N_L = 4 * PER_L, PER_D = 3 * 704, N_D = 2 * PER_D, PER_E = 3 * 896, N_E = (16 - N_DEFER) * PER_E;
    for (int it = gw; it < N_L + N_D + N_E; it += NGW) {
        int r = it;
        if (r < N_L) { const int l = r / PER_L; r -= l * PER_L;
            if (r < 2000) { const int kb = r / 125, nb = r % 125, n0 = nb * 64; const int scol = n0 < 2048 ? n0 : (n0 < PC ? n0 + 8 : 2048);
                const float sc = (n0 >= C_QD && n0 < C_KD) ? 0.125f : 1.0f;
                if (l < NBF) cvt_item(F.ka->in[I_W_IN] + (size_t)l * DM * IN_COLS, IN_COLS, scol, (bf16*)(ws + WS_WINB + (size_t)l * 16 * MiB), DM, n0, kb * 64, sc, scr, lane);
                else cvt_item8<true>(F.ka->in[I_W_IN] + (size_t)l * DM * IN_COLS, IN_COLS, scol, ws + WS_WIN + (size_t)l * SZ_WIN, DM, n0, kb * 64, S_W8I, scr, lane);
                continue; }
            r -= 2000;
            if (r < 256) { const int kb = r >> 4, nb = r & 15; cvt_item(F.ka->in[I_W_MEM_KV] + (size_t)l * DM * DM, DM, nb * 64, (bf16*)(ws + WS_WKV) + (size_t)l * DM * DM, DM, nb * 64, kb * 64, 1.f, scr, lane); continue; }
            r -= 256;
            if (r < 128) { const int kb = r >> 4, nb = r & 15; cvt_item(F.ka->in[I_W_BR_M] + (size_t)l * 512 * DM, DM, nb * 64, (bf16*)(ws + WS_WBRM) + (size_t)l * DM * HCW, HCW, nb * 64, kb * 64, 1.f, scr, lane); continue; }
            r -= 128;
            if (r < 64) { const int kb = r >> 4, nb = r & 15; cvt_item(F.ka->in[I_W_BR_D] + (size_t)l * 256 * DM, DM, nb * 64, (bf16*)(ws + WS_WBRM) + (size_t)l * DM * HCW + 512, HCW, nb * 64, kb * 64, 1.f, scr, lane); continue; }
            r -= 64;
            if (r < 128) { const int kb = r >> 4, nb = r & 15; cvt_item(F.ka->in[I_W_BR_X] + (size_t)l * 512 * DM, DM, nb * 64, (bf16*)(ws + WS_WBRM) + (size_t)l * DM * HCW + 768, HCW, nb * 64, kb * 64, 1.f, scr, lane); continue; }
            r -= 128;
            { const int kb = r >> 4, nb = r & 15; cvt_item(F.ka->in[I_W_OUT] + (size_t)l * DM * DM, DM, nb * 64, (bf16*)(ws + WS_WOUT) + (size_t)l * DM * DM, DM, nb * 64, kb * 64, 1.f, scr, lane); continue; }
        }
        r -= N_L;
        if (r < N_D) { const int j = r / PER_D; r -= j * PER_D;
            if (r < 1408) { const int up = r >= 704; if (up) r -= 704; const int kb = r / 44, nb = r % 44, n0 = nb * 64; const int drow = 256 * (n0 >> 7) + (n0 & 127) + (up ? 128 : 0);
                if ((D8_MASK >> j) & 1) cvt_item8<true>(F.ka->in[up ? I_FFN_U : I_FFN_G] + (size_t)j * DM * DFF, DFF, n0, ws + WS_FGU + (size_t)j * SZ_FGU, DM, drow, kb * 64, S_W8I, scr, lane);
                else cvt_item(F.ka->in[up ? I_FFN_U : I_FFN_G] + (size_t)j * DM * DFF, DFF, n0, (bf16*)(ws + WS_FGU + (size_t)j * SZ_FGU), DM, drow, kb * 64, 1.f, scr, lane);
                continue; }
            r -= 1408;
            { const int kb = r >> 4, nb = r & 15;
              if ((DD8_MASK >> j) & 1) cvt_item8<false>(F.ka->in[I_FFN_D] + (size_t)j * DFF * DM, DM, nb * 64, ws + WS_FD + (size_t)j * SZ_FD, DFF, nb * 64, kb * 64, W8_DN, scr, lane);
              else cvt_item(F.ka->in[I_FFN_D] + (size_t)j * DFF * DM, DM, nb * 64, (bf16*)(ws + WS_FD + (size_t)j * SZ_FD), DFF, nb * 64, kb * 64, 1.f, scr, lane);
              continue; }
        }
        r -= N_D;
        { const int jx = r / PER_E; r -= jx * PER_E; const int je = jx < 4 ? jx : jx + 4;
            if (r < 1792) { const int up = r >= 896; if (up) r -= 896; const int kb = r / 56, nb = r % 56, n0 = nb * 64; const int drow = 256 * (n0 >> 7) + (n0 & 127) + (up ? 128 : 0);
                cvt_item8<true>(F.ka->in[up ? I_MOE_U : I_MOE_G] + (size_t)je * DM * DFE, DFE, n0, ws + WS_MGU + (size_t)je * SZ_MGU_E, DM, drow, kb * 64, S_W8I, scr, lane); continue; }
            r -= 1792;
            { const int kb = r >> 4, nb = r & 15; cvt_item8<false>(F.ka->in[I_MOE_D] + (size_t)je * DFE * DM, DM, nb * 64, ws + WS_MD + (size_t)je * SZ_MD_E, DFE, nb * 64, kb * 64, W8_DN, scr, lane); continue; }
        }
    }
    for (int rw = gw; rw < 4 * NMEM; rw += NGW) { const int l = rw >> 8, m = rw & 255;
        const f32x4* xr = (const f32x4*)(F.ka->in[I_MEM] + (size_t)m * DM) + lane; const f32x4* gr = (const f32x4*)(F.ka->in[I_NORM_MEM] + (size_t)l * DM) + lane;
        f32x4 v[4]; float s = 0.f;
#pragma unroll
        for (int j = 0; j < 4; ++j) { v[j] = xr[64 * j]; s += (v[j].x * v[j].x + v[j].y * v[j].y) + (v[j].z * v[j].z + v[j].w * v[j].w); }
        const float rstd = 1.0f / sqrtf(wave_sum(s, lane) * (1.f / DM) + EPS);
        u32x2* o8 = (u32x2*)((bf16*)(ws + WS_MEMN) + (size_t)rw * DM) + lane;
#pragma unroll
        for (int j = 0; j < 4; ++j) { const f32x4 g = gr[64 * j]; u32x2 w; w.x = cvt_pk_bf16(v[j].x * rstd * g.x, v[j].y * rstd * g.y); w.y = cvt_pk_bf16(v[j].z * rstd * g.z, v[j].w * rstd * g.w); o8[64 * j] = w; }
    }
}

DI void convert_moe_expert(Frame& F, int je0, int rank, int nranks, int nexp = 1) {
    LAS float* scr = (LAS float*)(F.lds + F.wave * 16640);
    const int lane = F.lane; unsigned char* ws = F.ws;
    for (int it = rank * 8 + F.wave; it < nexp * 3 * 896; it += nranks * 8) {
        const int je = je0 + it / (3 * 896); int r = it % (3 * 896);
        if (r < 1792) { const int up = r >= 896; if (up) r -= 896; const int kb = r / 56, nb = r % 56, n0 = nb * 64; const int drow = 256 * (n0 >> 7) + (n0 & 127) + (up ? 128 : 0);
            cvt_item8<true>(F.ka->in[up ? I_MOE_U : I_MOE_G] + (size_t)je * DM * DFE, DFE, n0, ws + WS_MGU + (size_t)je * SZ_MGU_E, DM, drow, kb * 64, S_W8I, scr, lane); continue; }
        r -= 1792;
        { const int kb = r >> 4, nb = r & 15; cvt_item8<false>(F.ka->in[I_MOE_D] + (size_t)je * DFE * DM, DM, nb * 64, ws + WS_MD + (size_t)je * SZ_MD_E, DFE, nb * 64, kb * 64, W8_DN, scr, lane); }
    }
}

DI void reduce8(float (&d)[8], int lane) {
    float r4[4], r2[2], p;
    { const bool hi = lane & 32;
#pragma unroll
      for (int i = 0; i < 4; ++i) { const float send = hi ? d[i] : d[i + 4], keep = hi ? d[i + 4] : d[i]; r4[i] = keep + shx(send, 32, lane); } }
    { const bool hi = lane & 16;
#pragma unroll
      for (int i = 0; i < 2; ++i) { const float send = hi ? r4[i] : r4[i + 2], keep = hi ? r4[i + 2] : r4[i]; r2[i] = keep + shx(send, 16, lane); } }
    { const bool hi = lane & 8; const float send = hi ? r2[0] : r2[1], keep = hi ? r2[1] : r2[0]; p = keep + shx(send, 8, lane); }
    p += shx(p, 4, lane); p += shx(p, 2, lane); p += shx(p, 1, lane);
#pragma unroll
    for (int i = 0; i < 8; ++i) d[i] = shidx(p, ((i >> 2) & 1) * 32 + ((i >> 1) & 1) * 16 + (i & 1) * 8, lane);
}
template <bool ADD_YS, bool WRITE_X, int DOTS, bool FINAL, int U8 = 0  , bool XINB = true  >
DI void norm_phase(Frame& F, const void* xin, bf16* xout, const float* gain, bf16* U, float* outF, const float* wsm, int wld, int moe_j) {
    constexpr int RB = DOTS ? (XINB ? 4 : 1) : (ADD_YS ? 2 : 4);
    const int lane = F.lane;
    f32x4 g[4];
#pragma unroll
    for (int j = 0; j < 4; ++j) g[j] = *((const f32x4*)gain + 64 * j + lane);
    float wreg[DOTS ? 16 : 1][8];
    if (DOTS) {
#pragma unroll
        for (int j = 0; j < 4; ++j)
#pragma unroll
            for (int e = 0; e < 4; ++e) { const float* p = wsm + (size_t)(256 * j + 4 * lane + e) * wld; const f32x4 a = *(const f32x4*)p, b = *(const f32x4*)(p + 4);
                wreg[j * 4 + e][0] = a.x; wreg[j * 4 + e][1] = a.y; wreg[j * 4 + e][2] = a.z; wreg[j * 4 + e][3] = a.w; wreg[j * 4 + e][4] = b.x; wreg[j * 4 + e][5] = b.y; wreg[j * 4 + e][6] = b.z; wreg[j * 4 + e][7] = b.w; }
    }
    const bf16* ys = (const bf16*)(F.ws + WS_YS);
    LAS int* sel_e = (LAS int*)(F.lds); LAS int* sel_lp = sel_e + 128; LAS float* sel_g = (LAS float*)(sel_lp + 128);
    for (int rb = F.vcu; rb < SEQ / 64; rb += F.G) {
        LAS unsigned* rowl = (LAS unsigned*)(F.lds + 4096) + F.wave * 2048;
        if (DOTS == 2) { if (F.tid < 8) F.lc[LC_LC + F.tid] = 0u; __syncthreads(); }
        for (int i0 = 0; i0 < 8; i0 += RB) {
            f32x4 v[RB][4]; u32x2 xraw[XINB ? RB : 1][4]; u32x2 y0[ADD_YS ? RB : 1][4], y1[ADD_YS ? RB : 1][4];
#pragma unroll
            for (int r = 0; r < RB; ++r) { const int row = rb * 64 + F.wave * 8 + i0 + r;
#pragma unroll
                for (int j = 0; j < 4; ++j) {
                    if (XINB) xraw[r][j] = *((const u32x2*)((const bf16*)xin + (size_t)row * DM) + 64 * j + lane);
                    else v[r][j] = *((const f32x4*)((const float*)xin + (size_t)row * DM) + 64 * j + lane);
                    if (ADD_YS) { y0[r][j] = *((const u32x2*)(ys + (size_t)row * DM) + 64 * j + lane); y1[r][j] = *((const u32x2*)(ys + (size_t)(SEQ + row) * DM) + 64 * j + lane); } } }
#pragma unroll
            for (int r = 0; r < RB; ++r) {
                const int rl = F.wave * 8 + i0 + r, row = rb * 64 + rl;
                float ss = 0.f;
#pragma unroll
                for (int j = 0; j < 4; ++j) {
                    if (XINB) { const u32x2 xr = xraw[r][j]; v[r][j] = (f32x4){bflo(xr.x), bfhi(xr.x), bflo(xr.y), bfhi(xr.y)}; }
                    if (ADD_YS) { v[r][j].x += bflo(y0[r][j].x) + bflo(y1[r][j].x); v[r][j].y += bfhi(y0[r][j].x) + bfhi(y1[r][j].x); v[r][j].z += bflo(y0[r][j].y) + bflo(y1[r][j].y); v[r][j].w += bfhi(y0[r][j].y) + bfhi(y1[r][j].y); }
                    if (WRITE_X) { u32x2 xw; xw.x = cvt_pk_bf16(v[r][j].x, v[r][j].y); xw.y = cvt_pk_bf16(v[r][j].z, v[r][j].w); *((u32x2*)(xout + (size_t)row * DM) + 64 * j + lane) = xw;
                        v[r][j] = (f32x4){bflo(xw.x), bfhi(xw.x), bflo(xw.y), bfhi(xw.y)}; }
                    ss += (v[r][j].x * v[r][j].x + v[r][j].y * v[r][j].y) + (v[r][j].z * v[r][j].z + v[r][j].w * v[r][j].w); }
                const float rstd = 1.0f / sqrtf(wave_sum(ss, lane) * (1.f / DM) + EPS);
#pragma unroll
                for (int j = 0; j < 4; ++j) { v[r][j] = v[r][j] * g[j];
                    if (FINAL) *((f32x4*)(outF + (size_t)row * DM) + 64 * j + lane) = v[r][j] * rstd;
                    else if (DOTS == 2) rowl[(i0 + r) * 256 + 64 * j + lane] = pk4_i8(v[r][j].x * (rstd * S_U8), v[r][j].y * (rstd * S_U8), v[r][j].z * (rstd * S_U8), v[r][j].w * (rstd * S_U8));
                    else if (U8 == 1) *((unsigned*)((unsigned char*)U + (size_t)row * DM) + 64 * j + lane) = pk4_i8(v[r][j].x * (rstd * S_U8), v[r][j].y * (rstd * S_U8), v[r][j].z * (rstd * S_U8), v[r][j].w * (rstd * S_U8));
                    else { if (U8 == 2) *((unsigned*)(F.ws + WS_U8 + (size_t)row * DM) + 64 * j + lane) = pk4_i8(v[r][j].x * (rstd * S_U8), v[r][j].y * (rstd * S_U8), v[r][j].z * (rstd * S_U8), v[r][j].w * (rstd * S_U8)); u32x2 w; w.x = cvt_pk_bf16(v[r][j].x * rstd, v[r][j].y * rstd); w.y = cvt_pk_bf16(v[r][j].z * rstd, v[r][j].w * rstd); *((u32x2*)(U + (size_t)row * DM) + 64 * j + lane) = w; } }
                if (DOTS == 2) {
                    float d[8];
#pragma unroll
                    for (int c = 0; c < 8; ++c) d[c] = 0.f;
#pragma unroll
                    for (int j = 0; j < 4; ++j)
#pragma unroll
                        for (int c = 0; c < 8; ++c) d[c] += v[r][j].x * wreg[j * 4 + 0][c] + v[r][j].y * wreg[j * 4 + 1][c] + v[r][j].z * wreg[j * 4 + 2][c] + v[r][j].w * wreg[j * 4 + 3][c];
                    reduce8(d, lane);
                    int e0 = 0; float l0 = d[0];
#pragma unroll
                    for (int c = 1; c < 8; ++c) if (d[c] > l0) { l0 = d[c]; e0 = c; }
                    int e1 = -1; float l1 = -3.0e38f;
#pragma unroll
                    for (int c = 0; c < 8; ++c) if (c != e0 && d[c] > l1) { l1 = d[c]; e1 = c; }
                    const float g0 = 1.0f / (1.0f + __expf((l1 - l0) * rstd)), g1 = 1.0f - g0;
                    if (lane < 2) { const int e = lane ? e1 : e0;
                        const unsigned lp = __hip_atomic_fetch_add((LAS unsigned*)&F.lc[LC_LC + e], 1u, __ATOMIC_RELAXED, __HIP_MEMORY_SCOPE_WORKGROUP);
                        sel_e[rl * 2 + lane] = e; sel_lp[rl * 2 + lane] = (int)lp; sel_g[rl * 2 + lane] = lane ? g1 : g0; }
                }
            }
        }
        if (DOTS == 2) {
            __syncthreads();
            if (F.tid < 8) { const unsigned n = F.lc[LC_LC + F.tid]; F.lc[LC_BASE + F.tid] = xb_add(F.ctl + CW_MOE + (moe_j * 8 + F.tid) * 64, n); }
            __syncthreads();
            if (F.tid < 128) { const int e = sel_e[F.tid], pos = (int)F.lc[LC_BASE + e] + sel_lp[F.tid];
                ((int*)(F.ws + WS_TOKE))[e * SEQ + pos] = (rb * 64 + (F.tid >> 1)) | ((F.tid & 1) << 20);
                ((float*)(F.ws + WS_GATEE))[e * SEQ + pos] = sel_g[F.tid]; }
            unsigned char* u8s = F.ws + WS_U8S;
#pragma unroll
            for (int i = 0; i < 8; ++i)
#pragma unroll
                for (int sl = 0; sl < 2; ++sl) { const int si = (F.wave * 8 + i) * 2 + sl; const int e = sel_e[si], pos = (int)F.lc[LC_BASE + e] + sel_lp[si];
                    unsigned* dst = (unsigned*)(u8s + ((size_t)e * SEQ + pos) * DM) + lane;
#pragma unroll
                    for (int j = 0; j < 4; ++j) dst[64 * j] = rowl[i * 256 + 64 * j + lane]; }
            __syncthreads();
        }
    }
}

DI bf16x8 ld_bf16x8(const bf16* p) { return __builtin_bit_cast(bf16x8, *(const u32x4*)p); }
DI bf16x8 pack_p(const f32x4& a, const f32x4& b) { u32x4 w; w.x = cvt_pk_bf16(a[0], a[1]); w.y = cvt_pk_bf16(a[2], a[3]); w.z = cvt_pk_bf16(b[0], b[1]); w.w = cvt_pk_bf16(b[2], b[3]); return __builtin_bit_cast(bf16x8, w); }
DI bf16x8 lds_frag_perm(ldsp rowp, int koff_bytes) {
    const u32x2 lo = *(const LAS u32x2*)(rowp + koff_bytes), hi = *(const LAS u32x2*)(rowp + koff_bytes + 32);
    u32x4 w; w.x = lo.x; w.y = lo.y; w.z = hi.x; w.w = hi.y; return __builtin_bit_cast(bf16x8, w);
}

typedef short s16x4 __attribute__((ext_vector_type(4)));
DI bf16x8 lds_frag_tr(ldsp lo, ldsp hi) {
    const s16x4 a = __builtin_amdgcn_ds_read_tr16_b64_v4i16((LAS s16x4*)lo), b = __builtin_amdgcn_ds_read_tr16_b64_v4i16((LAS s16x4*)hi);
    return __builtin_shufflevector(a, b, 0, 1, 2, 3, 4, 5, 6, 7);
}
DI void memattn_phase(Frame& F, int l) {
    ldsp Ks = F.lds, Vt = F.lds + 69632;
    const bf16* xq = (const bf16*)(F.ws + WS_XQ); bf16* hx_out = (bf16*)(F.ws + WS_HCAT) + 768;
    const int tid = F.tid, lane = F.lane, fr = lane & 15, fq = lane >> 4;
    for (int unit = F.vcu; unit < 256; unit += F.G) {
        const int hx = unit >> 6, rb = unit & 63;
        const bf16* km = (const bf16*)(F.ws + WS_KM) + (size_t)l * 256 * 512 + hx * 128;
        const bf16* vt = (const bf16*)(F.ws + WS_VMT) + (size_t)l * 512 * 256 + (size_t)hx * 128 * 256;
#pragma unroll
        for (int it = 0; it < 8; ++it) { const int i = tid + it * 512, r = i >> 4, c8 = i & 15; *(LAS u32x4*)(Ks + r * 272 + c8 * 16) = *(const u32x4*)(km + (size_t)r * 512 + c8 * 8); }
#pragma unroll
        for (int it = 0; it < 8; ++it) { const int i = tid + it * 512, r = i >> 5, c8 = i & 31; *(LAS u32x4*)(Vt + r * 528 + c8 * 16) = *(const u32x4*)(vt + (size_t)r * 256 + c8 * 8); }
        __syncthreads();
        for (int pass = 0; pass < 2; ++pass) {
            const int row = rb * 256 + F.wave * 32 + pass * 16 + fr;
            bf16x8 q[4];
#pragma unroll
            for (int ks = 0; ks < 4; ++ks) q[ks] = ld_bf16x8(xq + ((size_t)hx * SEQ + row) * 128 + ks * 32 + fq * 8);
            f32x4 s[16];
#pragma unroll
            for (int t = 0; t < 16; ++t) { s[t] = (f32x4){0.f, 0.f, 0.f, 0.f};
#pragma unroll
                for (int ks = 0; ks < 4; ++ks) s[t] = MFMA16(*(const LAS bf16x8*)(Ks + (16 * t + fr) * 272 + (ks * 32 + fq * 8) * 2), q[ks], s[t]); }
            float mx = -3.0e38f;
#pragma unroll
            for (int t = 0; t < 16; ++t) mx = fmaxf(mx, fmaxf(fmaxf(s[t][0], s[t][1]), fmaxf(s[t][2], s[t][3])));
            mx = fmaxf(mx, shx(mx, 16, lane)); mx = fmaxf(mx, shx(mx, 32, lane));
            float sum = 0.f;
#pragma unroll
            for (int t = 0; t < 16; ++t)
#pragma unroll
                for (int r = 0; r < 4; ++r) { s[t][r] = fexp(s[t][r] - mx); sum += s[t][r]; }
            sum += shx(sum, 16, lane); sum += shx(sum, 32, lane);
            f32x4 o[8];
#pragma unroll
            for (int tv = 0; tv < 8; ++tv) o[tv] = (f32x4){0.f, 0.f, 0.f, 0.f};
#pragma unroll
            for (int k2 = 0; k2 < 8; ++k2) { const bf16x8 pf = pack_p(s[2 * k2], s[2 * k2 + 1]);
#pragma unroll
                for (int tv = 0; tv < 8; ++tv) o[tv] = MFMA16(lds_frag_perm(Vt + (16 * tv + fr) * 528, (32 * k2 + 4 * fq) * 2), pf, o[tv]); }
            const float inv = 1.0f / sum;
#pragma unroll
            for (int tv = 0; tv < 8; ++tv) { u32x2 w; w.x = cvt_pk_bf16(o[tv][0] * inv, o[tv][1] * inv); w.y = cvt_pk_bf16(o[tv][2] * inv, o[tv][3] * inv);
                *(u32x2*)(hx_out + (size_t)row * HCW + hx * 128 + 16 * tv + 4 * fq) = w; }
        }
        __syncthreads();
    }
}

#define DIL_DECODE(ud_, g_, r_, s0_, gh_, sh_) const int g_ = (ud_) >> 9, rem_##g_ = (ud_) & 511, sh_ = 2 * g_, nbs_##g_ = 7 - sh_, blk_##g_ = rem_##g_ & 127, \
        r_ = blk_##g_ >> nbs_##g_, s0_ = (blk_##g_ & ((1 << nbs_##g_) - 1)) * 128, gh_ = g_ * 4 + (rem_##g_ >> 7)
#define DIL_ISSUE(ud_) do { DIL_DECODE(ud_, gN, rN, s0N, ghN, shN); const size_t pb = (size_t)rN << (14 - shN); \
        _Pragma("unroll") for (int it = 0; it < 4; ++it) { const int i = tid + it * 512, jl = i >> 3, c8 = i & 7, sp = s0N - 128 + jl; kreg[it] = (u32x4){0u, 0u, 0u, 0u}; vreg[it] = (u32x4){0u, 0u, 0u, 0u}; \
            if (sp >= 0) { kreg[it] = *(const u32x4*)(dq + ((size_t)(12 + ghN) * SEQ + pb + sp) * 64 + c8 * 8); vreg[it] = *(const u32x4*)(dq + ((size_t)(24 + ghN) * SEQ + pb + sp) * 64 + c8 * 8); } } \
        { const bf16* qp = dq + ((size_t)ghN * SEQ + pb + s0N + 16 * w + fr) * 64 + fq * 8; qreg[0] = *(const u32x4*)qp; qreg[1] = *(const u32x4*)(qp + 32); } } while (0)
DI void dilated_phase(Frame& F) {
    ldsp Kd = F.lds, Vd = F.lds + 36864;
    const bf16* dq = (const bf16*)(F.ws + WS_DQ); bf16* od = (bf16*)(F.ws + WS_OD); float* lse = (float*)(F.ws + WS_LSE);
    const int tid = F.tid, lane = F.lane, fr = lane & 15, fq = lane >> 4, w = F.wave;
    for (int i = tid; i < 24 * 36; i += 512) *(LAS unsigned*)(Vd + 256 * 144 + i * 4) = 0u;
    u32x4 kreg[4], vreg[4], qreg[2];
    int ud = F.vcu;
    if (ud < 1536) DIL_ISSUE(ud);
    for (; ud < 1536; ud += F.G) {
        DIL_DECODE(ud, g, r, s0, gh, sh);
#pragma unroll
        for (int it = 0; it < 4; ++it) { const int i = tid + it * 512, jl = i >> 3, c8 = i & 7; *(LAS u32x4*)(Kd + jl * 144 + c8 * 16) = kreg[it]; *(LAS u32x4*)(Vd + jl * 144 + c8 * 16) = vreg[it]; }
        bf16x8 q[2]; q[0] = __builtin_bit_cast(bf16x8, qreg[0]); q[1] = __builtin_bit_cast(bf16x8, qreg[1]);
        __syncthreads();
        { const int un = ud + F.G; if (un < 1536) DIL_ISSUE(un); }
        {
            const int qs = s0 + 16 * w + fr; const size_t qtok = (size_t)((qs << sh) + r);
            f32x4 s[10];
#pragma unroll
            for (int t = 0; t < 9; ++t) { s[t] = (f32x4){0.f, 0.f, 0.f, 0.f};
#pragma unroll
                for (int ks = 0; ks < 2; ++ks) s[t] = MFMA16(*(const LAS bf16x8*)(Kd + (16 * w + 16 * t + fr) * 144 + (ks * 32 + fq * 8) * 2), q[ks], s[t]); }
            s[9] = (f32x4){0.f, 0.f, 0.f, 0.f};
            float mx = -3.0e38f;
#pragma unroll
            for (int t = 0; t < 9; ++t)
#pragma unroll
                for (int rg = 0; rg < 4; ++rg) { const int jj = 16 * t + 4 * fq + rg; const bool ok = (jj >= fr) && (jj <= 128 + fr) && (s0 - 128 + 16 * w + jj >= 0);
                    s[t][rg] = ok ? s[t][rg] : -1.0e30f; mx = fmaxf(mx, s[t][rg]); }
            mx = fmaxf(mx, shx(mx, 16, lane)); mx = fmaxf(mx, shx(mx, 32, lane));
            float sum = 0.f;
#pragma unroll
            for (int t = 0; t < 9; ++t)
#pragma unroll
                for (int rg = 0; rg < 4; ++rg) { s[t][rg] = fexp(s[t][rg] - mx); sum += s[t][rg]; }
            sum += shx(sum, 16, lane); sum += shx(sum, 32, lane);
            f32x4 o[4];
#pragma unroll
            for (int tv = 0; tv < 4; ++tv) o[tv] = (f32x4){0.f, 0.f, 0.f, 0.f};
#pragma unroll
            for (int k2 = 0; k2 < 5; ++k2) { const bf16x8 pf = pack_p(s[2 * k2], s[2 * k2 + 1]);
#pragma unroll
                for (int tv = 0; tv < 4; ++tv) { ldsp lo = Vd + (16 * w + 32 * k2 + 4 * fq + (fr >> 2)) * 144 + (16 * tv + 4 * (fr & 3)) * 2; o[tv] = MFMA16(lds_frag_tr(lo, lo + 16 * 144), pf, o[tv]); } }
            const float inv = 1.0f / sum;
#pragma unroll
            for (int tv = 0; tv < 4; ++tv) { u32x2 ww; ww.x = cvt_pk_bf16(o[tv][0] * inv, o[tv][1] * inv); ww.y = cvt_pk_bf16(o[tv][2] * inv, o[tv][3] * inv);
                *(u32x2*)(od + qtok * 768 + gh * 64 + 16 * tv + 4 * fq) = ww; }
            if (fq == 0) lse[qtok * 12 + gh] = mx + __logf(sum);
        }
        __syncthreads();
    }
}

DI void gate_scan(const float* ifg, int t0, int h, int lane, float& a0, float& a1, float& cum0, float& cum1, float& total, float& maxa) {
    const float* p0 = ifg + (size_t)(t0 + 2 * lane) * 8; const float i0 = p0[h], lf0 = p0[4 + h], i1 = p0[8 + h], lf1 = p0[12 + h];
    const float s = lf0 + lf1; float incl = s;
#pragma unroll
    for (int off = 1; off < 64; off <<= 1) { const float t = shup(incl, off, lane); if (lane >= off) incl += t; }
    const float excl = incl - s; cum0 = excl + lf0; cum1 = incl; a0 = i0 - cum0; a1 = i1 - cum1;
    total = shidx(incl, 63, lane); maxa = wave_max(fmaxf(a0, a1), lane);
}
DI void mlstm_delta_phase(Frame& F, int l) {
    ldsp Kimg = F.lds, Vimg = F.lds + 34816; LAS float* w_s = (LAS float*)(F.lds + 69632);
    const bf16* mq = (const bf16*)(F.ws + WS_MQ); bf16* qkc = (bf16*)(F.ws + WS_QKC); const float* ifg = (const float*)(F.ws + WS_IFG);
    const float* convw = F.ka->in[I_CONV] + (size_t)l * 4 * 1024;
    const int tid = F.tid, lane = F.lane, fr = lane & 15, fq = lane >> 4, w = F.wave;
    for (int unit = F.vcu; unit < 512; unit += F.G) {
        const int c = unit >> 2, h = unit & 3, t0 = c * 128;
        const int cs = tid & 15, rg = tid >> 4, l0 = rg * 4;
        u32x4 xrr[2][7], vv[4];
#pragma unroll
        for (int which = 0; which < 2; ++which)
#pragma unroll
            for (int i = 0; i < 7; ++i) { const int row = t0 + l0 - 3 + i; xrr[which][i] = (u32x4){0u, 0u, 0u, 0u}; if (row >= 0) xrr[which][i] = *(const u32x4*)(mq + ((size_t)(which * 4 + h) * SEQ + row) * 128 + cs * 8); }
#pragma unroll
        for (int it = 0; it < 4; ++it) { const int i = tid + it * 512, lr = i >> 4, c8 = i & 15; vv[it] = *(const u32x4*)(mq + ((size_t)(8 + h) * SEQ + t0 + lr) * 128 + c8 * 8); }
        f32x4 cwv[2][4][2];
#pragma unroll
        for (int which = 0; which < 2; ++which)
#pragma unroll
            for (int j = 0; j < 4; ++j) { const float* p = convw + j * 1024 + which * 512 + h * 128 + cs * 8; cwv[which][j][0] = *(const f32x4*)p; cwv[which][j][1] = *(const f32x4*)(p + 4); }
        if (w == 0) { float a0, a1, c0, c1, total, maxa; gate_scan(ifg, t0, h, lane, a0, a1, c0, c1, total, maxa);
            w_s[2 * lane] = fexp(a0 - maxa); w_s[2 * lane + 1] = fexp(a1 - maxa);
            if (lane == 0) { float* sm = (float*)(F.ws + WS_SUMM) + (c * 4 + h) * 2; sm[0] = total; sm[1] = maxa; } }
#pragma unroll
        for (int which = 0; which < 2; ++which) {
            float cw[4][8];
#pragma unroll
            for (int j = 0; j < 4; ++j) { const f32x4 a = cwv[which][j][0], b = cwv[which][j][1];
                cw[j][0] = a.x; cw[j][1] = a.y; cw[j][2] = a.z; cw[j][3] = a.w; cw[j][4] = b.x; cw[j][5] = b.y; cw[j][6] = b.z; cw[j][7] = b.w; }
            const u32x4 (&xr)[7] = xrr[which];
#pragma unroll
            for (int o = 0; o < 4; ++o) { float acc[8];
#pragma unroll
                for (int e = 0; e < 8; ++e) acc[e] = 0.f;
#pragma unroll
                for (int j = 0; j < 4; ++j) { const u32x4 x = xr[o + j];
                    acc[0] += cw[j][0] * bflo(x.x); acc[1] += cw[j][1] * bfhi(x.x); acc[2] += cw[j][2] * bflo(x.y); acc[3] += cw[j][3] * bfhi(x.y);
                    acc[4] += cw[j][4] * bflo(x.z); acc[5] += cw[j][5] * bfhi(x.z); acc[6] += cw[j][6] * bflo(x.w); acc[7] += cw[j][7] * bfhi(x.w); }
#pragma unroll
                for (int e = 0; e < 8; ++e) { acc[e] = siluf_(acc[e]); if (which) acc[e] *= RS128; }
                u32x4 ww; ww.x = cvt_pk_bf16(acc[0], acc[1]); ww.y = cvt_pk_bf16(acc[2], acc[3]); ww.z = cvt_pk_bf16(acc[4], acc[5]); ww.w = cvt_pk_bf16(acc[6], acc[7]);
                *(u32x4*)(qkc + ((size_t)(which * 4 + h) * SEQ + t0 + l0 + o) * 128 + cs * 8) = ww;
                if (which) *(LAS u32x4*)(Kimg + (l0 + o) * 272 + cs * 16) = ww; } }
        __syncthreads();
#pragma unroll
        for (int it = 0; it < 4; ++it) { const int i = tid + it * 512, lr = i >> 4, c8 = i & 15; const u32x4 v = vv[it]; const float ww = w_s[lr];
            u32x4 p; p.x = cvt_pk_bf16(bflo(v.x) * ww, bfhi(v.x) * ww); p.y = cvt_pk_bf16(bflo(v.y) * ww, bfhi(v.y) * ww); p.z = cvt_pk_bf16(bflo(v.z) * ww, bfhi(v.z) * ww); p.w = cvt_pk_bf16(bflo(v.w) * ww, bfhi(v.w) * ww);
            *(LAS u32x4*)(Vimg + lr * 272 + c8 * 16) = p; }
        __syncthreads();
        { f32x4 acc[8];
#pragma unroll
          for (int t = 0; t < 8; ++t) acc[t] = (f32x4){0.f, 0.f, 0.f, 0.f};
#pragma unroll
          for (int ks = 0; ks < 4; ++ks) { const int rowb = (32 * ks + 8 * fq + (fr >> 2)) * 272 + 8 * (fr & 3);
            ldsp vb = Vimg + rowb + 32 * w; const bf16x8 bfrag = lds_frag_tr(vb, vb + 4 * 272);
#pragma unroll
            for (int t = 0; t < 8; ++t) { ldsp ka = Kimg + rowb + 32 * t; acc[t] = MFMA16(lds_frag_tr(ka, ka + 4 * 272), bfrag, acc[t]); } }
          bf16* dl = (bf16*)(F.ws + WS_DELTA) + ((size_t)(c * 4 + h) * 128 + 16 * w + fr) * 128 + 4 * fq;
#pragma unroll
          for (int t = 0; t < 8; ++t) { u32x2 dw; dw.x = cvt_pk_bf16(acc[t][0], acc[t][1]); dw.y = cvt_pk_bf16(acc[t][2], acc[t][3]); *(u32x2*)(dl + 16 * t) = dw; }
        }
        if (tid < 128) { float sacc = 0.f;
#pragma unroll 8
            for (int j = 0; j < 128; ++j) sacc += w_s[j] * bf2f(*(const LAS bf16*)(Kimg + j * 272 + tid * 2));
            ((float*)(F.ws + WS_ND))[(c * 4 + h) * 128 + tid] = sacc; }
        __syncthreads();
    }
}
DI void scan_phase(Frame& F) {
    LAS float* dec = (LAS float*)F.lds; LAS float* scl = dec + 512;
    const int tid = F.tid, lane = F.lane, w = F.wave;
    if (w < 4) { const int h = w; const float* sm = (const float*)(F.ws + WS_SUMM);
        const float tot0 = sm[((2 * lane) * 4 + h) * 2], mxa0 = sm[((2 * lane) * 4 + h) * 2 + 1], tot1 = sm[((2 * lane + 1) * 4 + h) * 2], mxa1 = sm[((2 * lane + 1) * 4 + h) * 2 + 1];
        const float s = tot0 + tot1; float incl = s;
#pragma unroll
        for (int off = 1; off < 64; off <<= 1) { const float t = shup(incl, off, lane); if (lane >= off) incl += t; }
        const float excl = incl - s, T0 = excl + tot0, T1 = incl;
        const float b0 = mxa0 - excl, b1 = mxa1 - T0; float inclm = fmaxf(b0, b1);
#pragma unroll
        for (int off = 1; off < 64; off <<= 1) { const float t = shup(inclm, off, lane); if (lane >= off) inclm = fmaxf(inclm, t); }
        float exclm = shup(inclm, 1, lane); if (lane == 0) exclm = -1.0e30f;
        const float m0 = T0 + fmaxf(exclm, b0), m1 = T1 + inclm;
        float mprev = shup(m1, 1, lane); if (lane == 0) mprev = -1.0e30f;
        const float A0 = fmaxf(mprev, mxa0), A1 = fmaxf(m0, mxa1);
        dec[h * 128 + 2 * lane] = fexp(mprev - A0); scl[h * 128 + 2 * lane] = fexp(mxa0 - A0);
        dec[h * 128 + 2 * lane + 1] = fexp(m0 - A1); scl[h * 128 + 2 * lane + 1] = fexp(mxa1 - A1);
        if (F.vcu == 0) { float* mst = (float*)(F.ws + WS_MST); mst[(2 * lane) * 4 + h] = mprev; mst[(2 * lane + 1) * 4 + h] = m0; }
    }
    __syncthreads();
    if (w < 4) {
        const bf16* delta = (const bf16*)(F.ws + WS_DELTA); bf16* cst = (bf16*)(F.ws + WS_CST);
        const float* nd = (const float*)(F.ws + WS_ND); float* nst = (float*)(F.ws + WS_NST);
        for (int e = F.vcu * 256 + tid; e < 65536 + 512; e += F.G * 256) {
            if (e < 65536) { const int h = e >> 14, vd = e & 16383; float C = 0.f;
                for (int c0 = 0; c0 < 128; c0 += 32) { float dv[32];
#pragma unroll
                    for (int j = 0; j < 32; ++j) dv[j] = bf2f(delta[(size_t)((c0 + j) * 4 + h) * 16384 + vd]);
#pragma unroll
                    for (int j = 0; j < 32; ++j) { const float Cin = C; C = dec[h * 128 + c0 + j] * C + scl[h * 128 + c0 + j] * dv[j]; dv[j] = Cin; }
#pragma unroll
                    for (int j = 0; j < 32; ++j) cst[(size_t)((c0 + j) * 4 + h) * 16384 + vd] = (bf16)(cvt_pk_bf16(dv[j], 0.f) & 0xffff); }
            } else { const int idx = e - 65536, h = idx >> 7, d = idx & 127; float n = 0.f;
                for (int c0 = 0; c0 < 128; c0 += 32) { float dv[32];
#pragma unroll
                    for (int j = 0; j < 32; ++j) dv[j] = nd[((c0 + j) * 4 + h) * 128 + d];
#pragma unroll
                    for (int j = 0; j < 32; ++j) { const float nin = n; n = dec[h * 128 + c0 + j] * n + scl[h * 128 + c0 + j] * dv[j]; dv[j] = nin; }
#pragma unroll
                    for (int j = 0; j < 32; ++j) nst[((c0 + j) * 4 + h) * 128 + d] = dv[j]; } }
        }
    } else {
        const bf16* od = (const bf16*)(F.ws + WS_OD); const float* lse = (const float*)(F.ws + WS_LSE); bf16* hd = (bf16*)(F.ws + WS_HCAT) + 512;
        const int hh = lane >> 4, dv4 = (lane & 15) * 4;
        for (int tok = F.vcu * 4 + (w - 4); tok < SEQ; tok += F.G * 4) {
            const float l0 = lse[(size_t)tok * 12 + hh], l1 = lse[(size_t)tok * 12 + 4 + hh], l2 = lse[(size_t)tok * 12 + 8 + hh];
            const float mx = fmaxf(l0, fmaxf(l1, l2)); float w0 = fexp(l0 - mx), w1 = fexp(l1 - mx), w2 = fexp(l2 - mx); const float inv = 1.0f / (w0 + w1 + w2); w0 *= inv; w1 *= inv; w2 *= inv;
            const u32x2 o0 = *(const u32x2*)(od + (size_t)tok * 768 + hh * 64 + dv4), o1 = *(const u32x2*)(od + (size_t)tok * 768 + 256 + hh * 64 + dv4), o2 = *(const u32x2*)(od + (size_t)tok * 768 + 512 + hh * 64 + dv4);
            u32x2 r; r.x = cvt_pk_bf16(w0 * bflo(o0.x) + w1 * bflo(o1.x) + w2 * bflo(o2.x), w0 * bfhi(o0.x) + w1 * bfhi(o1.x) + w2 * bfhi(o2.x));
            r.y = cvt_pk_bf16(w0 * bflo(o0.y) + w1 * bflo(o1.y) + w2 * bflo(o2.y), w0 * bfhi(o0.y) + w1 * bfhi(o1.y) + w2 * bfhi(o2.y));
            *(u32x2*)(hd + (size_t)tok * HCW + hh * 64 + dv4) = r;
        }
    }
    __syncthreads();
}
DI void mlstm_out_phase(Frame& F, int l) {
    ldsp Ks = F.lds, Vimg = F.lds + 34816, Cs = F.lds + 73728;
    LAS float* a_s = (LAS float*)(F.lds + 113152); LAS float* A_s = a_s + 128; LAS float* wi_s = A_s + 128; LAS float* emr_s = wi_s + 128;
    const bf16* mq = (const bf16*)(F.ws + WS_MQ); const bf16* qkc = (const bf16*)(F.ws + WS_QKC); const float* ifg = (const float*)(F.ws + WS_IFG);
    const bf16* cst = (const bf16*)(F.ws + WS_CST); const float* nst = (const float*)(F.ws + WS_NST); bf16* hm = (bf16*)(F.ws + WS_HCAT);
    const float* gain = F.ka->in[I_MLSTM_NORM] + (size_t)l * 512;
    const int tid = F.tid, lane = F.lane, fr = lane & 15, fq = lane >> 4, w = F.wave;
    for (int unit = F.vcu; unit < 512; unit += F.G) {
        const int c = unit >> 2, h = unit & 3, t0 = c * 128;
        u32x4 kst[4], vst[4], cstr[4]; float nval = 0.f;
#pragma unroll
        for (int it = 0; it < 4; ++it) { const int i = tid + it * 512, j = i >> 4, c8 = i & 15;
            kst[it] = *(const u32x4*)(qkc + ((size_t)(4 + h) * SEQ + t0 + j) * 128 + c8 * 8);
            vst[it] = *(const u32x4*)(mq + ((size_t)(8 + h) * SEQ + t0 + j) * 128 + c8 * 8);
            cstr[it] = *(const u32x4*)(cst + ((size_t)(c * 4 + h) * 128 + j) * 128 + c8 * 8); }
        if (tid < 128) nval = nst[(c * 4 + h) * 128 + tid];
        const int lrow = 16 * w + fr; const size_t trow = (size_t)(t0 + lrow);
        bf16x8 q[4];
#pragma unroll
        for (int ks = 0; ks < 4; ++ks) q[ks] = ld_bf16x8(qkc + ((size_t)h * SEQ + trow) * 128 + ks * 32 + fq * 8);
        u32x2 ogv[8]; f32x4 gnv[8];
#pragma unroll
        for (int tv = 0; tv < 8; ++tv) { ogv[tv] = *(const u32x2*)(mq + ((size_t)(12 + h) * SEQ + trow) * 128 + 16 * tv + 4 * fq); gnv[tv] = *(const f32x4*)(gain + h * 128 + 16 * tv + 4 * fq); }
        if (w == 0) { float a0, a1, c0, c1, total, maxa; gate_scan(ifg, t0, h, lane, a0, a1, c0, c1, total, maxa);
            const float m_in = ((const float*)(F.ws + WS_MST))[c * 4 + h];
            float inclm = fmaxf(a0, a1);
#pragma unroll
            for (int off = 1; off < 64; off <<= 1) { const float t = shup(inclm, off, lane); if (lane >= off) inclm = fmaxf(inclm, t); }
            float exclm = shup(inclm, 1, lane); if (lane == 0) exclm = -3.0e38f;
            const float A0 = fmaxf(fmaxf(exclm, a0), m_in), A1 = fmaxf(inclm, m_in);
            a_s[2 * lane] = a0; a_s[2 * lane + 1] = a1; A_s[2 * lane] = A0; A_s[2 * lane + 1] = A1;
            wi_s[2 * lane] = fexp(m_in - A0); wi_s[2 * lane + 1] = fexp(m_in - A1);
            emr_s[2 * lane] = fexp(-(c0 + A0)); emr_s[2 * lane + 1] = fexp(-(c1 + A1)); }
#pragma unroll
        for (int it = 0; it < 4; ++it) { const int i = tid + it * 512, j = i >> 4, c8 = i & 15;
            *(LAS u32x4*)(Ks + j * 272 + c8 * 16) = kst[it]; *(LAS u32x4*)(Vimg + j * 304 + c8 * 16) = vst[it]; *(LAS u32x4*)(Cs + j * 272 + c8 * 16) = cstr[it]; }
        if (tid < 128) { unsigned z_ = 0u; asm volatile("" : "+v"(z_)); *(LAS u32x4*)(Vimg + tid * 304 + 256) = (u32x4){0x00003F80u + z_, z_, z_, z_}; *(LAS u32x4*)(Vimg + tid * 304 + 272) = (u32x4){z_, z_, z_, z_};
            *(LAS bf16*)(Cs + 128 * 272 + tid * 2) = (bf16)(cvt_pk_bf16(nval, 0.f) & 0xffff); }
        for (int i = tid; i < 15 * 64; i += 512) { const int rr = 129 + i / 64, ww = i % 64; *(LAS unsigned*)(Cs + rr * 272 + ww * 4) = 0u; }
        __syncthreads();
        {
            f32x4 s[8];
#pragma unroll
            for (int t = 0; t < 8; ++t) { s[t] = (f32x4){0.f, 0.f, 0.f, 0.f};
                if (t <= w) {
#pragma unroll
                    for (int ks = 0; ks < 4; ++ks) s[t] = MFMA16(*(const LAS bf16x8*)(Ks + (16 * t + fr) * 272 + (ks * 32 + fq * 8) * 2), q[ks], s[t]);
                    const f32x4 a4 = *(const LAS f32x4*)(a_s + 16 * t + 4 * fq); const float Al = A_s[lrow];
#pragma unroll
                    for (int rg = 0; rg < 4; ++rg) { const int j = 16 * t + 4 * fq + rg; s[t][rg] = (j <= lrow) ? s[t][rg] * fexp(a4[rg] - Al) : 0.f; } } }
            const float wi = wi_s[lrow];
            bf16x8 qs[4];
#pragma unroll
            for (int ks = 0; ks < 4; ++ks) { const u32x4 x = __builtin_bit_cast(u32x4, q[ks]); u32x4 y;
                y.x = cvt_pk_bf16(bflo(x.x) * wi, bfhi(x.x) * wi); y.y = cvt_pk_bf16(bflo(x.y) * wi, bfhi(x.y) * wi); y.z = cvt_pk_bf16(bflo(x.z) * wi, bfhi(x.z) * wi); y.w = cvt_pk_bf16(bflo(x.w) * wi, bfhi(x.w) * wi);
                qs[ks] = __builtin_bit_cast(bf16x8, y); }
            f32x4 o[9];
#pragma unroll
            for (int tv = 0; tv < 9; ++tv) { o[tv] = (f32x4){0.f, 0.f, 0.f, 0.f};
#pragma unroll
                for (int ks = 0; ks < 4; ++ks) o[tv] = MFMA16(*(const LAS bf16x8*)(Cs + (16 * tv + fr) * 272 + (ks * 32 + fq * 8) * 2), qs[ks], o[tv]); }
#pragma unroll
            for (int k2 = 0; k2 < 4; ++k2) if (2 * k2 <= w) { const bf16x8 pf = pack_p(s[2 * k2], s[2 * k2 + 1]);
#pragma unroll
                for (int tv = 0; tv < 9; ++tv) { ldsp lo = Vimg + (32 * k2 + 4 * fq + (fr >> 2)) * 304 + (16 * tv + 4 * (fr & 3)) * 2; o[tv] = MFMA16(lds_frag_tr(lo, lo + 16 * 304), pf, o[tv]); } }
            const float den = shidx(o[8][0], fr, lane);
            const float inv = 1.0f / fmaxf(fabsf(den), emr_s[lrow]);
            float sm = 0.f;
#pragma unroll
            for (int tv = 0; tv < 8; ++tv) { o[tv] = o[tv] * inv; sm += (o[tv][0] + o[tv][1]) + (o[tv][2] + o[tv][3]); }
            sm += shx(sm, 16, lane); sm += shx(sm, 32, lane);
            const float mu = sm * (1.f / 128.f); float vs = 0.f;
#pragma unroll
            for (int tv = 0; tv < 8; ++tv) { o[tv] = o[tv] - mu; vs += (o[tv][0] * o[tv][0] + o[tv][1] * o[tv][1]) + (o[tv][2] * o[tv][2] + o[tv][3] * o[tv][3]); }
            vs += shx(vs, 16, lane); vs += shx(vs, 32, lane);
            const float rstd = 1.0f / sqrtf(vs * (1.f / 128.f) + EPS);
#pragma unroll
            for (int tv = 0; tv < 8; ++tv) { const int col = h * 128 + 16 * tv + 4 * fq; const f32x4 gn = gnv[tv]; const u32x2 og = ogv[tv];
                const float r0 = o[tv][0] * rstd * gn.x * sigmoidf_(bflo(og.x)), r1 = o[tv][1] * rstd * gn.y * sigmoidf_(bfhi(og.x)), r2 = o[tv][2] * rstd * gn.z * sigmoidf_(bflo(og.y)), r3 = o[tv][3] * rstd * gn.w * sigmoidf_(bfhi(og.y));
                u32x2 ww; ww.x = cvt_pk_bf16(r0, r1); ww.y = cvt_pk_bf16(r2, r3); *(u32x2*)(hm + trow * HCW + col) = ww; }
        }
        __syncthreads();
    }
}

#define PH() refresh(F); unsigned char* const ws = F.ws; (void)ws
#define P_XRES ((bf16*)(ws + WS_XRES))
#define P_U ((bf16*)(ws + WS_U))
#define P_PROJ ((bf16*)(ws + WS_PROJ))
#define P_MERGED ((bf16*)(ws + WS_MERGED))
#ifndef PROBE_GROUP
#define PROBE_GROUP 0
#endif
#define PROBE_AMP 8
#define PB(g) unsigned long long pt0_ = 0; if (PROBE_GROUP == (g)) pt0_ = __builtin_amdgcn_s_memrealtime()
#define PE(g) do { if (PROBE_GROUP == (g)) F.pacc += __builtin_amdgcn_s_memrealtime() - pt0_; } while (0)
#define GRID_BAR() do { refresh(F); XcdBarrier bar_; bar_.bar = F.ctl + CW_BAR; bar_.x = xb_xcc_id(); bar_.st = F.lc + LC_BAR; xcd_barrier(bar_); } while (0)
template <int l> DI void layer_body(Frame& F) {
    const int G = F.G, cid = (int)blockIdx.x;
        if constexpr (l == 2) {
            PB(2); PH();
            norm_phase<true, true, 0, false, 1>(F, P_XRES, P_XRES, F.ka->in[I_NORM_MIX] + l * DM, (bf16*)(ws + WS_U8), nullptr, nullptr, 0, 0);
            GRID_BAR(); PE(2);
        }
        { PB(3);
        if constexpr (l < NBF) { PH(); pg8::SchedProj<2> S{(const char*)P_U, (const char*)(ws + WS_WINB + (size_t)l * 16 * MiB), G, cid, DM, DM};
          pg8::EpiProj E{(bf16*)(ws + WS_MQ), (bf16*)(ws + WS_DQ), (bf16*)(ws + WS_XQ), (bf16*)(ws + WS_GT), (float*)(ws + WS_IFG), F.ka->in[I_BIF] + l * 8, 1.0f, l == 1 ? (const u64*)(F.ctl + CW_RS) + 1 * SEQ : nullptr, 1.0f};
          pg8::gemm_phase<pg8::EpiProj, pg8::SchedProj<2>, true, 0, true>(F.lds, DM, DM, DM, S, E); }
        else { PH(); pg8::SchedProj<2> S{(const char*)(ws + WS_U8), (const char*)(ws + WS_WIN + (size_t)l * SZ_WIN), G, cid, DM / 2, DM / 2};
          pg8::EpiProj E{(bf16*)(ws + WS_MQ), (bf16*)(ws + WS_DQ), (bf16*)(ws + WS_XQ), (bf16*)(ws + WS_GT), (float*)(ws + WS_IFG), F.ka->in[I_BIF] + l * 8, 1.0f / (((l == 1 || l == 3) ? S_XB8 : S_U8) * S_W8I), (l == 1 || l == 3) ? (const u64*)(F.ctl + CW_RS) + l * SEQ : nullptr, 0.125f};
          pg8::gemm_phase<pg8::EpiProj, pg8::SchedProj<2>, true, 2, true>(F.lds, DM / 2, DM / 2, DM / 2, S, E); }
        if (l == 0) { PH(); pg8::SchedKV S{(const char*)(ws + WS_MEMN), (const char*)(ws + WS_WKV), G, cid, 192 % G};
          pg8::EpiKV E{(bf16*)(ws + WS_KM), (bf16*)(ws + WS_VMT)};
          pg8::gemm_phase<pg8::EpiKV, pg8::SchedKV, false>(F.lds, DM, DM, DM, S, E); }
        if (l == 0) { PH(); int cc = cid - 192 % G; if (cc < 0) cc += G; if (cc >= 16 || G <= 16) convert_moe_expert(F, 4, G > 16 ? cc - 16 : cid, G > 16 ? G - 16 : G, 2); }
        GRID_BAR(); PE(3); }
        { PB(4);
        { PB(13); PH(); memattn_phase(F, l); PE(13); }
        { PB(14); PH(); dilated_phase(F); PE(14); }
        { PB(15); PH(); mlstm_delta_phase(F, l); PE(15); }
        GRID_BAR(); PE(4); }
        { PB(5); PH(); scan_phase(F);
        GRID_BAR(); PE(5); }
        { PB(6); PH(); mlstm_out_phase(F, l);
        GRID_BAR(); PE(6); }
        { PB(7);
        { PH(); pg8::SchedDense S{(const char*)(ws + WS_HCAT), (const char*)(ws + WS_WBRM + (size_t)l * DM * HCW * 2), SEQ / 256, 4, G, cid, HCW, HCW};
          pg8::EpiBranchFused E{P_MERGED, (const unsigned char*)(ws + WS_GT)};
          pg8::gemm_phase<pg8::EpiBranchFused, pg8::SchedDense, false>(F.lds, HCW, HCW, HCW, S, E); }
        GRID_BAR(); PE(7); }
        { PB(8);
        { PH(); pg8::SchedDense S{(const char*)P_MERGED, (const char*)(ws + WS_WOUT + (size_t)l * DM * DM * 2), SEQ / 256, 4, G, cid, DM, DM};
          constexpr int XBM = (l & 1) ? 0 : (((D8_MASK >> (l >> 1)) & 1) ? 2 : 1);
          pg8::EpiRes<XBM, l == 0> E{(l == 0) ? (const void*)F.ka->in[I_X] : (const void*)P_XRES, P_XRES, 1.0f, F.ka->in[I_NORM_FFN] + l * DM, XBM == 2 ? (unsigned char*)(ws + WS_U8) : (unsigned char*)P_U, (u64*)(F.ctl + CW_RS) + l * SEQ};
          pg8::gemm_phase<pg8::EpiRes<XBM, l == 0>, pg8::SchedDense, false>(F.lds, DM, DM, DM, S, E); }
        GRID_BAR(); PE(8); }
        const int j = l >> 1;
        if (l & 1) {
            { PB(2); PH(); norm_phase<false, false, 2, false, 1>(F, P_XRES, nullptr, F.ka->in[I_NORM_FFN] + l * DM, P_U, nullptr, F.ka->in[I_ROUTER] + (size_t)j * DM * 8, 8, j);
            GRID_BAR(); PE(2); }
            { PB(11); PH();
              if (F.tid < 8) F.lc[LC_CNT + F.tid] = xb_ld(F.ctl + CW_MOE + (j * 8 + F.tid) * 64);
              __syncthreads();
              if (F.tid == 0) { unsigned t = 0;
                  for (int e = 0; e < 8; ++e) { F.lc[LC_TB + e] = t; t += (F.lc[LC_CNT + e] + 255u) >> 8; }
                  F.lc[LC_TB + 8] = t; }
              __syncthreads();
              pg8::SchedMoe<true> S{(const char*)(ws + WS_U8S), (const char*)(ws + WS_MGU + (size_t)j * 8 * SZ_MGU_E), SZ_MGU_E, F.lc, 2 * DFE / 256, G, cid, DM / 2, DM / 2};
              pg8::EpiSwiglu<true> E{(unsigned char*)P_PROJ, DFE, (const float*)(ws + WS_GATEE), F.lc, 1.0f / (S_U8 * S_W8I), nullptr};
              pg8::gemm_phase<pg8::EpiSwiglu<true>, pg8::SchedMoe<true>, true, 2>(F.lds, DM / 2, DM / 2, DM / 2, S, E);
              if (l == 1) { PH(); const int nun = __builtin_amdgcn_readfirstlane((int)F.lc[LC_TB + 8]) * (2 * DFE / 256), rem = nun % G; if (cid >= rem) convert_moe_expert(F, 11, cid - rem, G - rem); }
            GRID_BAR(); PE(11); }
            { PB(12); PH(); pg8::SchedMoe<false> S{(const char*)P_PROJ, (const char*)(ws + WS_MD + (size_t)j * 8 * SZ_MD_E), SZ_MD_E, F.lc, 4, G, cid, DFE / 2, DFE / 2};
              pg8::EpiMoeDown E{(bf16*)(ws + WS_YS), (const int*)(ws + WS_TOKE), F.lc, 1.0f / W8_DN};
              pg8::gemm_phase<pg8::EpiMoeDown, pg8::SchedMoe<false>, true, 1>(F.lds, DFE / 2, DFE / 2, DFE / 2, S, E);
              if (l == 1) { PH(); const int nun = __builtin_amdgcn_readfirstlane((int)F.lc[LC_TB + 8]) * 4, rem = nun % G; if (cid >= rem) convert_moe_expert(F, 13, cid - rem, G - rem, 3); }
            GRID_BAR(); PE(12); }
        } else {
            { PB(9); PH();
              if constexpr ((D8_MASK >> (l >> 1)) & 1) {
              pg8::SchedDense S{(const char*)(ws + WS_U8), (const char*)(ws + WS_FGU + (size_t)j * SZ_FGU), SEQ / 256, 2 * DFF / 256, G, cid, DM / 2, DM / 2};
              constexpr bool HD8 = (DD8_MASK >> (l >> 1)) & 1;
              pg8::EpiSwiglu<false, HD8> E{(unsigned char*)P_PROJ, DFF, nullptr, F.lc, 1.0f / (S_XB8 * S_W8I), (const u64*)(F.ctl + CW_RS) + l * SEQ};
              pg8::gemm_phase<pg8::EpiSwiglu<false, HD8>, pg8::SchedDense, true, 2>(F.lds, DM / 2, DM / 2, DM / 2, S, E);
              } else {
              pg8::SchedDense S{(const char*)P_U, (const char*)(ws + WS_FGU + (size_t)j * SZ_FGU), SEQ / 256, 2 * DFF / 256, G, cid, DM, DM};
              pg8::EpiSwiglu<false> E{(unsigned char*)P_PROJ, DFF, nullptr, F.lc, 1.0f, (const u64*)(F.ctl + CW_RS) + l * SEQ};
              pg8::gemm_phase<pg8::EpiSwiglu<false>, pg8::SchedDense, true>(F.lds, DM, DM, DM, S, E); }
              { PH(); const int nun = (SEQ / 256) * (2 * DFF / 256), rem = nun % G; if (cid >= rem) convert_moe_expert(F, l == 0 ? 6 : 12, cid - rem, G - rem, l == 0 ? 2 : 1); }
            GRID_BAR(); PE(9); }
            { PB(10); PH(); constexpr bool DD8 = (DD8_MASK >> (l >> 1)) & 1; constexpr int KP = DD8 ? DFF / 2 : DFF;
              pg8::SchedDense S{(const char*)P_PROJ, (const char*)(ws + WS_FD + (size_t)j * SZ_FD), SEQ / 256, 4, G, cid, KP, KP};
              constexpr int XBM = (l + 1 < NBF) ? 1 : 2;
              pg8::EpiRes<XBM, false> E{(const void*)P_XRES, P_XRES, DD8 ? 1.0f / W8_DN : 1.0f, F.ka->in[I_NORM_MIX] + (l + 1) * DM, XBM == 1 ? (unsigned char*)P_U : (unsigned char*)(ws + WS_U8), (u64*)(F.ctl + CW_RS) + (l + 1) * SEQ};
              pg8::gemm_phase<pg8::EpiRes<XBM, false>, pg8::SchedDense, false, DD8 ? 1 : 0>(F.lds, KP, KP, KP, S, E);
            GRID_BAR(); PE(10); }
        }
}
__global__ void __launch_bounds__(512, 2) fwd_kernel(Args args_unused) {
    extern __shared__ __attribute__((aligned(16))) unsigned char lds_raw[];
    Frame F;
    F.lds = (ldsp)lds_raw; F.lc = (volatile LAS unsigned*)(F.lds + LDSCTL_OFF);
    F.G = gridDim.x; { const int bx = blockIdx.x; F.vcu = (F.G % 8 == 0) ? (bx % 8) * (F.G / 8) + bx / 8 : bx; }
    refresh(F); F.pacc = 0ull;
    for (int u = F.tid; u < (LDS_BYTES - LDSCTL_OFF) / 4; u += 512) F.lc[u] = 0u;
    __syncthreads();
    (void)xcd_barrier_post(F.ctl + CW_BAR, F.lc + LC_BAR);
    const int G = F.G, cid = (int)blockIdx.x;

    { PB(1); PH(); prologue_convert(F); PE(1); }
    { PB(2); PH(); norm_phase<false, false, 0, false, (NBF > 0 ? 0 : 1), false>(F, F.ka->in[I_X], nullptr, F.ka->in[I_NORM_MIX], NBF > 0 ? P_U : (bf16*)(ws + WS_U8), nullptr, nullptr, 0, 0);
    GRID_BAR(); PE(2); }

    layer_body<0>(F); layer_body<1>(F); layer_body<2>(F); layer_body<3>(F);
    { PB(2); PH(); norm_phase<true, false, 0, true>(F, P_XRES, nullptr, F.ka->in[I_NORM_FINAL], nullptr, F.ka->out, nullptr, 0, 0); PE(2); }
    if (PROBE_GROUP) { const unsigned long long t0 = __builtin_amdgcn_s_memrealtime(), wait = F.pacc * PROBE_AMP; while (__builtin_amdgcn_s_memrealtime() - t0 < wait) __builtin_amdgcn_s_sleep(20); }
}

extern "C" void kernel_launch(void* const* d_in, const int* in_sizes, int n_in, void* d_out, int out_size, void* d_ws, size_t ws_size, hipStream_t stream) {
    static int grid = 0;
    if (grid == 0) {
        if (n_in != 22 || out_size != SEQ * DM || ws_size < WS_END) { fprintf(stderr, "kernel_launch: unexpected problem (n_in %d, out %d, ws %zu < %zu)\n", n_in, out_size, ws_size, (size_t)WS_END); grid = -1; return; }
        int dev = 0, cus = 0;
        if (hipGetDevice(&dev) != hipSuccess || hipDeviceGetAttribute(&cus, hipDeviceAttributeMultiprocessorCount, dev) != hipSuccess) { grid = -1; return; }
        if (hipFuncSetAttribute((const void*)fwd_kernel, hipFuncAttributeMaxDynamicSharedMemorySize, LDS_BYTES) != hipSuccess) { fprintf(stderr, "kernel_launch: hipFuncSetAttribute failed\n"); grid = -1; return; }
        int per_cu = 0;
        if (hipOccupancyMaxActiveBlocksPerMultiprocessor(&per_cu, (const void*)fwd_kernel, 512, LDS_BYTES) != hipSuccess || per_cu < 1) { fprintf(stderr, "kernel_launch: occupancy query says %d\n", per_cu); }
        (void)hipGetLastError();
        grid = cus;
    }
    if (grid < 0) return;
    (void)hipMemsetAsync((char*)d_ws + WS_CTL, 0, CTL_ZERO_BYTES, stream);
    Args a{};
    for (int i = 0; i < 22; ++i) a.in[i] = (const float*)d_in[i];
    a.out = (float*)d_out; a.ws = (unsigned char*)d_ws;
    hipLaunchKernelGGL(fwd_kernel, dim3(grid), dim3(512), LDS_BYTES, stream, a);
}
```
